# Optimizing an MI355X kernel written in HIP

```python
import math
import jax
import jax.numpy as jnp
from jax import lax
import numpy as np

D_MODEL = 1024
BATCH = 2
SEQ = 8192
DEPTH = 2

GRID_W = 64
CTX_LEN = 256
N_DIR = 2
SHORT_CONV = 3

D_MIX = D_MODEL
D_MLSTM = D_MIX // 4
MLSTM_HEAD_DIM = 64
MLSTM_HEADS = D_MLSTM // MLSTM_HEAD_DIM
MLSTM_GATES = N_DIR * 2 * MLSTM_HEADS
MLSTM_CHUNK = 128

D_ATTN = D_MIX // 2
ATTN_HEAD_DIM = 64
ATTN_HEADS = D_ATTN // ATTN_HEAD_DIM
ATTN_KV_HEADS = 2
ATTN_GROUP = ATTN_HEADS // ATTN_KV_HEADS
D_KV = ATTN_KV_HEADS * ATTN_HEAD_DIM
ATTN_BLOCK = 128
ROPE_THETA = 10000.0

D_HYENA = D_MIX - D_MLSTM - D_ATTN
HYENA_ORDER = 2
HYENA_BANDS = 16
HYENA_EMB = 1 + 2 * HYENA_BANDS
HYENA_FILTER_HIDDEN = 64
HYENA_FAST_DECAY = 0.3
HYENA_SLOW_DECAY = 1.5
HYENA_DECAY_TARGET = 1e-2
HYENA_WINDOW_SHIFT = 0.05

N_IN = 4 * D_MLSTM + MLSTM_GATES + D_ATTN + 2 * D_KV + 3 * D_HYENA

N_EXPERTS = 16
EC_CAPACITY_FACTOR = 2
D_FF_EXPERT = 2816

N_MOD = 6
LN_EPS = 1e-5
RMS_EPS = 1e-6

kernel_name = "hybrid_mlstm_gqa_hyena_ecmoe_dit"


def _layer_norm(x, w=None, b=None):
    xf = x.astype(jnp.float32)
    mu = jnp.mean(xf, axis=-1, keepdims=True)
    var = jnp.mean(jnp.square(xf - mu), axis=-1, keepdims=True)
    y = (xf - mu) * lax.rsqrt(var + LN_EPS)
    if w is not None:
        y = y * w.astype(jnp.float32) + b.astype(jnp.float32)
    return y.astype(x.dtype)


def _rms_norm(x, w):
    xf = x.astype(jnp.float32)
    y = xf * lax.rsqrt(jnp.mean(xf * xf, axis=-1, keepdims=True) + RMS_EPS)
    return (y * w.astype(jnp.float32)).astype(x.dtype)


def _modulate(x, shift, scale):
    return _layer_norm(x) * (1 + scale) + shift


def _centred_dwconv(x, w, b):
    ch = x.shape[-1]
    pad = SHORT_CONV // 2
    y = lax.conv_general_dilated(x, w.astype(x.dtype)[:, None, :], window_strides=(1,),
                                 padding=[(pad, pad)], dimension_numbers=("NWC", "WIO", "NWC"),
                                 feature_group_count=ch)
    return y + b.astype(x.dtype)


def _split_projection(p):
    sizes = (2 * D_MLSTM, D_MLSTM, D_MLSTM, MLSTM_GATES, D_ATTN, D_KV, D_KV, 3 * D_HYENA)
    idx, acc = [], 0
    for s in sizes[:-1]:
        acc += s
        idx.append(acc)
    return jnp.split(p, idx, axis=-1)


def _mlstm_chunk_scan(q, k, v, li, lf, state):
    n_dir, bsz, nh, L, dh = q.shape
    nc = L // MLSTM_CHUNK

    def chunks(a):
        a = a.reshape(a.shape[:3] + (nc, MLSTM_CHUNK) + a.shape[4:])
        return jnp.moveaxis(a, 3, 0)

    lower = jnp.tril(jnp.ones((MLSTM_CHUNK, MLSTM_CHUNK), dtype=bool))

    def step(carry, inp):
        c0, n0, m0 = carry
        qc, kc, vc, ic, fc = inp
        bcum = jnp.cumsum(fc, axis=-1)
        log_inter = bcum + m0[..., None]
        log_intra = jnp.where(lower, bcum[..., :, None] - bcum[..., None, :] + ic[..., None, :], -jnp.inf)
        m = jnp.maximum(log_inter, jnp.max(log_intra, axis=-1))
        w_inter = jnp.exp(log_inter - m)
        scores = jnp.einsum("nbhjd,nbhsd->nbhjs", qc, kc) * jnp.exp(log_intra - m[..., None])
        num = (w_inter[..., None] * jnp.einsum("nbhed,nbhjd->nbhje", c0, qc)
               + jnp.einsum("nbhjs,nbhse->nbhje", scores, vc))
        den = w_inter * jnp.einsum("nbhd,nbhjd->nbhj", n0, qc) + jnp.sum(scores, axis=-1)
        hc = num / jnp.maximum(jnp.abs(den), jnp.exp(-m))[..., None]
        b_last = bcum[..., -1:]
        log_src = b_last - bcum + ic
        m_new = jnp.maximum(b_last[..., 0] + m0, jnp.max(log_src, axis=-1))
        w_src = jnp.exp(log_src - m_new[..., None])
        decay = jnp.exp(b_last[..., 0] + m0 - m_new)
        c_new = decay[..., None, None] * c0 + jnp.einsum("nbhs,nbhse,nbhsd->nbhed", w_src, vc, kc)
        n_new = decay[..., None] * n0 + jnp.einsum("nbhs,nbhsd->nbhd", w_src, kc)
        return (c_new, n_new, m_new), hc

    state, hs = lax.scan(step, state, tuple(chunks(a) for a in (q, k, v, li, lf)))
    hs = jnp.moveaxis(hs, 0, 3).reshape(n_dir, bsz, nh, L, dh)
    return hs, state


def _mlstm_zero_state(bsz):
    f32 = jnp.float32
    return (jnp.zeros((N_DIR, bsz, MLSTM_HEADS, MLSTM_HEAD_DIM, MLSTM_HEAD_DIM), f32),
            jnp.zeros((N_DIR, bsz, MLSTM_HEADS, MLSTM_HEAD_DIM), f32),
            jnp.zeros((N_DIR, bsz, MLSTM_HEADS), f32))


def _mlstm_stream(q, k, v, gates, gate_b, state):
    bsz, n, _ = q.shape

    def heads(a):
        return a.reshape(bsz, n, MLSTM_HEADS, MLSTM_HEAD_DIM).transpose(0, 2, 1, 3).astype(jnp.float32)

    def both_dirs(a):
        return jnp.stack([a, jnp.flip(a, axis=2)])

    g = gates.astype(jnp.float32).reshape(bsz, n, N_DIR, 2, MLSTM_HEADS) + gate_b.astype(jnp.float32)
    g = jnp.transpose(g, (2, 3, 0, 4, 1))
    li = jnp.stack([g[0, 0], jnp.flip(g[1, 0], axis=-1)])
    lf = jax.nn.log_sigmoid(jnp.stack([g[0, 1], jnp.flip(g[1, 1], axis=-1)]))
    h, state = _mlstm_chunk_scan(both_dirs(heads(q) * MLSTM_HEAD_DIM ** -0.5), both_dirs(heads(k)),
                                 both_dirs(heads(v)), li, lf, state)
    return h[0] + jnp.flip(h[1], axis=2), state


def _mlstm_output(h, o, norm_w):
    bsz, _, n, _ = h.shape
    h = _rms_norm(jnp.transpose(h, (0, 2, 1, 3)), norm_w.reshape(MLSTM_HEADS, MLSTM_HEAD_DIM))
    return (jax.nn.sigmoid(o.astype(jnp.float32)) * h.reshape(bsz, n, D_MLSTM)).astype(o.dtype)


def _axial_rope_tables(n_lat):
    rows = n_lat // GRID_W
    row = jnp.repeat(jnp.arange(rows, dtype=jnp.float32), GRID_W)
    col = (jnp.arange(n_lat) % GRID_W).astype(jnp.float32)
    nf = ATTN_HEAD_DIM // 4
    inv = ROPE_THETA ** (-jnp.arange(nf, dtype=jnp.float32) / nf)
    ar = row[:, None] * inv
    ac = col[:, None] * inv
    ang = jnp.concatenate([ar, ar, ac, ac], axis=-1)
    return jnp.cos(ang), jnp.sin(ang)


def _apply_rope(x, cos, sin):
    nf = ATTN_HEAD_DIM // 4
    xf = x.astype(jnp.float32)
    xr = xf.reshape(xf.shape[:-1] + (2, 2, nf))
    rot = jnp.stack([-xr[..., 1, :], xr[..., 0, :]], axis=-2).reshape(xf.shape)
    return (xf * cos + rot * sin).astype(x.dtype)


def _attend(q, k, v):
    s = jnp.einsum("bkgqd,bksd->bkgqs", q, k, preferred_element_type=jnp.float32)
    p = jax.nn.softmax(s, axis=-1).astype(v.dtype)
    return jnp.einsum("bkgqs,bksd->bkgqd", p, v)


def _gqa_mixer(q_lat, k_lat, v_lat, q_ctx, k_ctx, v_ctx, q_norm_w, k_norm_w, with_ctx_out):
    bsz, n_lat, _ = q_lat.shape
    n_ctx = q_ctx.shape[1]
    scale = ATTN_HEAD_DIM ** -0.5

    def q_heads(q):
        n = q.shape[1]
        q = q.reshape(bsz, n, ATTN_KV_HEADS, ATTN_GROUP, ATTN_HEAD_DIM).transpose(0, 2, 3, 1, 4)
        return _rms_norm(q, q_norm_w) * scale

    def kv_heads(t):
        n = t.shape[1]
        return t.reshape(bsz, n, ATTN_KV_HEADS, ATTN_HEAD_DIM).transpose(0, 2, 1, 3)

    cos, sin = _axial_rope_tables(n_lat)
    ql = _apply_rope(q_heads(q_lat), cos, sin)
    kl = _apply_rope(_rms_norm(kv_heads(k_lat), k_norm_w), cos, sin)
    kc = _rms_norm(kv_heads(k_ctx), k_norm_w)
    vc = kv_heads(v_ctx)
    k_all = jnp.concatenate([kl, kc], axis=2)
    v_all = jnp.concatenate([kv_heads(v_lat), vc], axis=2)
    nb = n_lat // ATTN_BLOCK
    qb = jnp.moveaxis(ql.reshape(bsz, ATTN_KV_HEADS, ATTN_GROUP, nb, ATTN_BLOCK, ATTN_HEAD_DIM), 3, 0)
    o = lax.map(lambda qi: _attend(qi, k_all, v_all), qb)
    y_lat = jnp.transpose(o, (1, 0, 4, 2, 3, 5)).reshape(bsz, n_lat, D_ATTN)
    if not with_ctx_out:
        return y_lat, None
    oc = _attend(q_heads(q_ctx), kc, vc)
    return y_lat, oc.transpose(0, 3, 1, 2, 4).reshape(bsz, n_ctx, D_ATTN)


def _hyena_filters(n, f_w1, f_b1, f_freq, f_w2, f_b2, f_w3):
    f32 = jnp.float32
    t = jnp.arange(n, dtype=f32) / n
    bands = jnp.arange(1, HYENA_BANDS + 1, dtype=f32)
    ang = (2.0 * math.pi) * t[:, None] * bands
    feats = jnp.concatenate([t[:, None], jnp.cos(ang), jnp.sin(ang)], axis=-1)
    hid = jnp.sin(f_freq[0].astype(f32) * (feats @ f_w1.astype(f32) + f_b1.astype(f32)))
    hid = jnp.sin(f_freq[1].astype(f32) * (hid @ f_w2.astype(f32) + f_b2.astype(f32)))
    filt = (hid @ f_w3.astype(f32)).reshape(n, N_DIR, HYENA_ORDER, D_HYENA)
    log_target = abs(math.log(HYENA_DECAY_TARGET))
    deltas = jnp.linspace(log_target / HYENA_SLOW_DECAY, log_target / HYENA_FAST_DECAY, D_HYENA, dtype=f32)
    window = jnp.exp(-t[:, None] * deltas) + HYENA_WINDOW_SHIFT
    filt = filt * window[:, None, None, :]
    fwd = filt[:, 0]
    bwd = filt[1:, 1]
    l1 = jnp.sum(jnp.abs(fwd), axis=0) + jnp.sum(jnp.abs(bwd), axis=0)
    taps = jnp.concatenate([fwd, jnp.zeros((1, HYENA_ORDER, D_HYENA), f32), bwd[::-1]], axis=0)
    return taps / l1


def _fft_long_conv(z, taps):
    n = z.shape[1]
    zf = jnp.fft.rfft(z, n=2 * n, axis=1)
    tf = jnp.fft.rfft(taps, axis=0)
    return jnp.fft.irfft(zf * tf[None], n=2 * n, axis=1)[:, :n]


def _hyena(u, filter_params, skip):
    n = u.shape[1]
    taps = _hyena_filters(n, *filter_params)
    v, x1, x2 = jnp.split(u.astype(jnp.float32), 3, axis=-1)
    z = v
    for o, gate in enumerate((x1, x2)):
        z = gate * (_fft_long_conv(z, taps[:, o]) + skip[o].astype(jnp.float32) * z)
    return z.astype(u.dtype)


def _mixing_sublayer(h_lat, h_ctx, w_in, mlstm_conv_w, mlstm_conv_b, mlstm_gate_b, mlstm_norm_w,
                     attn_q_norm_w, attn_k_norm_w, hyena_conv_w, hyena_conv_b, hyena_filter,
                     hyena_skip, w_out, with_ctx_out):
    bsz = h_lat.shape[0]
    mqk_l, mv_l, mo_l, mg_l, aq_l, ak_l, av_l, hy_l = _split_projection(h_lat @ w_in)
    mqk_c, mv_c, mo_c, mg_c, aq_c, ak_c, av_c, hy_c = _split_projection(h_ctx @ w_in)
    q_c, k_c = jnp.split(jax.nn.silu(_centred_dwconv(mqk_c, mlstm_conv_w, mlstm_conv_b)), 2, axis=-1)
    q_l, k_l = jnp.split(jax.nn.silu(_centred_dwconv(mqk_l, mlstm_conv_w, mlstm_conv_b)), 2, axis=-1)
    hm_c, ctx_state = _mlstm_stream(q_c, k_c, mv_c, mg_c, mlstm_gate_b, _mlstm_zero_state(bsz))
    hm_l, _ = _mlstm_stream(q_l, k_l, mv_l, mg_l, mlstm_gate_b, ctx_state)
    ym_l = _mlstm_output(hm_l, mo_l, mlstm_norm_w)
    ya_l, ya_c = _gqa_mixer(aq_l, ak_l, av_l, aq_c, ak_c, av_c, attn_q_norm_w, attn_k_norm_w, with_ctx_out)
    yh_l = _hyena(_centred_dwconv(hy_l, hyena_conv_w, hyena_conv_b), hyena_filter, hyena_skip)
    y_lat = jnp.concatenate([ym_l, ya_l, yh_l], axis=-1) @ w_out
    if not with_ctx_out:
        return y_lat, None
    ym_c = _mlstm_output(hm_c, mo_c, mlstm_norm_w)
    yh_c = _hyena(_centred_dwconv(hy_c, hyena_conv_w, hyena_conv_b), hyena_filter, hyena_skip)
    y_ctx = jnp.concatenate([ym_c, ya_c, yh_c], axis=-1) @ w_out
    return y_lat, y_ctx


def _expert_choice_ffn(h, router_w, router_b, w_gate, w_up, w_down):
    bsz, n, d = h.shape
    cap = EC_CAPACITY_FACTOR * n // N_EXPERTS
    logits = (h @ router_w).astype(jnp.float32) + router_b.astype(jnp.float32)
    aff = jax.nn.softmax(logits, axis=-1)
    top_val, top_idx = lax.top_k(jnp.swapaxes(aff, 1, 2), cap)
    xs = jax.vmap(lambda hb, ib: hb[ib])(h, top_idx)
    g = jnp.einsum("becd,edf->becf", xs, w_gate)
    u = jnp.einsum("becd,edf->becf", xs, w_up)
    y = jnp.einsum("becf,efd->becd", jax.nn.silu(g) * u, w_down) * top_val[..., None].astype(h.dtype)
    return jax.vmap(lambda yb, ib: jnp.zeros((n, d), yb.dtype).at[ib.reshape(-1)].add(yb.reshape(-1, d)))(y, top_idx)


def setup_inputs(seed: int = 0) -> dict:
    key = jax.random.key(seed)
    ks = iter(jax.random.split(key, 40))
    f32 = jnp.float32

    def nrm(shape, scale):
        return scale * jax.random.normal(next(ks), shape, f32)

    beta = (8.0 * DEPTH) ** -0.25
    fg_base = jnp.linspace(3.0, 6.0, MLSTM_HEADS, dtype=f32)
    mlstm_gate_b = jnp.concatenate([nrm((DEPTH, N_DIR, 1, MLSTM_HEADS), 0.1),
                                    fg_base + nrm((DEPTH, N_DIR, 1, MLSTM_HEADS), 0.1)], axis=2)
    return {
        "x": nrm((BATCH, SEQ, D_MODEL), 1.0),
        "c": nrm((BATCH, D_MODEL), 1.0),
        "ctx": nrm((BATCH, CTX_LEN, D_MODEL), 1.0),
        "c_ctx": nrm((D_MODEL,), 1.0),
        "w_mod": nrm((DEPTH, D_MODEL, N_MOD * D_MODEL), 0.5 * D_MODEL ** -0.5),
        "b_mod": nrm((DEPTH, N_MOD * D_MODEL), 0.02),
        "w_in": nrm((DEPTH, D_MODEL, N_IN), D_MODEL ** -0.5),
        "mlstm_conv_w": nrm((DEPTH, SHORT_CONV, 2 * D_MLSTM), SHORT_CONV ** -0.5),
        "mlstm_conv_b": nrm((DEPTH, 2 * D_MLSTM), 0.02),
        "mlstm_gate_b": mlstm_gate_b,
        "mlstm_norm_w": 1.0 + nrm((DEPTH, D_MLSTM), 0.02),
        "attn_q_norm_w": 1.0 + nrm((DEPTH, ATTN_HEAD_DIM), 0.02),
        "attn_k_norm_w": 1.0 + nrm((DEPTH, ATTN_HEAD_DIM), 0.02),
        "hyena_conv_w": nrm((DEPTH, SHORT_CONV, 3 * D_HYENA), SHORT_CONV ** -0.5),
        "hyena_conv_b": nrm((DEPTH, 3 * D_HYENA), 0.02),
        "hyena_f_w1": nrm((DEPTH, HYENA_EMB, HYENA_FILTER_HIDDEN), HYENA_EMB ** -0.5),
        "hyena_f_b1": nrm((DEPTH, HYENA_FILTER_HIDDEN), 0.5),
        "hyena_f_freq": 1.0 + nrm((DEPTH, 2, HYENA_FILTER_HIDDEN), 0.1),
        "hyena_f_w2": nrm((DEPTH, HYENA_FILTER_HIDDEN, HYENA_FILTER_HIDDEN), HYENA_FILTER_HIDDEN ** -0.5),
        "hyena_f_b2": nrm((DEPTH, HYENA_FILTER_HIDDEN), 0.5),
        "hyena_f_w3": nrm((DEPTH, HYENA_FILTER_HIDDEN, N_DIR * HYENA_ORDER * D_HYENA), HYENA_FILTER_HIDDEN ** -0.5),
        "hyena_skip": nrm((DEPTH, HYENA_ORDER, D_HYENA), 0.5),
        "w_out": nrm((DEPTH, D_MIX, D_MODEL), beta * D_MIX ** -0.5),
        "ln_mix_w": 1.0 + nrm((DEPTH, D_MODEL), 0.02),
        "ln_mix_b": nrm((DEPTH, D_MODEL), 0.02),
        "router_w": nrm((DEPTH, D_MODEL, N_EXPERTS), D_MODEL ** -0.5),
        "router_b": nrm((DEPTH, N_EXPERTS), 0.01),
        "exp_w_gate": nrm((DEPTH, N_EXPERTS, D_MODEL, D_FF_EXPERT), D_MODEL ** -0.5),
        "exp_w_up": nrm((DEPTH, N_EXPERTS, D_MODEL, D_FF_EXPERT), D_MODEL ** -0.5),
        "exp_w_down": nrm((DEPTH, N_EXPERTS, D_FF_EXPERT, D_MODEL), beta * D_FF_EXPERT ** -0.5),
        "ln_ffn_w": 1.0 + nrm((DEPTH, D_MODEL), 0.02),
        "ln_ffn_b": nrm((DEPTH, D_MODEL), 0.02),
    }


def reference(x, c, ctx, c_ctx, w_mod, b_mod, w_in, mlstm_conv_w, mlstm_conv_b, mlstm_gate_b,
              mlstm_norm_w, attn_q_norm_w, attn_k_norm_w, hyena_conv_w, hyena_conv_b,
              hyena_f_w1, hyena_f_b1, hyena_f_freq, hyena_f_w2, hyena_f_b2, hyena_f_w3,
              hyena_skip, w_out, ln_mix_w, ln_mix_b, router_w, router_b,
              exp_w_gate, exp_w_up, exp_w_down, ln_ffn_w, ln_ffn_b):
    alpha = (2.0 * DEPTH) ** 0.25
    for l in range(DEPTH):
        last = l == DEPTH - 1
        mod_x = jnp.split((jax.nn.silu(c) @ w_mod[l] + b_mod[l])[:, None, :], N_MOD, axis=-1)
        mod_c = jnp.split((jax.nn.silu(c_ctx) @ w_mod[l] + b_mod[l])[None, None, :], N_MOD, axis=-1)
        mix_x, mix_c = _mixing_sublayer(
            _modulate(x, mod_x[0], mod_x[1]), _modulate(ctx, mod_c[0], mod_c[1]),
            w_in[l], mlstm_conv_w[l], mlstm_conv_b[l], mlstm_gate_b[l], mlstm_norm_w[l],
            attn_q_norm_w[l], attn_k_norm_w[l], hyena_conv_w[l], hyena_conv_b[l],
            (hyena_f_w1[l], hyena_f_b1[l], hyena_f_freq[l], hyena_f_w2[l], hyena_f_b2[l], hyena_f_w3[l]),
            hyena_skip[l], w_out[l], not last)
        x = _layer_norm(alpha * x + mod_x[2] * mix_x, ln_mix_w[l], ln_mix_b[l])
        ffn_x = _expert_choice_ffn(_modulate(x, mod_x[3], mod_x[4]), router_w[l], router_b[l],
                                   exp_w_gate[l], exp_w_up[l], exp_w_down[l])
        x = _layer_norm(alpha * x + mod_x[5] * ffn_x, ln_ffn_w[l], ln_ffn_b[l])
        if not last:
            ctx = _layer_norm(alpha * ctx + mod_c[2] * mix_c, ln_mix_w[l], ln_mix_b[l])
            ffn_c = _expert_choice_ffn(_modulate(ctx, mod_c[3], mod_c[4]), router_w[l], router_b[l],
                                       exp_w_gate[l], exp_w_up[l], exp_w_down[l])
            ctx = _layer_norm(alpha * ctx + mod_c[5] * ffn_c, ln_ffn_w[l], ln_ffn_b[l])
    return x
```

```cpp
#include <hip/hip_runtime.h>
#include <hip/hip_bf16.h>
#include <cstdio>
#include <cstdint>
#include <cmath>

#ifndef MK_SINGLE
#define MK_SINGLE 0
#endif

namespace pg8 {
#define PG8_LAS __attribute__((address_space(3)))
typedef unsigned short bf16_t;
typedef short bf16x8 __attribute__((ext_vector_type(8)));
typedef float f32x4 __attribute__((ext_vector_type(4)));
typedef unsigned u32x4 __attribute__((ext_vector_type(4)));
constexpr int BM = 256, BK = 64, HALF = 128, HTB = HALF * BK * 2  , STAGE_BYTES = 8 * HTB, NXCD = 8, WGM = 8;

__host__ __device__ __forceinline__ int lds_byte(int r, int c) { const int st = (r >> 4) * 2 + (c >> 5), rr = r & 15, cc = c & 31, ob = rr * 64 + cc * 2; return st * 1024 + (ob ^ (((ob >> 9) & 1) << 5)); }
__host__ __device__ __forceinline__ void stage_rc(int b, int& R, int& C) { const int st = b / 1024, sb = b % 1024, swz = sb ^ (((sb >> 9) & 1) << 5); R = (st >> 1) * 16 + swz / 64; C = (st & 1) * 32 + (swz % 64) / 2; }
__host__ __device__ __forceinline__ int perm32(int rho) { const int n = rho >> 4, i = rho & 15; return 8 * (i >> 2) + 4 * n + (i & 3); }

struct Unit { int pm, pn; };
struct Gemm { const bf16_t* A; const bf16_t* Bt; int M, N, K; };

struct StaticOrder {
    int nM, nN, nwg, G, c;
    __host__ __device__ void init(int M, int N, int G_, int c_) { nM = M / BM; nN = N / BM; nwg = nM * nN; G = G_; c = c_; }
    __host__ __device__ bool next(int i, Unit& u) const {
        const long L = (long)i * G + c; if (L >= nwg) return false;
        int wgid = (int)L; { const int q = nwg / NXCD, r = nwg % NXCD, xcd = wgid % NXCD, off = wgid / NXCD; wgid = (xcd < r ? xcd * (q + 1) : r * (q + 1) + (xcd - r) * q) + off; }
        const int nig = WGM * nN, gid = wgid / nig, fm = gid * WGM, gsz = (nM - fm) < WGM ? (nM - fm) : WGM;
        u.pm = fm + ((wgid % nig) % gsz); u.pn = (wgid % nig) / gsz; return true;
    }
    __device__ __forceinline__ void a_ready(const Unit&) const {}
    __device__ __forceinline__ void done(const Unit&) const {}
};

__device__ __forceinline__ unsigned cvt_pk_bf16(float lo, float hi) { unsigned r; asm volatile("v_cvt_pk_bf16_f32 %0, %1, %2" : "=v"(r) : "v"(lo), "v"(hi)); return r; }
typedef float f32x2 __attribute__((ext_vector_type(2)));
__device__ __forceinline__ f32x2 gelu_pk(f32x2 v) {
    const f32x2 av = __builtin_elementwise_abs(v), d = av * 0.2316418882f + 1.0f;
    f32x2 t; t.x = __builtin_amdgcn_rcpf(d.x); t.y = __builtin_amdgcn_rcpf(d.y);
    f32x2 q = t * 0.5307027145f + (-0.7265760135f); q = q * t + 0.7107068705f; q = q * t + (-0.142248368f); q = q * t + 0.127414796f; q = q * t;
    const f32x2 s = (v * v) * (-0.72134752044f);
    f32x2 e; e.x = __builtin_amdgcn_exp2f(s.x); e.y = __builtin_amdgcn_exp2f(s.y);
    const f32x2 m = v * (q * e), r = v - m;
    f32x2 o; o.x = v.x < 0.f ? m.x : r.x; o.y = v.y < 0.f ? m.y : r.y; return o;
}

template <int ACT  > struct EpiBf16 {
    static constexpr bool PERM = true, AFTER_DRAIN = false; static_assert(ACT == 0 || ACT == 1, "EpiBf16: ACT is 0 (none) or 1 (gelu_pk)");
    bf16_t* O; int ldc; const float* bias; int split_cols; size_t split_stride; float scale0;
    __device__ __forceinline__ void operator()(const f32x4 (&acc)[2][2][4][2], const Unit& u, int wr, int wc, int fr, int fq) const {
        const int row0 = u.pm * BM + wr * 64 + fr; int colt = u.pn * BM; bf16_t* base = O;
        float sc = 1.f; if (split_cols) { const int t = colt / split_cols; base += (size_t)t * split_stride; colt -= t * split_cols; if (t == 0) sc = scale0; }
        const int col0 = colt + wc * 32 + 8 * fq, bcol0 = u.pn * BM + wc * 32 + 8 * fq;
        f32x4 bv[2][2];
#pragma unroll
        for (int bj = 0; bj < 2; ++bj)
#pragma unroll
            for (int n = 0; n < 2; ++n) bv[bj][n] = bias ? *(const f32x4*)(bias + bcol0 + bj * HALF + 4 * n) : (f32x4){0.f, 0.f, 0.f, 0.f};
#pragma unroll
        for (int ai = 0; ai < 2; ++ai)
#pragma unroll
            for (int m = 0; m < 4; ++m) { bf16_t* rowp = base + (size_t)(row0 + ai * HALF + m * 16) * ldc + col0;
#pragma unroll
                for (int bj = 0; bj < 2; ++bj) { f32x4 v0 = acc[ai][bj][m][0] + bv[bj][0], v1 = acc[ai][bj][m][1] + bv[bj][1];
                    if (ACT == 1) { f32x2 a = gelu_pk((f32x2){v0[0], v0[1]}), b = gelu_pk((f32x2){v0[2], v0[3]}), c = gelu_pk((f32x2){v1[0], v1[1]}), d = gelu_pk((f32x2){v1[2], v1[3]});
                        v0 = (f32x4){a.x, a.y, b.x, b.y}; v1 = (f32x4){c.x, c.y, d.x, d.y}; }
                    v0 = v0 * sc; v1 = v1 * sc; u32x4 w; w.x = cvt_pk_bf16(v0[0], v0[1]); w.y = cvt_pk_bf16(v0[2], v0[3]); w.z = cvt_pk_bf16(v1[0], v1[1]); w.w = cvt_pk_bf16(v1[2], v1[3]);
                    *(u32x4*)(rowp + bj * HALF) = w; } }
    }
};


template <class Epi, class Sched, bool ALIGN_EPI = false, bool SP2 = false>
__device__ __forceinline__ void gemm_phase(PG8_LAS unsigned char* lds, const Gemm g, const Sched& S, const Epi& E) {
    const int tid = threadIdx.x, wid = __builtin_amdgcn_readfirstlane(tid >> 6), lane = tid & 63, wr = wid >> 2, wc = wid & 3, fr = lane & 15, fq = lane >> 4;
    const int K = g.K, nt = K / BK;
    unsigned voffA[2], voffB[2];
#pragma unroll
    for (int i = 0; i < 2; ++i) { int R, C; stage_rc(tid * 16 + i * 8192, R, C); const int Rb = Epi::PERM ? ((R & ~31) + perm32(R & 31)) : R;
        voffA[i] = (unsigned)(R * K + C) * 2u; voffB[i] = (unsigned)(Rb * K + C) * 2u; }
    const size_t kstep = (size_t)(BK * 2);
    const size_t hstep = (size_t)HALF * K * 2;
    const size_t tstep = 2 * hstep;
    const unsigned ldsw = (unsigned)wid * 1024u;
    const int aoff = lds_byte(wr * 64 + fr, fq * 8), boff = lds_byte(wc * 32 + fr, fq * 8);
#define PG8_SA(b, h) (((b) * 2 + (h)) * HTB)
#define PG8_SB(b, h) ((4 + (b) * 2 + (h)) * HTB)
#define PG8_STAGE(bufoff, gbase, voff) do { _Pragma("unroll") for (int _i = 0; _i < 2; ++_i) \
        __builtin_amdgcn_global_load_lds((const unsigned*)((const char*)(gbase) + (voff)[_i]), (PG8_LAS unsigned*)(lds + (bufoff) + ldsw + _i * 8192), 16, 0, 0); } while (0)
#define PG8_LDA(dst, b, h) do { _Pragma("unroll") for (int m = 0; m < 4; ++m) _Pragma("unroll") for (int k = 0; k < 2; ++k) dst[m][k] = *(const PG8_LAS bf16x8*)(lds + PG8_SA(b, h) + aoff + m * 2048 + k * 1024); } while (0)
#define PG8_LDB(dst, b, h) do { _Pragma("unroll") for (int n = 0; n < 2; ++n) _Pragma("unroll") for (int k = 0; k < 2; ++k) dst[n][k] = *(const PG8_LAS bf16x8*)(lds + PG8_SB(b, h) + boff + n * 2048 + k * 1024); } while (0)
#define PG8_MMA(ai, bj, At, Bt) do { __builtin_amdgcn_s_setprio(1); _Pragma("unroll") for (int m = 0; m < 4; ++m) _Pragma("unroll") for (int n = 0; n < 2; ++n) _Pragma("unroll") for (int k = 0; k < 2; ++k) \
        acc[ai][bj][m][n] = __builtin_amdgcn_mfma_f32_16x16x32_bf16(Bt[n][k], At[m][k], acc[ai][bj][m][n], 0, 0, 0); __builtin_amdgcn_s_setprio(0); } while (0)
#define PG8_WAIT_V(n) asm volatile("s_waitcnt vmcnt(" #n ")" ::: "memory")
#define PG8_WAIT_L(n) asm volatile("s_waitcnt lgkmcnt(" #n ")" ::: "memory")
#define PG8_BAR __builtin_amdgcn_s_barrier()
#define PG8_SCHED __builtin_amdgcn_sched_barrier(0)
    Unit cur, nxt; int ui = 0;
    if (!S.next(0, cur)) return;
    f32x4 acc[2][2][4][2];
#pragma unroll
    for (int a = 0; a < 2; ++a)
#pragma unroll
        for (int b = 0; b < 2; ++b)
#pragma unroll
            for (int m = 0; m < 4; ++m)
#pragma unroll
                for (int n = 0; n < 2; ++n) acc[a][b][m][n] = (f32x4){0.f, 0.f, 0.f, 0.f};
    bf16x8 At[4][2], B0[2][2], B1[2][2];
    const char* cA = (const char*)g.A + (size_t)cur.pm * tstep; const char* cB = (const char*)g.Bt + (size_t)cur.pn * tstep;
    S.a_ready(cur);
    if constexpr (SP2) {
        PG8_STAGE(PG8_SB(0, 0), cB, voffB); PG8_STAGE(PG8_SB(0, 1), cB + hstep, voffB); PG8_STAGE(PG8_SA(0, 0), cA, voffA); PG8_STAGE(PG8_SA(0, 1), cA + hstep, voffA);
        if (wr == 1) PG8_BAR;
        PG8_WAIT_V(2); PG8_BAR;
        PG8_STAGE(PG8_SB(1, 0), cB + kstep, voffB); PG8_STAGE(PG8_SA(1, 0), cA + kstep, voffA); PG8_STAGE(PG8_SB(1, 1), cB + hstep + kstep, voffB);
        PG8_WAIT_V(6); PG8_BAR;
    } else {
        PG8_STAGE(PG8_SB(0, 0), cB, voffB); PG8_STAGE(PG8_SA(0, 0), cA, voffA); PG8_STAGE(PG8_SB(0, 1), cB + hstep, voffB); PG8_STAGE(PG8_SA(0, 1), cA + hstep, voffA);
        if (wr == 1) PG8_BAR;
        PG8_WAIT_V(4); PG8_BAR;
        PG8_STAGE(PG8_SB(1, 0), cB + kstep, voffB); PG8_STAGE(PG8_SA(1, 0), cA + kstep, voffA); PG8_STAGE(PG8_SB(1, 1), cB + hstep + kstep, voffB);
        PG8_WAIT_V(6); PG8_BAR;
    }
    for (;;) {
        const bool has_next = S.next(ui + 1, nxt);
        const char* nA = has_next ? (const char*)g.A + (size_t)nxt.pm * tstep : cA; const char* nB = has_next ? (const char*)g.Bt + (size_t)nxt.pn * tstep : cB;
        for (int t = 0; t < nt; t += 2) {
            const bool last = (t == nt - 2);
            const char* a1 = cA + (size_t)(t + 1) * kstep;
            const char* a2 = last ? nA : cA + (size_t)(t + 2) * kstep; const char* b2 = last ? nB : cB + (size_t)(t + 2) * kstep;
            const char* a3 = a2 + kstep; const char* b3 = b2 + kstep;
            if (last && has_next) S.a_ready(nxt);
            if constexpr (SP2) {
            PG8_LDB(B0, 0, 0); PG8_LDB(B1, 0, 1); PG8_SCHED; PG8_LDA(At, 0, 0); PG8_STAGE(PG8_SA(1, 1), a1 + hstep, voffA);
            PG8_WAIT_V(8); PG8_WAIT_L(0); PG8_BAR; PG8_MMA(0, 0, At, B0); PG8_MMA(0, 1, At, B1); PG8_BAR; PG8_SCHED;
            PG8_LDA(At, 0, 1); PG8_STAGE(PG8_SB(0, 0), b2, voffB); PG8_STAGE(PG8_SB(0, 1), b2 + hstep, voffB); PG8_STAGE(PG8_SA(0, 0), a2, voffA);
            PG8_WAIT_V(8); PG8_WAIT_L(0); PG8_BAR; PG8_MMA(1, 0, At, B0); PG8_MMA(1, 1, At, B1); PG8_BAR; PG8_SCHED;
            PG8_LDB(B0, 1, 0); PG8_LDB(B1, 1, 1); PG8_SCHED; PG8_LDA(At, 1, 0); PG8_STAGE(PG8_SA(0, 1), a2 + hstep, voffA);
            PG8_WAIT_V(8); PG8_WAIT_L(0); PG8_BAR; PG8_MMA(0, 0, At, B0); PG8_MMA(0, 1, At, B1); PG8_BAR; PG8_SCHED;
            PG8_LDA(At, 1, 1); PG8_STAGE(PG8_SB(1, 0), b3, voffB); PG8_STAGE(PG8_SB(1, 1), b3 + hstep, voffB); PG8_STAGE(PG8_SA(1, 0), a3, voffA);
            PG8_WAIT_V(8); PG8_WAIT_L(0); PG8_BAR; PG8_MMA(1, 0, At, B0); PG8_MMA(1, 1, At, B1); PG8_BAR; PG8_SCHED;
            } else {
            PG8_LDB(B0, 0, 0); PG8_SCHED; PG8_LDA(At, 0, 0); PG8_STAGE(PG8_SA(1, 1), a1 + hstep, voffA);
            PG8_WAIT_L(8); PG8_BAR; PG8_WAIT_L(0); PG8_MMA(0, 0, At, B0); PG8_BAR; PG8_SCHED;
            PG8_LDB(B1, 0, 1); PG8_STAGE(PG8_SB(0, 0), b2, voffB);
            PG8_BAR; PG8_WAIT_L(0); PG8_MMA(0, 1, At, B1); PG8_BAR;
            PG8_LDA(At, 0, 1); PG8_STAGE(PG8_SA(0, 0), a2, voffA);
            PG8_BAR; PG8_WAIT_L(0); PG8_MMA(1, 0, At, B0); PG8_BAR; PG8_SCHED;
            PG8_STAGE(PG8_SB(0, 1), b2 + hstep, voffB);
            PG8_WAIT_V(6); PG8_BAR; PG8_MMA(1, 1, At, B1); PG8_BAR;
            PG8_LDB(B0, 1, 0); PG8_SCHED; PG8_LDA(At, 1, 0); PG8_STAGE(PG8_SA(0, 1), a2 + hstep, voffA);
            PG8_WAIT_L(8); PG8_BAR; PG8_WAIT_L(0); PG8_MMA(0, 0, At, B0); PG8_BAR; PG8_SCHED;
            PG8_LDB(B1, 1, 1); PG8_STAGE(PG8_SB(1, 0), b3, voffB);
            PG8_BAR; PG8_WAIT_L(0); PG8_MMA(0, 1, At, B1); PG8_BAR;
            PG8_LDA(At, 1, 1); PG8_STAGE(PG8_SA(1, 0), a3, voffA);
            PG8_BAR; PG8_WAIT_L(0); PG8_MMA(1, 0, At, B0); PG8_BAR; PG8_SCHED;
            PG8_STAGE(PG8_SB(1, 1), b3 + hstep, voffB);
            PG8_WAIT_V(6); PG8_BAR; PG8_MMA(1, 1, At, B1); PG8_BAR;
            }
        }
        if constexpr (ALIGN_EPI) { if (wr == 0) PG8_BAR; }
        if constexpr (!Epi::AFTER_DRAIN) { E(acc, cur, wr, wc, fr, fq); S.done(cur); }
        if (!has_next) break;
#pragma unroll
        for (int a = 0; a < 2; ++a)
#pragma unroll
            for (int b = 0; b < 2; ++b)
#pragma unroll
                for (int m = 0; m < 4; ++m)
#pragma unroll
                    for (int n = 0; n < 2; ++n) acc[a][b][m][n] = (f32x4){0.f, 0.f, 0.f, 0.f};
        cur = nxt; cA = nA; cB = nB; ++ui;
        if constexpr (ALIGN_EPI) { if (wr == 1) PG8_BAR; }
    }
    PG8_WAIT_V(0);
    if constexpr (!ALIGN_EPI) { if (wr == 0) PG8_BAR; }
    PG8_BAR;
    if constexpr (Epi::AFTER_DRAIN) { E.fused(acc, cur, wr, wc, fr, fq, lds, wid, lane); S.done(cur); }
#undef PG8_SA
#undef PG8_SB
#undef PG8_STAGE
#undef PG8_LDA
#undef PG8_LDB
#undef PG8_MMA
#undef PG8_WAIT_V
#undef PG8_WAIT_L
#undef PG8_BAR
#undef PG8_SCHED
}
}

#ifndef PG8_SP2
#define PG8_SP2 true
#endif
#ifndef PG8_ALIGN
#define PG8_ALIGN true
#endif

#include <hip/hip_bf16.h>
#include <cmath>
namespace attn_body {
using bf16=__hip_bfloat16;
using bf16x8=__attribute__((ext_vector_type(8)))short;
using s16x4=__attribute__((ext_vector_type(4)))short;
using f32x16=__attribute__((ext_vector_type(16)))float;
using u32x4=__attribute__((ext_vector_type(4)))unsigned;
constexpr int BATCH=2,NHEAD=16,SEQ=8192,D=64,DM=NHEAD*D;
constexpr int NW=8,QBLK=32,QB=QBLK*NW,KVBLK=64,NQB=SEQ/QB;
constexpr int ATTN_PITCH=DM, ATTN_UNIT_ROWS=QB;
__device__ __forceinline__ int crow(int r,int hi){return (r&3)+8*(r>>2)+4*hi;}
#define SBAR() __builtin_amdgcn_sched_barrier(0)
__device__ __forceinline__ void cmask(f32x16&p0,f32x16&p1,int jb,int qrel,int hi){
  const float NEG=-INFINITY; int kb=64*jb+4*hi;
  #pragma unroll
  for(int r=0;r<16;++r){int kv=kb+(r&3)+8*(r>>2); if(kv>qrel)p0[r]=NEG; if(kv+32>qrel)p1[r]=NEG;}
}

constexpr int NSLOT=3, SLOTB=8192;
constexpr int LDS_K=0, LDS_V=NSLOT*SLOTB, LDS_WS=2*NSLOT*SLOTB, LDS_OST=LDS_WS+NW*64*4, LDS_BYTES=LDS_OST+NW*4096;
constexpr float C2=0.125f*1.4426950408889634f;
__device__ __forceinline__ void glds16(const void*gsrc,unsigned lds_dst){unsigned keep;
  asm volatile("s_mov_b32 %0, m0\n\ts_mov_b32 m0, %2\n\ts_nop 0\n\tglobal_load_lds_dwordx4 %1, off\n\ts_mov_b32 m0, %0":"=&s"(keep):"v"(gsrc),"s"(lds_dst):"memory");}
__device__ __forceinline__ float max3f(float a,float b,float c){float r;asm("v_max3_f32 %0, %1, %2, %3":"=v"(r):"v"(a),"v"(b),"v"(c));return r;}
__device__ __forceinline__ float max2f(float a,float b){float r;asm("v_max_f32_e32 %0, %1, %2":"=v"(r):"v"(a),"v"(b));return r;}
__device__ __forceinline__ float fadd_s(float a,float b){float r;asm("v_add_f32_e32 %0, %1, %2":"=v"(r):"v"(a),"v"(b));return r;}
__device__ __forceinline__ float fsub_s(float a,float b){float r;asm("v_sub_f32_e32 %0, %1, %2":"=v"(r):"v"(a),"v"(b));return r;}
typedef float f32x2_t __attribute__((ext_vector_type(2))); typedef __bf16 bf16x2_t __attribute__((ext_vector_type(2)));
__device__ __forceinline__ unsigned cvtpk_s(float lo,float hi){f32x2_t v={lo,hi};bf16x2_t b=__builtin_convertvector(v,bf16x2_t);return __builtin_bit_cast(unsigned,b);}
#define WAIT_BAR(N) asm volatile("s_waitcnt vmcnt(" #N ") lgkmcnt(0)\n\ts_barrier":::"memory")

__device__ __forceinline__ void qkt(f32x16&p0,f32x16&p1,const char*Kslot,const bf16x8*qr,const f32x16&negm,int r32,int hi){
  const char*kb=Kslot+hi*1024+r32*16;
  #pragma unroll
  for(int d0=0;d0<4;++d0){
    const bf16x8 b0=*reinterpret_cast<const bf16x8*>(kb+d0*2048);
    const bf16x8 b1=*reinterpret_cast<const bf16x8*>(kb+d0*2048+512);
    if(d0==0){p0=__builtin_amdgcn_mfma_f32_32x32x16_bf16(b0,qr[0],negm,0,0,0);p1=__builtin_amdgcn_mfma_f32_32x32x16_bf16(b1,qr[0],negm,0,0,0);}
    else{p0=__builtin_amdgcn_mfma_f32_32x32x16_bf16(b0,qr[d0],p0,0,0,0);p1=__builtin_amdgcn_mfma_f32_32x32x16_bf16(b1,qr[d0],p1,0,0,0);}}
}
typedef __attribute__((address_space(3))) const char* lds_cptr;
typedef short v4i16_t __attribute__((ext_vector_type(4)));
__device__ __forceinline__ void kload8(bf16x8*kf,lds_cptr kp){
  kf[0]=*(const __attribute__((address_space(3))) bf16x8*)(kp);      kf[1]=*(const __attribute__((address_space(3))) bf16x8*)(kp+512);
  kf[2]=*(const __attribute__((address_space(3))) bf16x8*)(kp+2048); kf[3]=*(const __attribute__((address_space(3))) bf16x8*)(kp+2560);
  kf[4]=*(const __attribute__((address_space(3))) bf16x8*)(kp+4096); kf[5]=*(const __attribute__((address_space(3))) bf16x8*)(kp+4608);
  kf[6]=*(const __attribute__((address_space(3))) bf16x8*)(kp+6144); kf[7]=*(const __attribute__((address_space(3))) bf16x8*)(kp+6656);
}
__device__ __forceinline__ void kload2(bf16x8*kf,lds_cptr kp,int j){ kf[2*j]=*(const __attribute__((address_space(3))) bf16x8*)(kp+j*2048); kf[2*j+1]=*(const __attribute__((address_space(3))) bf16x8*)(kp+j*2048+512); }
__device__ __forceinline__ s16x4 vtr(lds_cptr p){ return __builtin_bit_cast(s16x4,__builtin_amdgcn_ds_read_tr16_b64_v4i16((__attribute__((address_space(3))) v4i16_t*)p)); }
__device__ __forceinline__ float rowmax(const f32x16&p0,const f32x16&p1){
  float a=max3f(p0[0],p0[1],p1[0]),b=max3f(p0[2],p0[3],p1[1]);a=max3f(a,p1[2],p1[3]);
  #pragma unroll
  for(int r=4;r<16;r+=4){a=max3f(a,p0[r],p0[r+1]);b=max3f(b,p0[r+2],p0[r+3]);a=max3f(a,p1[r],p1[r+1]);b=max3f(b,p1[r+2],p1[r+3]);}
  const float m=max2f(a,b);
  auto rr=__builtin_amdgcn_permlane32_swap(__float_as_uint(m),__float_as_uint(m),false,false);
  return max2f(__uint_as_float(rr[0]),__uint_as_float(rr[1]));
}
__device__ __forceinline__ void pv(f32x16*o,int vb,bf16x8 pa0,bf16x8 pa1,bf16x8 pa2,bf16x8 pa3){
  #pragma unroll
  for(int d0=0;d0<2;++d0){s16x4 lo[4],hi[4];
    #pragma unroll
    for(int ks=0;ks<4;++ks){
      asm volatile("ds_read_b64_tr_b16 %0,%1 offset:%c2":"=&v"(lo[ks]):"v"(vb),"i"(d0*4096+ks*1024):"memory");
      asm volatile("ds_read_b64_tr_b16 %0,%1 offset:%c2":"=&v"(hi[ks]):"v"(vb),"i"(d0*4096+ks*1024+512):"memory");}
    asm volatile("s_waitcnt lgkmcnt(0)":::"memory");SBAR();
    #define PK(k) (bf16x8){lo[k][0],lo[k][1],lo[k][2],lo[k][3],hi[k][0],hi[k][1],hi[k][2],hi[k][3]}
    o[d0]=__builtin_amdgcn_mfma_f32_32x32x16_bf16(pa0,PK(0),o[d0],0,0,0);
    o[d0]=__builtin_amdgcn_mfma_f32_32x32x16_bf16(pa1,PK(1),o[d0],0,0,0);
    o[d0]=__builtin_amdgcn_mfma_f32_32x32x16_bf16(pa2,PK(2),o[d0],0,0,0);
    o[d0]=__builtin_amdgcn_mfma_f32_32x32x16_bf16(pa3,PK(3),o[d0],0,0,0);
    #undef PK
  }
}

#ifndef ATTN_STORE16
#define ATTN_STORE16(p,v) (*(u32x4*)(p)=(v))
#endif
template<int THRL> __device__ __forceinline__ void attn_unit(const bf16*Qbase,const int QP,const bf16*__restrict__ Kh,const bf16*__restrict__ Vh,const int KP,const int NT,bf16*Obase,const int OP,char*shm){
  const int tid=threadIdx.x,lane=tid&63,r32=lane&31,hi=lane>>5; const int wid=__builtin_amdgcn_readfirstlane(tid>>6);
  const bf16*Qw=Qbase+(long)(wid*QBLK)*QP;
  const unsigned lds0=(unsigned)(uintptr_t)shm;
  float*wsf=(float*)(shm+LDS_WS)+wid*64;
  const bf16*ksrc=Kh+(long)lane*KP+wid*8;
  const bf16*vsrc=Vh+(long)(16*(wid&3)+(lane>>2))*KP+(wid>>2)*32+(lane&3)*8;
  const unsigned kdst=lds0+LDS_K+wid*1024, vdst=lds0+LDS_V+wid*1024;
  #define DMA_K(t,slot) glds16(ksrc+(long)(t)*KVBLK*KP,(unsigned)__builtin_amdgcn_readfirstlane(kdst+(slot)))
  #define DMA_V(t,slot) glds16(vsrc+(long)(t)*KVBLK*KP,(unsigned)__builtin_amdgcn_readfirstlane(vdst+(slot)))
  const int vb0=(int)(lds0+LDS_V)+((lane>>4)&1)*32+(lane&3)*8+(4*hi+((lane&15)>>2))*64;
  const char*Kbase=shm+LDS_K; bf16x8 kf[8];
  const lds_cptr shm3=(lds_cptr)shm; const lds_cptr kp0=shm3+LDS_K+hi*1024+r32*16; const lds_cptr vp0=shm3+LDS_V+((lane>>4)&1)*32+(lane&3)*8+(4*hi+((lane&15)>>2))*64;
  DMA_K(0,0);DMA_V(0,0);DMA_K(1,SLOTB);
  bf16x8 qr[4];
  #pragma unroll
  for(int d0=0;d0<4;++d0)qr[d0]=*reinterpret_cast<const bf16x8*>(&Qw[(long)r32*QP+d0*16+hi*8]);
  float mhat=0.f,l_reg=0.f;f32x16 o[2];o[0]=f32x16{};o[1]=f32x16{};f32x16 negm=f32x16{};asm volatile("":"+v"(negm));
  #define CMASK(P0,P1,t) do{}while(0)
  bool resc=false;
  #define START(P0,P1) do{ const float rm=rowmax(P0,P1); resc=false; \
    { const float dl=rm; mhat=fadd_s(mhat,dl); \
      _Pragma("unroll") for(int r=0;r<16;++r){P0[r]=fsub_s(P0[r],dl);P1[r]=fsub_s(P1[r],dl);} \
      _Pragma("unroll") for(int r=0;r<16;++r)negm[r]=-mhat; asm volatile("":"+v"(negm)); } \
    _Pragma("unroll") for(int r=0;r<16;++r)P0[r]=__builtin_amdgcn_exp2f(P0[r]); }while(0)
  #define RESC() do{ if(resc){ asm volatile("s_waitcnt lgkmcnt(0)":::"memory"); \
      _Pragma("unroll") for(int d_=0;d_<2;++d_) _Pragma("unroll") for(int r=0;r<16;++r)o[d_][r]*=wsf[crow(r,hi)]; } }while(0)
  f32x16 pA0,pA1,pB0,pB1;
  int sl_prev=0,sl_cur=0,sl_next=SLOTB;
  #define ROT() do{sl_prev=sl_cur;sl_cur=sl_next;sl_next=(sl_next==(NSLOT-1)*SLOTB)?0:sl_next+SLOTB;}while(0)
  DMA_K(2,2*SLOTB);
  WAIT_BAR(3);
  qkt(pA0,pA1,Kbase,qr,negm,r32,hi);asm volatile("s_nop 15\n\ts_nop 7":"+v"(pA0),"+v"(pA1));CMASK(pA0,pA1,0);
  START(pA0,pA1);
  _Pragma("unroll") for(int r=0;r<16;++r)pA1[r]=__builtin_amdgcn_exp2f(pA1[r]);
  WAIT_BAR(0);
  DMA_K(3,0);DMA_V(1,SLOTB);
  ROT();
  kload8(kf,kp0+sl_cur);
  WAIT_BAR(2);
  s16x4 vlo[8],vhi[8]; u32x4 pw0,pw1,pw2,pw3;
  #define PKW(P,B) cvtpk_s(P[B],P[B+1])
  #define PAF(k) __builtin_bit_cast(bf16x8,pw##k)
  #define VFR(i) (bf16x8){vlo[i][0],vlo[i][1],vlo[i][2],vlo[i][3],vhi[i][0],vhi[i][1],vhi[i][2],vhi[i][3]}
  #define PIN(x) asm volatile("":"+v"(x))
  #define MX3(a,b,c) __builtin_fmaxf(__builtin_fmaxf((a),(b)),(c))
  #define GAPA(MF,A0,A1,A2,A3,W0,W1,PW) do{ MF; sacc+=A0; sacc+=A1; sacc+=A2; sacc+=A3; PIN(sacc); W0; W1; PIN(PW); SBAR(); }while(0)
  #define EX(v) __builtin_amdgcn_exp2f(v)
  #define GAPB(MF,X,B) do{ MF; X[B]=EX(X[B]); X[B+1]=EX(X[B+1]); X[B+2]=EX(X[B+2]); X[B+3]=EX(X[B+3]); PIN(X); SBAR(); }while(0)
  #define VRD(i) do{ vlo[i]=vtr(vp_+(((i)>>2)*4096+((i)&3)*1024)); vhi[i]=vtr(vp_+(((i)>>2)*4096+((i)&3)*1024+512)); }while(0)
  #define KRD(G,j) do{ if(G){ kload2(kf,kp0+sl_next,j); SBAR(); } }while(0)
  #define STEP(C0,C1,P0,P1,t,GK,GV,GL) do{ SBAR(); \
    const lds_cptr vp_=vp0+sl_prev; \
    VRD(0); SBAR(); float sacc=(P0[0]+P0[1]); \
    GAPA(C0=__builtin_amdgcn_mfma_f32_32x32x16_bf16(kf[0],qr[0],negm,0,0,0), P0[2],P0[3],P0[4],P0[5],     pw0[0]=PKW(P0,0), pw0[1]=PKW(P0,2), pw0); \
    VRD(4); SBAR(); GAPA(C1=__builtin_amdgcn_mfma_f32_32x32x16_bf16(kf[1],qr[0],negm,0,0,0), P0[6],P0[7],P0[8],P0[9],     pw0[2]=PKW(P0,4), pw0[3]=PKW(P0,6), pw0); \
    VRD(1); SBAR(); GAPA(C0=__builtin_amdgcn_mfma_f32_32x32x16_bf16(kf[2],qr[1],C0,0,0,0),   P0[10],P0[11],P0[12],P0[13], pw1[0]=PKW(P0,8), pw1[1]=PKW(P0,10), pw1); \
    VRD(5); SBAR(); GAPA(C1=__builtin_amdgcn_mfma_f32_32x32x16_bf16(kf[3],qr[1],C1,0,0,0),   P0[14],P0[15],P1[0],P1[1],   pw1[2]=PKW(P0,12),pw1[3]=PKW(P0,14), pw1); \
    VRD(2); SBAR(); GAPA(C0=__builtin_amdgcn_mfma_f32_32x32x16_bf16(kf[4],qr[2],C0,0,0,0),   P1[2],P1[3],P1[4],P1[5],     pw2[0]=PKW(P1,0), pw2[1]=PKW(P1,2), pw2); \
    VRD(6); SBAR(); GAPA(C1=__builtin_amdgcn_mfma_f32_32x32x16_bf16(kf[5],qr[2],C1,0,0,0),   P1[6],P1[7],P1[8],P1[9],     pw2[2]=PKW(P1,4), pw2[3]=PKW(P1,6), pw2); \
    VRD(3); SBAR(); GAPA(C0=__builtin_amdgcn_mfma_f32_32x32x16_bf16(kf[6],qr[3],C0,0,0,0),   P1[10],P1[11],P1[12],P1[13], pw3[0]=PKW(P1,8), pw3[1]=PKW(P1,10), pw3); \
    VRD(7); SBAR(); GAPA(C1=__builtin_amdgcn_mfma_f32_32x32x16_bf16(kf[7],qr[3],C1,0,0,0),   P1[14],P1[15],0.f,0.f,       pw3[2]=PKW(P1,12),pw3[3]=PKW(P1,14), pw3); \
    l_reg+=sacc; \
    if(GK){DMA_K((t)+3,sl_cur);} if(GV){DMA_V((t)+1,sl_next);} \
    CMASK(C0,C1,t); \
    { float a=MX3(C0[0],C0[1],C1[0]),b=MX3(C0[2],C0[3],C1[1]); a=MX3(a,C1[2],C1[3]); \
      _Pragma("unroll") for(int r=4;r<16;r+=4){a=MX3(a,C0[r],C0[r+1]);b=MX3(b,C0[r+2],C0[r+3]);a=MX3(a,C1[r],C1[r+1]);b=MX3(b,C1[r+2],C1[r+3]);} \
      float rm=__builtin_fmaxf(a,b); { auto rr=__builtin_amdgcn_permlane32_swap(__float_as_uint(rm),__float_as_uint(rm),false,false); rm=__builtin_fmaxf(__uint_as_float(rr[0]),__uint_as_float(rr[1])); } \
      resc=false; \
      if(__builtin_expect(__any(rm>(float)THRL),0)){ const float dl=__builtin_fmaxf(rm,0.f); mhat+=dl; \
        _Pragma("unroll") for(int r=0;r<16;++r){C0[r]-=dl;C1[r]-=dl;} \
        _Pragma("unroll") for(int r=0;r<16;++r)negm[r]=-mhat; asm volatile("":"+v"(negm)); \
        const float f=__builtin_amdgcn_exp2f(-dl); l_reg*=f; if(hi==0)wsf[r32]=f; resc=true; } } \
    SBAR(); \
    GAPB(o[0]=__builtin_amdgcn_mfma_f32_32x32x16_bf16(PAF(0),VFR(0),o[0],0,0,0), C0,0); \
    GAPB(o[1]=__builtin_amdgcn_mfma_f32_32x32x16_bf16(PAF(0),VFR(4),o[1],0,0,0), C0,4); \
    KRD(GL,0); GAPB(o[0]=__builtin_amdgcn_mfma_f32_32x32x16_bf16(PAF(1),VFR(1),o[0],0,0,0), C0,8); \
    KRD(GL,1); GAPB(o[1]=__builtin_amdgcn_mfma_f32_32x32x16_bf16(PAF(1),VFR(5),o[1],0,0,0), C0,12); \
    KRD(GL,2); GAPB(o[0]=__builtin_amdgcn_mfma_f32_32x32x16_bf16(PAF(2),VFR(2),o[0],0,0,0), C1,0); \
    KRD(GL,3); GAPB(o[1]=__builtin_amdgcn_mfma_f32_32x32x16_bf16(PAF(2),VFR(6),o[1],0,0,0), C1,4); \
    GAPB(o[0]=__builtin_amdgcn_mfma_f32_32x32x16_bf16(PAF(3),VFR(3),o[0],0,0,0), C1,8); \
    GAPB(o[1]=__builtin_amdgcn_mfma_f32_32x32x16_bf16(PAF(3),VFR(7),o[1],0,0,0), C1,12); \
    }while(0)
  int t=1;
  #undef CMASK
  #define CMASK(P0,P1,t) do{}while(0)
  for(;t+5<NT;t+=2){
    STEP(pB0,pB1,pA0,pA1,t,true,true,true);     WAIT_BAR(2); RESC(); ROT();
    STEP(pA0,pA1,pB0,pB1,t+1,true,true,true);   WAIT_BAR(2); RESC(); ROT();
  }
  #undef CMASK
  #define CMASK(P0,P1,t) do{}while(0)
  #define ENDW(tt) do{ if((tt)+3<NT){WAIT_BAR(2);} else if((tt)+2<NT){WAIT_BAR(1);} else {WAIT_BAR(0);} }while(0)
  for(;t+1<NT;t+=2){
    STEP(pB0,pB1,pA0,pA1,t,(t+3<NT),(t+1<NT),(t+1<NT));       ENDW(t);   RESC(); ROT();
    STEP(pA0,pA1,pB0,pB1,t+1,(t+4<NT),(t+2<NT),(t+2<NT));     ENDW(t+1); RESC(); ROT();
  }
  STEP(pB0,pB1,pA0,pA1,NT-1,false,false,false); RESC();
  { float sacc=pB0[0]+pB0[1]; _Pragma("unroll") for(int r=2;r<16;++r)sacc+=pB0[r]; _Pragma("unroll") for(int r=0;r<16;++r)sacc+=pB1[r]; l_reg+=sacc;
    pw0=(u32x4){PKW(pB0,0),PKW(pB0,2),PKW(pB0,4),PKW(pB0,6)};pw1=(u32x4){PKW(pB0,8),PKW(pB0,10),PKW(pB0,12),PKW(pB0,14)};pw2=(u32x4){PKW(pB1,0),PKW(pB1,2),PKW(pB1,4),PKW(pB1,6)};pw3=(u32x4){PKW(pB1,8),PKW(pB1,10),PKW(pB1,12),PKW(pB1,14)};
    SBAR(); pv(o,vb0+sl_cur,PAF(0),PAF(1),PAF(2),PAF(3)); }
  #undef PKW
  #undef PAF
  #undef VFR
  #undef PIN
  #undef MX3
  #undef GAPA
  #undef GAPB
  #undef EX
  #undef VRD
  #undef KRD
  #undef STEP
  #undef ENDW
  {auto rr=__builtin_amdgcn_permlane32_swap(__float_as_uint(l_reg),__float_as_uint(l_reg),false,false);l_reg=__uint_as_float(rr[0])+__uint_as_float(rr[1]);}
  if(hi==0)wsf[32+r32]=l_reg;asm volatile("s_waitcnt lgkmcnt(0)":::"memory");
  float rli[16];
  #pragma unroll
  for(int r=0;r<16;++r)rli[r]=__builtin_amdgcn_rcpf(wsf[32+crow(r,hi)]);
  bf16*Ow=Obase+(long)(wid*QBLK)*OP;
  { bf16*stg=(bf16*)(shm+LDS_OST)+wid*2048;
    #pragma unroll
    for(int r=0;r<16;++r){const int orow=crow(r,hi);
      #pragma unroll
      for(int d0=0;d0<2;++d0)stg[orow*64+d0*32+r32]=__float2bfloat16(o[d0][r]*rli[r]);}
    asm volatile("s_waitcnt lgkmcnt(0)":::"memory");
    #pragma unroll
    for(int i=0;i<4;++i){const int row=i*8+(lane>>3),ch=lane&7; const u32x4 v=*(const u32x4*)(stg+row*64+ch*8); ATTN_STORE16(Ow+(long)row*OP+ch*8,v);} }
  asm volatile("s_waitcnt lgkmcnt(0)\n\ts_barrier":::"memory");
  #undef DMA_K
  #undef DMA_V
  #undef CMASK
  #undef START
  #undef RESC
  #undef ROT
}
constexpr int ATTN_LDS_BYTES=LDS_BYTES;
#undef SBAR
#undef WAIT_BAR
}

constexpr int DM = 1024, NB = 2, SEQ = 8192, CTXL = 256, SB = SEQ + CTXL, MT = NB * SB, DEPTH = 2;
constexpr int NIN = 2576, NWIN = 2560, NP1 = 1792;
constexpr int C_MQ = 0, C_MK = 256, C_MV = 512, C_MO = 768, C_AQ = 1024, C_AK = 1536, C_AV = 1664;
constexpr int NE = 16, FF = 2816, ROWS_E = 2304, NT1 = 22;
constexpr int NFFT = 16384;
constexpr float LN_EPS = 1e-5f, RMS_EPS = 1e-6f, ALPHA = 1.41421356237309515f;
constexpr int SST = 4224;
constexpr int NPOS = 66;

constexpr size_t MiB = 1u << 20;
constexpr size_t WS_CTL = 0, CTL_ZERO_BYTES = 64 * 1024;
constexpr size_t WS_MODP = 1 * MiB, WS_MOD = 4 * MiB, WS_WG = 5 * MiB, WS_TW = 6 * MiB, WS_HID = 7 * MiB, WS_TAPC = 12 * MiB;
constexpr size_t WS_WINT = 16 * MiB, WS_WOUTT = 28 * MiB, WS_HF = 32 * MiB, WS_W1T = 160 * MiB, WS_W2T = 512 * MiB, WS_HN = 688 * MiB;
constexpr size_t WS_R = 722 * MiB;
constexpr size_t WS_P1 = WS_R, WS_HY = WS_R + 58 * MiB, WS_SLOC = WS_R + 108 * MiB, WS_SCAR = WS_R + 126 * MiB, WS_Y = WS_R + 144 * MiB, WS_MIX = WS_R + 178 * MiB;
constexpr size_t WS_Z1 = WS_R + 250 * MiB;
constexpr size_t WS_XG = WS_R, WS_ACT = WS_R + 72 * MiB, WS_YE = WS_R + 270 * MiB;
constexpr size_t WS_XS = WS_R + 414 * MiB, WS_AFF = WS_XS + 66 * MiB, WS_GT = WS_AFF + 2 * MiB, WS_INV = WS_GT + 2 * MiB, WS_IDX = WS_INV + 2 * MiB, WS_VAL = WS_IDX + 1 * MiB, WS_END = WS_VAL + 1 * MiB;
static_assert(WS_END <= 1408 * MiB, "workspace");
static_assert((size_t)MT * NP1 * 2 <= 58 * MiB && (size_t)NB * 768 * SB * 4 <= 50 * MiB && (size_t)16 * NPOS * SST * 4 <= 18 * MiB && (size_t)MT * DM * 2 <= 34 * MiB && (size_t)MT * DM * 4 <= 66 * MiB, "mix region");
static_assert((size_t)NE * ROWS_E * DM * 2 <= 72 * MiB && (size_t)NE * ROWS_E * FF * 2 <= 198 * MiB && (size_t)NE * ROWS_E * DM * 4 <= 144 * MiB, "moe region");
static_assert(WS_MIX + 66 * MiB <= WS_XS, "mix region end");

constexpr int RING_OFF = 0;
constexpr int LDSX_OFF = 139264;
constexpr int LDSCTL_OFF = 143360, MISC_OFF = LDSCTL_OFF + 320;
constexpr int LDS_BYTES = 147456;
constexpr int NWAVES = 8, NTHR = 512;

#define GAS __attribute__((address_space(1)))
#define LAS __attribute__((address_space(3)))
typedef unsigned short bf16;
typedef unsigned v4u __attribute__((ext_vector_type(4)));
typedef float f32x4 __attribute__((ext_vector_type(4)));
typedef short bf16x8 __attribute__((ext_vector_type(8)));
typedef GAS unsigned gu32;
typedef GAS unsigned long long gu64;
#define RLX_AGENT __ATOMIC_RELAXED, __HIP_MEMORY_SCOPE_AGENT
#define LDS_WAIT() asm volatile("s_waitcnt lgkmcnt(0)" ::: "memory")
#define VM_WAIT() asm volatile("s_waitcnt vmcnt(0)" ::: "memory")
__device__ __forceinline__ unsigned long long rt() { return __builtin_amdgcn_s_memrealtime(); }
__device__ __forceinline__ unsigned f2bf(float f) { unsigned u = __builtin_bit_cast(unsigned, f); return (u + 0x7fffu + ((u >> 16) & 1u)) >> 16; }
__device__ __forceinline__ unsigned pk2(float lo, float hi) { return f2bf(lo) | (f2bf(hi) << 16); }

#define XB_TMO      128
#define XB_XCNT(j)  (256  + 64 * (j))
#define XB_XSUB(j)  (1280 + 64 * (j))
#define XB_XGEN(j)  (2304 + 64 * (j))
#define XB_TOP      3328
#define XB_TOPGEN   3392
#define XCD_BAR_WORDS 3456
#define XB_SPIN_CAP (1u << 18)

__device__ __forceinline__ unsigned xb_ld(unsigned* p)              { return __hip_atomic_load(p, __ATOMIC_RELAXED, __HIP_MEMORY_SCOPE_AGENT); }
__device__ __forceinline__ unsigned xb_add(unsigned* p, unsigned v) { return __hip_atomic_fetch_add(p, v, __ATOMIC_RELAXED, __HIP_MEMORY_SCOPE_AGENT); }
__device__ __forceinline__ unsigned xb_xcc_id() { return (unsigned)__builtin_amdgcn_s_getreg((3 << 11) | 20) & 0xFu; }
#define XB_SPIN(cond, bar) do { unsigned _sp = 0; while (cond) { __builtin_amdgcn_s_sleep(1); \
    if ((++_sp & 255u) == 0u) { if (xb_ld(&(bar)[XB_TMO])) break; if (_sp > XB_SPIN_CAP) { atomicAdd(&(bar)[XB_TMO], 1u); break; } } } } while (0)

struct XcdBarrier {
    unsigned* bar; unsigned x;
    volatile LAS unsigned* st;
};

__device__ __forceinline__ XcdBarrier xcd_barrier_post(unsigned* bar, volatile LAS unsigned* st) {
    XcdBarrier b; b.bar = bar; b.x = xb_xcc_id(); b.st = st;
    if (threadIdx.x == 0) (void)xb_add(&bar[XB_XCNT(b.x)], 1u);
    return b;
}
__device__ __forceinline__ void xcd_barrier_complete(unsigned* bar, unsigned x, unsigned& nloc, unsigned& nx) {
    const unsigned G = gridDim.x * gridDim.y * gridDim.z;
    unsigned sum, cnt, mine, sp = 0u;
    for (;;) {
        sum = 0u; cnt = 0u; mine = 0u;
#pragma unroll
        for (unsigned j = 0; j < 16; ++j) { const unsigned c = xb_ld(&bar[XB_XCNT(j)]); sum += c; cnt += (c > 0u) ? 1u : 0u; mine = (j == x) ? c : mine; }
        if (sum == G) break;
        __builtin_amdgcn_s_sleep(1);
        if ((++sp & 255u) == 0u) { if (xb_ld(&bar[XB_TMO])) break; if (sp > XB_SPIN_CAP) { atomicAdd(&bar[XB_TMO], 1u); break; } }
    }
    nloc = mine > 0u ? mine : 1u; nx = cnt > 0u ? cnt : 1u;
}

__device__ __forceinline__ void xcd_barrier(const XcdBarrier& b) {
    asm volatile("s_waitcnt vmcnt(0)" ::: "memory");
    __syncthreads();
    if (threadIdx.x == 0) {
        unsigned* bar = b.bar;
        __builtin_amdgcn_s_waitcnt(0);
        unsigned nloc = b.st[0], nx = b.st[1];
        if (nloc == 0u) { xcd_barrier_complete(bar, b.x, nloc, nx); b.st[0] = nloc; b.st[1] = nx; }
        const unsigned old = xb_add(&bar[XB_XSUB(b.x)], 1u);
        const unsigned gen = old / nloc;
        if (old + 1u == (gen + 1u) * nloc) {
            __builtin_amdgcn_fence(__ATOMIC_RELEASE, "agent");
            asm volatile("s_waitcnt vmcnt(0)" ::: "memory");
            const unsigned og = xb_add(&bar[XB_TOP], 1u);
            const unsigned tg = og / nx;
            if (og + 1u == (tg + 1u) * nx) xb_add(&bar[XB_TOPGEN], 1u);
            else XB_SPIN(xb_ld(&bar[XB_TOPGEN]) == tg, bar);
            __builtin_amdgcn_fence(__ATOMIC_ACQUIRE, "agent");
            xb_add(&bar[XB_XGEN(b.x)], 1u);
            asm volatile("s_waitcnt vmcnt(0)" ::: "memory");
        } else {
            XB_SPIN(xb_ld(&bar[XB_XGEN(b.x)]) == gen, bar);
            __builtin_amdgcn_fence(__ATOMIC_ACQUIRE, "agent");
            asm volatile("s_waitcnt vmcnt(0)" ::: "memory");
        }
    }
    __syncthreads();
}


typedef float f32x16 __attribute__((ext_vector_type(16)));
typedef float f32x2 __attribute__((ext_vector_type(2)));

struct Args { const float* in[32]; float* out; unsigned char* ws; int ph_lo, ph_hi; };

struct Fr { LAS unsigned char* lds; int tid, lane, wave, G, bid; };

__device__ __forceinline__ float wave_sum(float v) {
#pragma unroll
    for (int o = 1; o < 64; o <<= 1) v += __shfl_xor(v, o);
    return v;
}
__device__ __forceinline__ float wave_max(float v) {
#pragma unroll
    for (int o = 1; o < 64; o <<= 1) v = fmaxf(v, __shfl_xor(v, o));
    return v;
}
__device__ __forceinline__ int wave_sum_i(int v) {
#pragma unroll
    for (int o = 1; o < 64; o <<= 1) v += __shfl_xor(v, o);
    return v;
}
__device__ __forceinline__ float bf2f(unsigned short b) { return __uint_as_float(((unsigned)b) << 16); }
__device__ __forceinline__ float bflo(unsigned w) { return __uint_as_float(w << 16); }
__device__ __forceinline__ float bfhi(unsigned w) { return __uint_as_float(w & 0xffff0000u); }
__device__ __forceinline__ float sigmoidf_(float x) { return 1.f / (1.f + __expf(-x)); }
__device__ __forceinline__ float siluf_(float x) { return x / (1.f + __expf(-x)); }
#define BSYNC() __syncthreads()

template <int MODE> __device__ __forceinline__ int tr_row(int n) {
    if (MODE == 0) return n;
    if (MODE == 1) return n < 1024 ? n : (n < 1040 ? -1 : (n < NIN ? n - 16 : -1));
    if (MODE == 2) return (n >> 7) * 256 + (n & 127);
    return (n >> 7) * 256 + 128 + (n & 127);
}
template <int MODE> __device__ __forceinline__ void tr_item(const float* __restrict__ W, int K, int N, bf16* WT, LAS float* scr, int item, int lane) {
    const int nblk = (N + 31) / 32, kb = item / nblk, nb = item % nblk, k0 = 64 * kb, n0 = 32 * nb;
    const int nn = n0 + (lane & 31);
#pragma unroll 8
    for (int i = 0; i < 32; ++i) { const int kk = 2 * i + (lane >> 5); scr[kk * 33 + (lane & 31)] = (nn < N) ? W[(size_t)(k0 + kk) * N + nn] : 0.f; }
    LDS_WAIT(); asm volatile("" ::: "memory");
    const int c = lane & 7;
#pragma unroll
    for (int j = 0; j < 4; ++j) { const int n = (lane >> 3) + 8 * j; const LAS float* s = scr + (8 * c) * 33 + n;
        v4u o; o.x = pk2(s[0 * 33], s[1 * 33]); o.y = pk2(s[2 * 33], s[3 * 33]); o.z = pk2(s[4 * 33], s[5 * 33]); o.w = pk2(s[6 * 33], s[7 * 33]);
        const int row = (n0 + n < N) ? tr_row<MODE>(n0 + n) : -1;
        if (row >= 0) *(GAS v4u*)(WT + (size_t)row * K + k0 + 8 * c) = o; }
    LDS_WAIT(); asm volatile("" ::: "memory");
}

__device__ __forceinline__ void ph_convert(const Fr& F, const Args& A) {
    unsigned char* ws = A.ws;
    LAS float* scr = (LAS float*)(F.lds + RING_OFF + F.wave * 16384);
    const int gw = F.bid * NWAVES + F.wave, NGW = F.G * NWAVES;
    const int gid = F.bid * NTHR + F.tid, NG = F.G * NTHR;
    constexpr int I_WIN = 16 * 81, I_WOUT = 16 * 32, I_GU = 16 * 88, I_DN = 44 * 32;
    constexpr int S_A = DEPTH * I_WIN, S_B = S_A + DEPTH * I_WOUT, S_C = S_B + DEPTH * NE * I_GU, S_D = S_C + DEPTH * NE * I_GU, S_E = S_D + DEPTH * NE * I_DN;
    for (int it = gw; it < S_E; it += NGW) {
        if (it < S_A) { const int l = it / I_WIN, r = it % I_WIN; tr_item<1>(A.in[6] + (size_t)l * DM * NIN, DM, NIN, (bf16*)(ws + WS_WINT) + (size_t)l * NWIN * DM, scr, r, F.lane); }
        else if (it < S_B) { const int q = it - S_A, l = q / I_WOUT, r = q % I_WOUT; tr_item<0>(A.in[22] + (size_t)l * DM * DM, DM, DM, (bf16*)(ws + WS_WOUTT) + (size_t)l * DM * DM, scr, r, F.lane); }
        else if (it < S_C) { const int q = it - S_B, le = q / I_GU, r = q % I_GU; tr_item<2>(A.in[27] + (size_t)le * DM * FF, DM, FF, (bf16*)(ws + WS_W1T) + (size_t)le * (2 * FF) * DM, scr, r, F.lane); }
        else if (it < S_D) { const int q = it - S_C, le = q / I_GU, r = q % I_GU; tr_item<3>(A.in[28] + (size_t)le * DM * FF, DM, FF, (bf16*)(ws + WS_W1T) + (size_t)le * (2 * FF) * DM, scr, r, F.lane); }
        else { const int q = it - S_D, le = q / I_DN, r = q % I_DN; tr_item<0>(A.in[29] + (size_t)le * FF * DM, FF, DM, (bf16*)(ws + WS_W2T) + (size_t)le * DM * FF, scr, r, F.lane); }
    }
    float* WG = (float*)(ws + WS_WG);
    for (int i = gid; i < DEPTH * 16 * DM; i += NG) { const int l = i / (16 * DM), g = (i / DM) % 16, k = i % DM; WG[i] = A.in[6][((size_t)l * DM + k) * NIN + 1024 + g]; }
    f32x2* TW = (f32x2*)(ws + WS_TW);
    for (int i = gid; i < NFFT / 2; i += NG) { float s, c; sincospif((float)i * (1.f / 8192.f), &s, &c); TW[i] = (f32x2){c, -s}; }
    float* MODP = (float*)(ws + WS_MODP);
    for (int it = gw; it < DEPTH * 16 * 24; it += NGW) {
        const int l = it / (16 * 24), kc = (it / 24) % 16, nb = it % 24;
        const int k = kc * 64 + F.lane;
        const float s0 = siluf_(A.in[1][k]), s1 = siluf_(A.in[1][DM + k]), s2 = siluf_(A.in[3][k]);
        f32x4 a0 = {0.f, 0.f, 0.f, 0.f}, a1 = a0, a2 = a0;
        const float* wp = A.in[4] + ((size_t)l * DM + kc * 64) * 6144 + nb * 256 + 4 * F.lane;
#pragma unroll 4
        for (int kk = 0; kk < 64; ++kk) { const f32x4 w = *(const f32x4*)(wp + (size_t)kk * 6144);
            const float t0 = __shfl(s0, kk), t1 = __shfl(s1, kk), t2 = __shfl(s2, kk); a0 += w * t0; a1 += w * t1; a2 += w * t2; }
        float* o = MODP + ((size_t)(l * 3) * 16 + kc) * 6144 + nb * 256 + 4 * F.lane;
        *(f32x4*)(o) = a0; *(f32x4*)(o + (size_t)16 * 6144) = a1; *(f32x4*)(o + (size_t)32 * 6144) = a2;
    }
    float* HID = (float*)(ws + WS_HID);
    for (int it = gw; it < DEPTH * SB; it += NGW) {
        const int l = it / SB, pos = it % SB; const int n = pos < SEQ ? SEQ : CTXL, i = pos < SEQ ? pos : pos - SEQ;
        const int k = F.lane; float feat = 0.f;
        if (k == 0) feat = (float)i / (float)n;
        else if (k <= 16) feat = cospif((float)(2 * i * k) / (float)n);
        else if (k <= 32) feat = sinpif((float)(2 * i * (k - 16)) / (float)n);
        const float* w1 = A.in[15] + (size_t)l * 33 * 64; const float* w2 = A.in[18] + (size_t)l * 64 * 64;
        float acc = A.in[16][l * 64 + k];
#pragma unroll
        for (int q = 0; q < 33; ++q) acc += __shfl(feat, q) * w1[q * 64 + k];
        const float h1 = sinf(A.in[17][l * 128 + k] * acc);
        float acc2 = A.in[19][l * 64 + k];
#pragma unroll 8
        for (int q = 0; q < 64; ++q) acc2 += __shfl(h1, q) * w2[q * 64 + k];
        HID[((size_t)l * SB + pos) * 64 + k] = sinf(A.in[17][l * 128 + 64 + k] * acc2);
    }
}

__device__ __forceinline__ int fphys(int i) { return i + ((i >> 6) << 2); }
__device__ __forceinline__ f32x2 cmul(f32x2 a, f32x2 b) { return (f32x2){a.x * b.x - a.y * b.y, a.x * b.y + a.y * b.x}; }
__device__ __forceinline__ f32x2 cmulc(f32x2 a, f32x2 b) { return (f32x2){a.x * b.x + a.y * b.y, a.y * b.x - a.x * b.y}; }
template <int R, bool INV> __device__ __forceinline__ void fft_pass(LAS f32x2* d, const f32x2* __restrict__ TW, const int s, const int tid) {
    constexpr int E = 1 << R;
    const int lq = 14 - s - R, q = 1 << lq;
#pragma unroll 1
    for (int w = tid; w < (NFFT >> R); w += NTHR) {
        const int grp = w >> lq, pos = w & (q - 1);
        const int base = (grp << (lq + R)) + pos;
        f32x2 x[E];
#pragma unroll
        for (int j = 0; j < E; ++j) x[j] = d[fphys(base + j * q)];
#pragma unroll
        for (int rr = 0; rr < R; ++rr) {
            const int r = INV ? (R - 1 - rr) : rr;
            const int hj = E >> (r + 1);
#pragma unroll
            for (int j = 0; j < E; ++j) {
                if ((j & hj) == 0) {
                    const int pj = (j & (hj - 1)) * q + pos;
                    const f32x2 tw = TW[(pj << (s + r)) & (NFFT / 2 - 1)];
                    const f32x2 a = x[j], b = x[j + hj];
                    if (!INV) { x[j] = a + b; x[j + hj] = cmul(a - b, tw); }
                    else { const f32x2 v = cmulc(b, tw); x[j] = a + v; x[j + hj] = a - v; }
                }
            }
        }
#pragma unroll
        for (int j = 0; j < E; ++j) d[fphys(base + j * q)] = x[j];
    }
}
__device__ __forceinline__ void fft_fwd(LAS f32x2* d, const f32x2* TW, int tid) {
    fft_pass<3, false>(d, TW, 0, tid); BSYNC(); fft_pass<3, false>(d, TW, 3, tid); BSYNC(); fft_pass<3, false>(d, TW, 6, tid); BSYNC(); fft_pass<3, false>(d, TW, 9, tid); BSYNC(); fft_pass<2, false>(d, TW, 12, tid); BSYNC();
}
__device__ __forceinline__ void fft_inv(LAS f32x2* d, const f32x2* TW, int tid) {
    fft_pass<2, true>(d, TW, 12, tid); BSYNC(); fft_pass<3, true>(d, TW, 9, tid); BSYNC(); fft_pass<3, true>(d, TW, 6, tid); BSYNC(); fft_pass<3, true>(d, TW, 3, tid); BSYNC(); fft_pass<3, true>(d, TW, 0, tid); BSYNC();
}

__device__ __forceinline__ float block_sum(float v, LAS float* red, int wave, int lane) {
    v = wave_sum(v);
    BSYNC();
    if (lane == 0) red[wave] = v;
    BSYNC();
    float s = 0.f;
#pragma unroll
    for (int i = 0; i < NWAVES; ++i) s += red[i];
    return s;
}

__device__ __forceinline__ void ph_filters(const Fr& F, const Args& A) {
    unsigned char* ws = A.ws;
    const int gid = F.bid * NTHR + F.tid, NG = F.G * NTHR;
    const int gw = F.bid * NWAVES + F.wave, NGW = F.G * NWAVES;
    { float* MOD = (float*)(ws + WS_MOD); const float* MODP = (const float*)(ws + WS_MODP);
      for (int i = gid; i < DEPTH * 3 * 6144; i += NG) { const int l = i / (3 * 6144), n = i % 6144; float a = A.in[5][l * 6144 + n]; const float* p = MODP + (size_t)(i / 6144) * 16 * 6144 + n;
#pragma unroll
          for (int kc = 0; kc < 16; ++kc) a += p[(size_t)kc * 6144];
          MOD[i] = a; } }
    const float* HID = (const float*)(ws + WS_HID);
    const float log_target = 4.605170185988091f; const float dlo = log_target / 1.5f, dhi = log_target / 0.3f;
    { float* TAPC = (float*)(ws + WS_TAPC);
      for (int it = gw; it < DEPTH * 2 * 256; it += NGW) {
          const int l = it / 512, o = (it / 256) & 1, c = it & 255;
          const float* w3 = A.in[20] + (size_t)l * 64 * 1024; const int cf = o * 256 + c, cb = 512 + o * 256 + c;
          const float delta = dlo + (dhi - dlo) * (float)c / 255.f;
          float fv[4], gv[4]; float l1 = 0.f;
#pragma unroll
          for (int i = 0; i < 4; ++i) { const int s = F.lane + 64 * i; const float* h = HID + ((size_t)l * SB + SEQ + s) * 64; float f = 0.f, g = 0.f;
              for (int k = 0; k < 64; ++k) { const float hv = h[k]; f += hv * w3[k * 1024 + cf]; g += hv * w3[k * 1024 + cb]; }
              const float win = expf(-((float)s / 256.f) * delta) + 0.05f; f *= win; g *= win; if (s == 0) g = 0.f; fv[i] = f; gv[i] = g; l1 += fabsf(f) + fabsf(g); }
          l1 = wave_sum(l1); const float inv = 1.f / l1; float* T = TAPC + (size_t)it * 512;
#pragma unroll
          for (int i = 0; i < 4; ++i) { const int s = F.lane + 64 * i; T[256 + s] = fv[i] * inv; if (s >= 1) T[256 - s] = gv[i] * inv; }
          if (F.lane == 0) T[0] = 0.f;
      } }
    LAS f32x2* d = (LAS f32x2*)(F.lds + RING_OFF); LAS float* xs = (LAS float*)(F.lds + LDSX_OFF);
    const f32x2* TW = (const f32x2*)(ws + WS_TW); f32x2* HF = (f32x2*)(ws + WS_HF);
    for (int u = F.bid; u < DEPTH * 2 * 256; u += F.G) {
        const int l = u / 512, o = (u / 256) & 1, c = u & 255;
        const float* w3 = A.in[20] + (size_t)l * 64 * 1024; const int cf = o * 256 + c, cb = 512 + o * 256 + c;
        BSYNC();
        if (F.tid < 64) xs[F.tid] = w3[F.tid * 1024 + cf]; else if (F.tid < 128) xs[F.tid] = w3[(F.tid - 64) * 1024 + cb];
        BSYNC();
        const float delta = dlo + (dhi - dlo) * (float)c / 255.f; float l1 = 0.f;
        for (int s = F.tid; s < SEQ; s += NTHR) { const f32x4* h = (const f32x4*)(HID + ((size_t)l * SB + s) * 64); float f = 0.f, g = 0.f;
#pragma unroll
            for (int k4 = 0; k4 < 16; ++k4) { const f32x4 hv = h[k4];
                f += hv.x * xs[4 * k4] + hv.y * xs[4 * k4 + 1] + hv.z * xs[4 * k4 + 2] + hv.w * xs[4 * k4 + 3];
                g += hv.x * xs[64 + 4 * k4] + hv.y * xs[64 + 4 * k4 + 1] + hv.z * xs[64 + 4 * k4 + 2] + hv.w * xs[64 + 4 * k4 + 3]; }
            const float win = expf(-((float)s / 8192.f) * delta) + 0.05f; f *= win; g *= win;
            d[fphys(s)] = (f32x2){f, 0.f};
            if (s >= 1) { d[fphys(NFFT - s)] = (f32x2){g, 0.f}; l1 += fabsf(g); } else d[fphys(SEQ)] = (f32x2){0.f, 0.f};
            l1 += fabsf(f); }
        l1 = block_sum(l1, xs + 128, F.wave, F.lane);
        const float sc = 1.f / (l1 * (float)NFFT);
        fft_fwd(d, TW, F.tid);
        f32x2* out = HF + (size_t)u * NFFT;
        for (int i = F.tid; i < NFFT; i += NTHR) { const f32x2 v = d[fphys(i)]; out[i] = (f32x2){v.x * sc, v.y * sc}; }
    }
}

struct Row { f32x4 v[4]; };
__device__ __forceinline__ Row row_load(const float* p, int lane) { Row r; const f32x4* q = (const f32x4*)p + lane;
#pragma unroll
    for (int j = 0; j < 4; ++j) r.v[j] = q[64 * j];
    return r; }
__device__ __forceinline__ void row_store(float* p, const Row& r, int lane) { f32x4* q = (f32x4*)p + lane;
#pragma unroll
    for (int j = 0; j < 4; ++j) q[64 * j] = r.v[j]; }
__device__ __forceinline__ void row_store_bf16(bf16* p, const Row& r, int lane) { unsigned long long* q = (unsigned long long*)p + lane;
#pragma unroll
    for (int j = 0; j < 4; ++j) q[64 * j] = (unsigned long long)pk2(r.v[j].x, r.v[j].y) | ((unsigned long long)pk2(r.v[j].z, r.v[j].w) << 32); }
__device__ __forceinline__ void row_norm(Row& r) {
    float s = 0.f;
#pragma unroll
    for (int j = 0; j < 4; ++j) s += (r.v[j].x + r.v[j].y) + (r.v[j].z + r.v[j].w);
    const float mean = wave_sum(s) * (1.f / DM); float s2 = 0.f;
#pragma unroll
    for (int j = 0; j < 4; ++j) { r.v[j] = r.v[j] - mean; s2 += (r.v[j].x * r.v[j].x + r.v[j].y * r.v[j].y) + (r.v[j].z * r.v[j].z + r.v[j].w * r.v[j].w); }
    const float rstd = 1.f / sqrtf(wave_sum(s2) * (1.f / DM) + LN_EPS);
#pragma unroll
    for (int j = 0; j < 4; ++j) r.v[j] = r.v[j] * rstd;
}
__device__ __forceinline__ void row_mod(Row& r, const float* shift, const float* scale, int lane) {
    const Row sh = row_load(shift, lane), sc = row_load(scale, lane);
#pragma unroll
    for (int j = 0; j < 4; ++j) r.v[j] = r.v[j] * (sc.v[j] + 1.f) + sh.v[j];
}
__device__ __forceinline__ void row_affine(Row& r, const float* w, const float* b, int lane) {
    const Row ww = row_load(w, lane), bb = row_load(b, lane);
#pragma unroll
    for (int j = 0; j < 4; ++j) r.v[j] = r.v[j] * ww.v[j] + bb.v[j];
}
__device__ __forceinline__ float row_dot16(const Row& r, const LAS float* W16, int lane) {
    float mine = 0.f;
#pragma unroll 2
    for (int e = 0; e < 16; ++e) { const LAS f32x4* w = (const LAS f32x4*)(W16 + e * DM) + lane; float p = 0.f;
#pragma unroll
        for (int j = 0; j < 4; ++j) { const f32x4 x = w[64 * j]; p += (r.v[j].x * x.x + r.v[j].y * x.y) + (r.v[j].z * x.z + r.v[j].w * x.w); }
        p = wave_sum(p); if (lane == e) mine = p; }
    return mine;
}
__device__ __forceinline__ const float* row_input(const Args& A, int l, int row) {
    if (l > 0) return (const float*)(A.ws + WS_XS) + (size_t)row * DM;
    const int b = row / SB, s = row % SB;
    return s < SEQ ? A.in[0] + ((size_t)b * SEQ + s) * DM : A.in[2] + ((size_t)b * CTXL + (s - SEQ)) * DM;
}
__device__ __forceinline__ const float* mod_vec(const Args& A, int l, int row) { const int b = row / SB, s = row % SB; return (const float*)(A.ws + WS_MOD) + (size_t)(l * 3 + (s < SEQ ? b : 2)) * 6144; }

__device__ __forceinline__ void ln_a_row(const Args& A, int l, int row, Row r, const LAS float* WGl, int lane) {
    const float* mod = mod_vec(A, l, row);
    row_norm(r); row_mod(r, mod, mod + DM, lane);
    row_store_bf16((bf16*)(A.ws + WS_HN) + (size_t)row * DM, r, lane);
    const float g = row_dot16(r, WGl, lane);
    if (lane < 16) ((float*)(A.ws + WS_GT))[(size_t)row * 16 + lane] = g;
}
__device__ __forceinline__ void load_w16(const Fr& F, LAS float* dst, const float* src  ) {
    BSYNC();
    for (int i = F.tid; i < 16 * DM / 4; i += NTHR) ((LAS f32x4*)dst)[i] = ((const f32x4*)src)[i];
    BSYNC();
}
__device__ __forceinline__ void ph_ln_a0(const Fr& F, const Args& A) {
    LAS float* WGl = (LAS float*)(F.lds + RING_OFF);
    load_w16(F, WGl, (const float*)(A.ws + WS_WG));
    const int gw = F.bid * NWAVES + F.wave, NGW = F.G * NWAVES;
    for (int row = gw; row < MT; row += NGW) ln_a_row(A, 0, row, row_load(row_input(A, 0, row), F.lane), WGl, F.lane);
}
__device__ __forceinline__ void ph_ln_b(const Fr& F, const Args& A, int l) {
    LAS float* RW = (LAS float*)(F.lds + RING_OFF);
    BSYNC();
    for (int i = F.tid; i < 16 * DM; i += NTHR) { const int e = i >> 10, k = i & 1023; RW[i] = A.in[25][((size_t)l * DM + k) * 16 + e]; }
    BSYNC();
    const int gw = F.bid * NWAVES + F.wave, NGW = F.G * NWAVES; const bool last = (l == DEPTH - 1);
    for (int row = gw; row < MT; row += NGW) {
        const int b = row / SB, s = row % SB; if (last && s >= SEQ) continue;
        const float* mod = mod_vec(A, l, row);
        Row r = row_load(row_input(A, l, row), F.lane); const Row mx = row_load((const float*)(A.ws + WS_MIX) + (size_t)row * DM, F.lane), g1 = row_load(mod + 2 * DM, F.lane);
#pragma unroll
        for (int j = 0; j < 4; ++j) r.v[j] = r.v[j] * ALPHA + g1.v[j] * mx.v[j];
        row_norm(r); row_affine(r, A.in[23] + l * DM, A.in[24] + l * DM, F.lane);
        row_store((float*)(A.ws + WS_XS) + (size_t)row * DM, r, F.lane);
        row_norm(r); row_mod(r, mod + 3 * DM, mod + 4 * DM, F.lane);
        row_store_bf16((bf16*)(A.ws + WS_HN) + (size_t)row * DM, r, F.lane);
        float lg = row_dot16(r, RW, F.lane) + A.in[26][l * 16 + (F.lane & 15)];
        float mxv = lg;
#pragma unroll
        for (int o = 1; o < 16; o <<= 1) mxv = fmaxf(mxv, __shfl_xor(mxv, o));
        const float ex = expf(lg - mxv); float sm = ex;
#pragma unroll
        for (int o = 1; o < 16; o <<= 1) sm += __shfl_xor(sm, o);
        if (F.lane < 16) ((float*)(A.ws + WS_AFF))[((size_t)b * 16 + F.lane) * SB + s] = ex / sm;
    }
}
__device__ __forceinline__ void ph_ln_c(const Fr& F, const Args& A, int l) {
    const bool last = (l == DEPTH - 1);
    LAS float* WGl = (LAS float*)(F.lds + RING_OFF);
    if (!last) load_w16(F, WGl, (const float*)(A.ws + WS_WG) + (size_t)(l + 1) * 16 * DM);
    const int gw = F.bid * NWAVES + F.wave, NGW = F.G * NWAVES;
    const int* INV = (const int*)(A.ws + WS_INV); const float* VAL = (const float*)(A.ws + WS_VAL); const float* YE = (const float*)(A.ws + WS_YE);
    for (int row = gw; row < MT; row += NGW) {
        const int b = row / SB, s = row % SB; if (last && s >= SEQ) continue;
        const float* mod = mod_vec(A, l, row);
        const int myinv = (F.lane < 16) ? INV[(size_t)row * 16 + F.lane] : 0;
        Row f;
#pragma unroll
        for (int j = 0; j < 4; ++j) f.v[j] = (f32x4){0.f, 0.f, 0.f, 0.f};
        for (int e = 0; e < 16; ++e) { const int r1 = __builtin_amdgcn_readlane(myinv, e);
            if (r1 != 0) { const size_t rr = (size_t)e * ROWS_E + (r1 - 1); const float val = VAL[rr]; const Row y = row_load(YE + rr * DM, F.lane);
#pragma unroll
                for (int j = 0; j < 4; ++j) f.v[j] += y.v[j] * val; } }
        Row r = row_load((const float*)(A.ws + WS_XS) + (size_t)row * DM, F.lane); const Row g2 = row_load(mod + 5 * DM, F.lane);
#pragma unroll
        for (int j = 0; j < 4; ++j) r.v[j] = r.v[j] * ALPHA + g2.v[j] * f.v[j];
        row_norm(r); row_affine(r, A.in[30] + l * DM, A.in[31] + l * DM, F.lane);
        if (last) row_store(A.out + ((size_t)b * SEQ + s) * DM, r, F.lane);
        else { row_store((float*)(A.ws + WS_XS) + (size_t)row * DM, r, F.lane); ln_a_row(A, l + 1, row, r, WGl, F.lane); }
    }
}

struct EpiWin {
    static constexpr bool PERM = true, AFTER_DRAIN = false;
    bf16* P1; float* HY;
    __device__ __forceinline__ void operator()(const pg8::f32x4 (&acc)[2][2][4][2], const pg8::Unit& u, int wr, int wc, int fr, int fq) const {
        const int row0 = u.pm * 256 + wr * 64 + fr;
        if (u.pn < 7) {
            const int col0 = u.pn * 256 + wc * 32 + 8 * fq;
#pragma unroll
            for (int ai = 0; ai < 2; ++ai)
#pragma unroll
                for (int m = 0; m < 4; ++m) { bf16* rowp = P1 + (size_t)(row0 + ai * 128 + m * 16) * NP1 + col0;
#pragma unroll
                    for (int bj = 0; bj < 2; ++bj) { const pg8::f32x4 v0 = acc[ai][bj][m][0], v1 = acc[ai][bj][m][1]; pg8::u32x4 w;
                        w.x = pg8::cvt_pk_bf16(v0[0], v0[1]); w.y = pg8::cvt_pk_bf16(v0[2], v0[3]); w.z = pg8::cvt_pk_bf16(v1[0], v1[1]); w.w = pg8::cvt_pk_bf16(v1[2], v1[3]);
                        *(pg8::u32x4*)(rowp + bj * 128) = w; } }
        } else {
            const int b = u.pm / 33, s0 = (u.pm % 33) * 256 + wr * 64 + fr; const int ch0 = (u.pn - 7) * 256 + wc * 32 + 8 * fq;
            float* base = HY + (size_t)b * 768 * SB;
#pragma unroll
            for (int ai = 0; ai < 2; ++ai)
#pragma unroll
                for (int m = 0; m < 4; ++m) { const int s = s0 + ai * 128 + m * 16;
#pragma unroll
                    for (int bj = 0; bj < 2; ++bj)
#pragma unroll
                        for (int n = 0; n < 2; ++n)
#pragma unroll
                            for (int i = 0; i < 4; ++i) base[(size_t)(ch0 + bj * 128 + 4 * n + i) * SB + s] = acc[ai][bj][m][n][i]; }
        }
    }
};
struct EpiF32g {
    static constexpr bool PERM = false, AFTER_DRAIN = false;
    float* C; int ldc; int ntn;
    __device__ __forceinline__ void operator()(const pg8::f32x4 (&acc)[2][2][4][2], const pg8::Unit& u, int wr, int wc, int fr, int fq) const {
        const int row0 = u.pm * 256 + wr * 64 + fr, col0 = (u.pn % ntn) * 256 + wc * 32 + 4 * fq;
#pragma unroll
        for (int ai = 0; ai < 2; ++ai)
#pragma unroll
            for (int m = 0; m < 4; ++m) { float* rowp = C + (size_t)(row0 + ai * 128 + m * 16) * ldc + col0;
#pragma unroll
                for (int bj = 0; bj < 2; ++bj)
#pragma unroll
                    for (int n = 0; n < 2; ++n) *(pg8::f32x4*)(rowp + bj * 128 + n * 16) = acc[ai][bj][m][n]; }
    }
};
struct EpiSwiglu {
    static constexpr bool PERM = true, AFTER_DRAIN = false;
    bf16* ACT;
    __device__ __forceinline__ void operator()(const pg8::f32x4 (&acc)[2][2][4][2], const pg8::Unit& u, int wr, int wc, int fr, int fq) const {
        const int row0 = u.pm * 256 + wr * 64 + fr, col0 = (u.pn % NT1) * 128 + wc * 32 + 8 * fq;
#pragma unroll
        for (int ai = 0; ai < 2; ++ai)
#pragma unroll
            for (int m = 0; m < 4; ++m) { float o[8];
#pragma unroll
                for (int n = 0; n < 2; ++n)
#pragma unroll
                    for (int i = 0; i < 4; ++i) { const float g = acc[ai][0][m][n][i], uu = acc[ai][1][m][n][i]; o[4 * n + i] = g / (1.f + __expf(-g)) * uu; }
                pg8::u32x4 w; w.x = pg8::cvt_pk_bf16(o[0], o[1]); w.y = pg8::cvt_pk_bf16(o[2], o[3]); w.z = pg8::cvt_pk_bf16(o[4], o[5]); w.w = pg8::cvt_pk_bf16(o[6], o[7]);
                *(pg8::u32x4*)(ACT + (size_t)(row0 + ai * 128 + m * 16) * FF + col0) = w; }
    }
};
struct OrderBase { __device__ __forceinline__ void a_ready(const pg8::Unit&) const {} __device__ __forceinline__ void done(const pg8::Unit&) const {} };
struct GroupOrder : OrderBase { int nMe, nN, G, c;
    __device__ __forceinline__ bool next(int i, pg8::Unit& u) const { const int L = i * G + c, per = nMe * nN; if (L >= NE * per) return false; const int e = L / per, r = L % per; u.pm = e * 9 + r % nMe; u.pn = e * nN + r / nMe; return true; } };
struct WoutOrder : OrderBase { int ntile, skipctx, G, c;
    __device__ __forceinline__ bool next(int i, pg8::Unit& u) const { const int L = i * G + c; if (L >= ntile * 4) return false; int t = L >> 2; if (skipctx) t += (t >= 32); u.pm = t; u.pn = L & 3; return true; } };

__device__ __forceinline__ void ph_attn_prep(const Fr& F, const Args& A, int l) {
    bf16* P1 = (bf16*)(A.ws + WS_P1);
    const int gw = F.bid * NWAVES + F.wave, NGW = F.G * NWAVES; const int d = F.lane;
    const float qw = A.in[11][l * 64 + d] * attn_body::C2, kw = A.in[12][l * 64 + d];
    const int f = d & 15; const float invf = exp2f(-(float)f * (13.287712379549449f / 16.f));
    const bool lastl = (l == DEPTH - 1);
    for (int row = gw; row < MT; row += NGW) {
        const int s = row % SB; const bool lat = s < SEQ;
        float cs = 1.f, sn = 0.f;
        if (lat) { const float pos = (float)((d < 32) ? (s >> 6) : (s & 63)); const float ang = pos * invf; cs = cosf(ang); sn = sinf(ang); if (((d >> 4) & 1) == 0) sn = -sn; }
        bf16* rp = P1 + (size_t)row * NP1;
        const int nq = (lat || !lastl) ? 8 : 0;
#pragma unroll
        for (int hh = 0; hh < 10; ++hh) {
            if (hh < 8 && hh >= nq) continue;
            bf16* p = rp + (hh < 8 ? C_AQ + hh * 64 : C_AK + (hh - 8) * 64) + d;
            float x = bf2f(*p); const float ss = wave_sum(x * x);
            x = x * (1.f / sqrtf(ss * (1.f / 64.f) + RMS_EPS)) * (hh < 8 ? qw : kw);
            const float partner = __shfl_xor(x, 16);
            x = x * cs + partner * sn;
            *p = (bf16)f2bf(x);
        }
    }
}

typedef short s16x8 __attribute__((ext_vector_type(8)));
__device__ __forceinline__ float wave_scan_add(float v, int lane) {
#pragma unroll
    for (int o = 1; o < 64; o <<= 1) { const float t = __shfl_up(v, o); if (lane >= o) v += t; }
    return v; }
__device__ __forceinline__ float wave_scan_max(float v, int lane) {
#pragma unroll
    for (int o = 1; o < 64; o <<= 1) { const float t = __shfl_up(v, o); if (lane >= o) v = fmaxf(v, t); }
    return v; }
__device__ __forceinline__ float logsigmoidf_(float x) { return fminf(x, 0.f) - log1pf(expf(-fabsf(x))); }
__device__ __forceinline__ int mpos(int dir, int blk) { return dir == 0 ? (blk >= 64 ? blk - 64 : blk + 2) : (blk >= 64 ? 65 - blk : 65 - blk); }
__device__ __forceinline__ void gate_scan(const Args& A, int l, int row0, int dir, int h, LAS float* BC, LAS float* GG, LAS float* PM, int lane) {
    const float* GT = (const float*)(A.ws + WS_GT); const float bi = A.in[9][((l * 2 + dir) * 2 + 0) * 4 + h], bfg = A.in[9][((l * 2 + dir) * 2 + 1) * 4 + h];
    const int o0 = 2 * lane, o1 = 2 * lane + 1; const int t0 = dir ? 127 - o0 : o0, t1 = dir ? 127 - o1 : o1;
    const float li0 = GT[(size_t)(row0 + t0) * 16 + dir * 8 + h] + bi, li1 = GT[(size_t)(row0 + t1) * 16 + dir * 8 + h] + bi;
    const float lf0 = logsigmoidf_(GT[(size_t)(row0 + t0) * 16 + dir * 8 + 4 + h] + bfg), lf1 = logsigmoidf_(GT[(size_t)(row0 + t1) * 16 + dir * 8 + 4 + h] + bfg);
    const float S = wave_scan_add(lf0 + lf1, lane); const float b0 = S - lf1, b1 = S;
    const float g0 = li0 - b0, g1 = li1 - b1;
    const float M = wave_scan_max(fmaxf(g0, g1), lane); float Mprev = __shfl_up(M, 1); if (lane == 0) Mprev = -INFINITY;
    BC[t0] = b0; BC[t1] = b1; GG[t0] = g0; GG[t1] = g1; PM[t0] = fmaxf(Mprev, g0); PM[t1] = M;
}
__device__ __forceinline__ void qk_conv8(const bf16* P1, const float* cw  , const float* cb, int row, int seq_lo, int seq_hi, int ch, float scale, float (&o)[8]) {
    const v4u z = {0u, 0u, 0u, 0u};
    const v4u xm = (row - 1 >= seq_lo) ? *(const v4u*)(P1 + (size_t)(row - 1) * NP1 + ch) : z;
    const v4u x0 = *(const v4u*)(P1 + (size_t)row * NP1 + ch);
    const v4u xp = (row + 1 < seq_hi) ? *(const v4u*)(P1 + (size_t)(row + 1) * NP1 + ch) : z;
    const f32x4 w0a = *(const f32x4*)(cw + ch), w0b = *(const f32x4*)(cw + ch + 4), w1a = *(const f32x4*)(cw + 512 + ch), w1b = *(const f32x4*)(cw + 512 + ch + 4), w2a = *(const f32x4*)(cw + 1024 + ch), w2b = *(const f32x4*)(cw + 1024 + ch + 4);
    const f32x4 ba = *(const f32x4*)(cb + ch), bb = *(const f32x4*)(cb + ch + 4);
    const unsigned am[4] = {xm.x, xm.y, xm.z, xm.w}, a0[4] = {x0.x, x0.y, x0.z, x0.w}, ap[4] = {xp.x, xp.y, xp.z, xp.w};
#pragma unroll
    for (int i = 0; i < 4; ++i) {
        const float wl0 = i < 2 ? w0a[2 * i] : w0b[2 * i - 4], wh0 = i < 2 ? w0a[2 * i + 1] : w0b[2 * i - 3];
        const float wl1 = i < 2 ? w1a[2 * i] : w1b[2 * i - 4], wh1 = i < 2 ? w1a[2 * i + 1] : w1b[2 * i - 3];
        const float wl2 = i < 2 ? w2a[2 * i] : w2b[2 * i - 4], wh2 = i < 2 ? w2a[2 * i + 1] : w2b[2 * i - 3];
        const float bl = i < 2 ? ba[2 * i] : bb[2 * i - 4], bh = i < 2 ? ba[2 * i + 1] : bb[2 * i - 3];
        const float ul = bl + wl0 * bflo(am[i]) + wl1 * bflo(a0[i]) + wl2 * bflo(ap[i]);
        const float uh = bh + wh0 * bfhi(am[i]) + wh1 * bfhi(a0[i]) + wh2 * bfhi(ap[i]);
        o[2 * i] = siluf_(ul) * scale; o[2 * i + 1] = siluf_(uh) * scale;
    }
}
constexpr int ML_QT = 0, ML_KN = 18432, ML_AP = 36864, ML_BTP = 88064, ML_VEC = 113664;
constexpr int ML_VT = 36864, ML_KT = 36864 + 17408;
__device__ __forceinline__ void ph_mlstm_local(const Fr& F, const Args& A, int l) {
    const bf16* P1 = (const bf16*)(A.ws + WS_P1); float* SLOC = (float*)(A.ws + WS_SLOC);
    LAS unsigned char* L = F.lds + RING_OFF;
    LAS unsigned short* VT = (LAS unsigned short*)(L + ML_VT); LAS unsigned short* KT = (LAS unsigned short*)(L + ML_KT);
    LAS float* BC = (LAS float*)(L + ML_VEC); LAS float* GG = BC + 256; LAS float* PM = GG + 256; LAS float* WW = PM + 256;
    const float* cw = A.in[7] + (size_t)l * 3 * 512; const float* cb = A.in[8] + l * 512;
    for (int u = F.bid; u < NB * 4 * NPOS; u += F.G) {
        const int b = u / (4 * NPOS), h = (u / NPOS) & 3, blk = u % NPOS;
        const int row0 = b * SB + blk * 128; const int seq_lo = blk < 64 ? b * SB : b * SB + SEQ, seq_hi = blk < 64 ? b * SB + SEQ : (b + 1) * SB;
        BSYNC();
        if (F.wave < 2) gate_scan(A, l, row0, F.wave, h, BC + F.wave * 128, GG + F.wave * 128, PM + F.wave * 128, F.lane);
#pragma unroll
        for (int it = 0; it < 2; ++it) { const int idx = F.tid + it * NTHR, t = idx >> 3, c8 = idx & 7; float o[8];
            qk_conv8(P1, cw, cb, row0 + t, seq_lo, seq_hi, C_MK + h * 64 + c8 * 8, 1.f, o);
#pragma unroll
            for (int i = 0; i < 8; ++i) KT[(c8 * 8 + i) * 136 + t] = (unsigned short)f2bf(o[i]); }
        BSYNC();
        for (int dir = 0; dir < 2; ++dir) {
            const float pmall = dir ? PM[128 + 0] : PM[127];
            const float atot = dir ? BC[128 + 0] : BC[127];
            if (F.tid < 128) WW[dir * 128 + F.tid] = expf(GG[dir * 128 + F.tid] - pmall);
            BSYNC();
#pragma unroll
            for (int it = 0; it < 2; ++it) { const int idx = F.tid + it * NTHR, t = idx >> 3, c8 = idx & 7; const float w = WW[dir * 128 + t];
                const v4u x = *(const v4u*)(P1 + (size_t)(row0 + t) * NP1 + C_MV + h * 64 + c8 * 8); const unsigned xa[4] = {x.x, x.y, x.z, x.w};
#pragma unroll
                for (int i = 0; i < 4; ++i) { VT[(c8 * 8 + 2 * i) * 136 + t] = (unsigned short)f2bf(w * bflo(xa[i])); VT[(c8 * 8 + 2 * i + 1) * 136 + t] = (unsigned short)f2bf(w * bfhi(xa[i])); } }
            BSYNC();
            const int stream = (dir * 2 + b) * 4 + h, p = mpos(dir, blk);
            float* rec = SLOC + ((size_t)stream * NPOS + p) * SST;
            if (F.wave < 4) {
                const int be = F.wave >> 1, bd = F.wave & 1, r = F.lane & 31, hh = F.lane >> 5; f32x16 acc = {};
#pragma unroll
                for (int kk = 0; kk < 8; ++kk) { const s16x8 a = *(const LAS s16x8*)(VT + (be * 32 + r) * 136 + kk * 16 + hh * 8), bb = *(const LAS s16x8*)(KT + (bd * 32 + r) * 136 + kk * 16 + hh * 8);
                    acc = __builtin_amdgcn_mfma_f32_32x32x16_bf16(a, bb, acc, 0, 0, 0); }
#pragma unroll
                for (int g = 0; g < 16; ++g) { const int e = be * 32 + (g & 3) + 8 * (g >> 2) + 4 * hh; rec[e * 64 + bd * 32 + r] = acc[g]; }
            } else if (F.wave == 4) {
                float a = 0.f; for (int t = 0; t < 128; ++t) a += WW[dir * 128 + t] * bf2f(KT[F.lane * 136 + t]);
                rec[4096 + F.lane] = a; if (F.lane == 0) { rec[4160] = atot; rec[4161] = atot + pmall; }
            }
            BSYNC();
        }
    }
}
__device__ __forceinline__ void ph_mlstm_carry(const Fr& F, const Args& A) {
    const float* SLOC = (const float*)(A.ws + WS_SLOC); float* SCAR = (float*)(A.ws + WS_SCAR);
    const int gid = F.bid * NTHR + F.tid, NG = F.G * NTHR;
    for (int i = gid; i < 16 * 4160; i += NG) {
        const int stream = i / 4160, el = i % 4160; float m = 0.f, val = 0.f;
        const float* sl = SLOC + (size_t)stream * NPOS * SST; float* sc = SCAR + (size_t)stream * NPOS * SST;
        for (int p = 0; p < NPOS; ++p) {
            sc[(size_t)p * SST + el] = val; if (el == 0) sc[(size_t)p * SST + 4160] = m;
            const float a = sl[(size_t)p * SST + 4160], ml = sl[(size_t)p * SST + 4161], dlt = sl[(size_t)p * SST + el];
            const float mn = fmaxf(a + m, ml);
            val = expf(a + m - mn) * val + expf(ml - mn) * dlt; m = mn;
        }
    }
}
__device__ __forceinline__ void ph_mlstm_out(const Fr& F, const Args& A, int l) {
    const bf16* P1 = (const bf16*)(A.ws + WS_P1); const float* SCAR = (const float*)(A.ws + WS_SCAR); bf16* Y = (bf16*)(A.ws + WS_Y);
    LAS unsigned char* L = F.lds + RING_OFF;
    LAS unsigned short* QT = (LAS unsigned short*)(L + ML_QT); LAS unsigned short* KN = (LAS unsigned short*)(L + ML_KN);
    LAS unsigned short* AP = (LAS unsigned short*)(L + ML_AP); LAS unsigned short* BTP = (LAS unsigned short*)(L + ML_BTP);
    LAS float* BC = (LAS float*)(L + ML_VEC); LAS float* GG = BC + 256; LAS float* PM = GG + 256;
    LAS float* MM = PM + 256; LAS float* WI = MM + 128; LAS float* DEN = WI + 128; LAS float* N0 = DEN + 128; LAS float* SS = N0 + 64;
    const float* cw = A.in[7] + (size_t)l * 3 * 512; const float* cb = A.in[8] + l * 512;
    const bool lastl = (l == DEPTH - 1);
    const int r = F.lane & 31, hh = F.lane >> 5;
    for (int u = F.bid; u < NB * 4 * NPOS; u += F.G) {
        const int b = u / (4 * NPOS), h = (u / NPOS) & 3, blk = u % NPOS;
        if (lastl && blk >= 64) continue;
        const int row0 = b * SB + blk * 128; const int seq_lo = blk < 64 ? b * SB : b * SB + SEQ, seq_hi = blk < 64 ? b * SB + SEQ : (b + 1) * SB;
        BSYNC();
        if (F.wave < 2) gate_scan(A, l, row0, F.wave, h, BC + F.wave * 128, GG + F.wave * 128, PM + F.wave * 128, F.lane);
#pragma unroll
        for (int it = 0; it < 2; ++it) { const int idx = F.tid + it * NTHR, t = idx >> 3, c8 = idx & 7; float o[8];
            qk_conv8(P1, cw, cb, row0 + t, seq_lo, seq_hi, C_MQ + h * 64 + c8 * 8, 0.125f, o);
            *(LAS v4u*)(QT + t * 72 + c8 * 8) = (v4u){pk2(o[0], o[1]), pk2(o[2], o[3]), pk2(o[4], o[5]), pk2(o[6], o[7])};
            qk_conv8(P1, cw, cb, row0 + t, seq_lo, seq_hi, C_MK + h * 64 + c8 * 8, 1.f, o);
            *(LAS v4u*)(KN + t * 72 + c8 * 8) = (v4u){pk2(o[0], o[1]), pk2(o[2], o[3]), pk2(o[4], o[5]), pk2(o[6], o[7])};
            const v4u x = *(const v4u*)(P1 + (size_t)(row0 + t) * NP1 + C_MV + h * 64 + c8 * 8); const unsigned xa[4] = {x.x, x.y, x.z, x.w};
#pragma unroll
            for (int i = 0; i < 4; ++i) { BTP[(c8 * 8 + 2 * i) * 200 + t] = (unsigned short)(xa[i] & 0xffffu); BTP[(c8 * 8 + 2 * i + 1) * 200 + t] = (unsigned short)(xa[i] >> 16); } }
        f32x16 osum = {};
        const int bj = F.wave >> 1, be = F.wave & 1;
        for (int dir = 0; dir < 2; ++dir) {
            const int stream = (dir * 2 + b) * 4 + h, p = mpos(dir, blk);
            const float* st = SCAR + ((size_t)stream * NPOS + p) * SST; const float m0 = st[4160];
            BSYNC();
            if (F.tid < 128) { const float mm = fmaxf(m0, PM[dir * 128 + F.tid]); MM[F.tid] = mm; WI[F.tid] = expf(m0 - mm); }
            if (F.tid >= 128 && F.tid < 192) N0[F.tid - 128] = st[4096 + F.tid - 128];
#pragma unroll
            for (int it = 0; it < 8; ++it) { const int idx = F.tid + it * NTHR; BTP[(idx >> 6) * 200 + 128 + (idx & 63)] = (unsigned short)f2bf(st[idx]); }
            BSYNC();
#pragma unroll
            for (int it = 0; it < 16; ++it) { const int idx = F.tid + it * NTHR, t = idx >> 6, dd = idx & 63; AP[t * 200 + 128 + dd] = (unsigned short)f2bf(WI[t] * bf2f(QT[t * 72 + dd])); }
#pragma unroll
            for (int q2 = 0; q2 < 2; ++q2) { const int blkid = F.wave * 2 + q2, bi = blkid >> 2, bs = blkid & 3; f32x16 acc = {};
                const bool need = dir ? (bs >= bi) : (bs <= bi);
                if (need) {
#pragma unroll
                    for (int kk = 0; kk < 4; ++kk) { const s16x8 a = *(const LAS s16x8*)(QT + (bi * 32 + r) * 72 + kk * 16 + hh * 8), bb = *(const LAS s16x8*)(KN + (bs * 32 + r) * 72 + kk * 16 + hh * 8);
                        acc = __builtin_amdgcn_mfma_f32_32x32x16_bf16(a, bb, acc, 0, 0, 0); } }
                const int s = bs * 32 + r; const float gs = GG[dir * 128 + s];
#pragma unroll
                for (int g = 0; g < 16; ++g) { const int j = bi * 32 + (g & 3) + 8 * (g >> 2) + 4 * hh; const bool valid = dir ? (s >= j) : (s <= j);
                    const float v = valid ? acc[g] * expf(gs - MM[j]) : 0.f; AP[j * 200 + s] = (unsigned short)f2bf(v); } }
            BSYNC();
            { const int j = F.tid >> 2, part = F.tid & 3; float a = 0.f;
              for (int k = part * 48; k < part * 48 + 48; ++k) { const float x = bf2f(AP[j * 200 + k]); a += (k < 128) ? x : x * N0[k - 128]; }
              a += __shfl_xor(a, 1); a += __shfl_xor(a, 2); if (part == 0) DEN[j] = a; }
            f32x16 acc = {};
#pragma unroll
            for (int kk = 0; kk < 12; ++kk) { const s16x8 a = *(const LAS s16x8*)(AP + (bj * 32 + r) * 200 + kk * 16 + hh * 8), bb = *(const LAS s16x8*)(BTP + (be * 32 + r) * 200 + kk * 16 + hh * 8);
                acc = __builtin_amdgcn_mfma_f32_32x32x16_bf16(a, bb, acc, 0, 0, 0); }
            BSYNC();
#pragma unroll
            for (int g = 0; g < 16; ++g) { const int j = bj * 32 + (g & 3) + 8 * (g >> 2) + 4 * hh; const float den = fmaxf(fabsf(DEN[j]), expf(-(BC[dir * 128 + j] + MM[j]))); osum[g] += acc[g] / den; }
        }
        float ssq[16];
#pragma unroll
        for (int g = 0; g < 16; ++g) { float q = osum[g] * osum[g]; q += __shfl_xor(q, 1); q += __shfl_xor(q, 2); q += __shfl_xor(q, 4); q += __shfl_xor(q, 8); q += __shfl_xor(q, 16); ssq[g] = q; }
        if (r == 0) {
#pragma unroll
            for (int g = 0; g < 16; ++g) SS[be * 128 + bj * 32 + (g & 3) + 8 * (g >> 2) + 4 * hh] = ssq[g]; }
        BSYNC();
        const int e = be * 32 + r; const float nw = A.in[10][l * 256 + h * 64 + e];
#pragma unroll
        for (int g = 0; g < 16; ++g) { const int j = bj * 32 + (g & 3) + 8 * (g >> 2) + 4 * hh; const float tot = SS[j] + SS[128 + j];
            const float og = bf2f(((const unsigned short*)P1)[(size_t)(row0 + j) * NP1 + C_MO + h * 64 + e]);
            const float y = osum[g] * (1.f / sqrtf(tot * (1.f / 64.f) + RMS_EPS)) * nw * sigmoidf_(og);
            Y[(size_t)(row0 + j) * DM + h * 64 + e] = (bf16)f2bf(y); }
    }
}

__device__ __forceinline__ float hy_conv(const float* p, int t, int n, float w0, float w1, float w2, float bb) {
    const float xm = t > 0 ? p[t - 1] : 0.f, x0 = p[t], xp = t + 1 < n ? p[t + 1] : 0.f; return bb + w0 * xm + w1 * x0 + w2 * xp; }
__device__ __forceinline__ void ph_hyena(const Fr& F, const Args& A, int l) {
    const float* HY = (const float*)(A.ws + WS_HY); bf16* Y = (bf16*)(A.ws + WS_Y);
    const f32x2* TW = (const f32x2*)(A.ws + WS_TW); const f32x2* HF = (const f32x2*)(A.ws + WS_HF);
    LAS f32x2* d = (LAS f32x2*)(F.lds + RING_OFF);
    const bool lastl = (l == DEPTH - 1);
    for (int c = F.bid; c < 256; c += F.G) {
        const float* cwp = A.in[13] + (size_t)l * 3 * 768; const float* cbp = A.in[14] + l * 768;
        float cw[3][3], cbv[3];
#pragma unroll
        for (int w = 0; w < 3; ++w) { cbv[w] = cbp[w * 256 + c];
#pragma unroll
            for (int j = 0; j < 3; ++j) cw[w][j] = cwp[j * 768 + w * 256 + c]; }
        const float sk0 = A.in[21][(l * 2 + 0) * 256 + c], sk1 = A.in[21][(l * 2 + 1) * 256 + c];
        const float* hv0 = HY + ((size_t)(0 * 768 + 0 * 256 + c)) * SB; const float* hv1 = HY + ((size_t)(1 * 768 + 0 * 256 + c)) * SB;
        const float* hx10 = HY + ((size_t)(0 * 768 + 256 + c)) * SB; const float* hx11 = HY + ((size_t)(1 * 768 + 256 + c)) * SB;
        const float* hx20 = HY + ((size_t)(0 * 768 + 512 + c)) * SB; const float* hx21 = HY + ((size_t)(1 * 768 + 512 + c)) * SB;
        float* Z1 = (float*)(A.ws + WS_Z1) + (size_t)c * 2 * SEQ;
        BSYNC();
#pragma unroll 2
        for (int i = 0; i < 16; ++i) { const int t = F.tid + NTHR * i;
            const float v0 = hy_conv(hv0, t, SEQ, cw[0][0], cw[0][1], cw[0][2], cbv[0]), v1 = hy_conv(hv1, t, SEQ, cw[0][0], cw[0][1], cw[0][2], cbv[0]);
            d[fphys(t)] = (f32x2){v0, v1}; d[fphys(SEQ + t)] = (f32x2){0.f, 0.f}; }
        BSYNC();
        fft_fwd(d, TW, F.tid);
        { const f32x2* hf = HF + ((size_t)(l * 2 + 0) * 256 + c) * NFFT;
#pragma unroll 4
          for (int i = F.tid; i < NFFT; i += NTHR) d[fphys(i)] = cmul(d[fphys(i)], hf[i]); }
        BSYNC();
        fft_inv(d, TW, F.tid);
#pragma unroll 2
        for (int i = 0; i < 16; ++i) { const int t = F.tid + NTHR * i; const f32x2 cv = d[fphys(t)];
            const float v0 = hy_conv(hv0, t, SEQ, cw[0][0], cw[0][1], cw[0][2], cbv[0]), v1 = hy_conv(hv1, t, SEQ, cw[0][0], cw[0][1], cw[0][2], cbv[0]);
            const float x0 = hy_conv(hx10, t, SEQ, cw[1][0], cw[1][1], cw[1][2], cbv[1]), x1 = hy_conv(hx11, t, SEQ, cw[1][0], cw[1][1], cw[1][2], cbv[1]);
            const float a0 = x0 * (cv.x + sk0 * v0), a1 = x1 * (cv.y + sk0 * v1);
            Z1[t] = a0; Z1[SEQ + t] = a1;
            d[fphys(t)] = (f32x2){a0, a1}; d[fphys(SEQ + t)] = (f32x2){0.f, 0.f}; }
        BSYNC();
        fft_fwd(d, TW, F.tid);
        { const f32x2* hf = HF + ((size_t)(l * 2 + 1) * 256 + c) * NFFT;
#pragma unroll 4
          for (int i = F.tid; i < NFFT; i += NTHR) d[fphys(i)] = cmul(d[fphys(i)], hf[i]); }
        BSYNC();
        fft_inv(d, TW, F.tid);
#pragma unroll 2
        for (int i = 0; i < 16; ++i) { const int t = F.tid + NTHR * i; const f32x2 cv = d[fphys(t)];
            const float x0 = hy_conv(hx20, t, SEQ, cw[2][0], cw[2][1], cw[2][2], cbv[2]), x1 = hy_conv(hx21, t, SEQ, cw[2][0], cw[2][1], cw[2][2], cbv[2]);
            const float a0 = x0 * (cv.x + sk1 * Z1[t]), a1 = x1 * (cv.y + sk1 * Z1[SEQ + t]);
            Y[((size_t)0 * SB + t) * DM + 768 + c] = (bf16)f2bf(a0); Y[((size_t)1 * SB + t) * DM + 768 + c] = (bf16)f2bf(a1); }
        BSYNC();
        if (!lastl) {
            LAS float* zc = (LAS float*)(F.lds + RING_OFF); LAS float* tp = zc + 512;
            const float* TAPC = (const float*)(A.ws + WS_TAPC) + ((size_t)(l * 2) * 256 + c) * 512;
            const int b = F.tid >> 8, t = F.tid & 255;
            const float* base = HY + ((size_t)(b * 768 + c)) * SB + SEQ;
            const float vc = hy_conv(base, t, CTXL, cw[0][0], cw[0][1], cw[0][2], cbv[0]);
            const float x1c = hy_conv(base + (size_t)256 * SB, t, CTXL, cw[1][0], cw[1][1], cw[1][2], cbv[1]);
            const float x2c = hy_conv(base + (size_t)512 * SB, t, CTXL, cw[2][0], cw[2][1], cw[2][2], cbv[2]);
            BSYNC();
            zc[F.tid] = vc; tp[F.tid] = TAPC[F.tid]; tp[512 + F.tid] = TAPC[(size_t)256 * 512 + F.tid];
            BSYNC();
            float y = 0.f; for (int q = 0; q < 256; ++q) y += tp[256 + t - q] * zc[b * 256 + q];
            const float zz1 = x1c * (y + sk0 * vc);
            BSYNC(); zc[F.tid] = zz1; BSYNC();
            float y2 = 0.f; for (int q = 0; q < 256; ++q) y2 += tp[512 + 256 + t - q] * zc[b * 256 + q];
            const float zz2 = x2c * (y2 + sk1 * zz1);
            Y[((size_t)b * SB + SEQ + t) * DM + 768 + c] = (bf16)f2bf(zz2);
        }
    }
}

__device__ __forceinline__ void ph_attention(const Fr& F, const Args& A, int l, unsigned char* lds_generic) {
    const attn_body::bf16* P1 = (const attn_body::bf16*)(A.ws + WS_P1); attn_body::bf16* Y = (attn_body::bf16*)(A.ws + WS_Y);
    const int nun = (l == DEPTH - 1) ? 512 : 528;
    for (int u = F.bid; u < nun; u += F.G) {
        int b, hq, q0, kv0, nt;
        if (u < 512) { b = u >> 8; hq = (u >> 5) & 7; q0 = (u & 31) * 256; kv0 = 0; nt = SB / 64; }
        else { const int v = u - 512; b = v >> 3; hq = v & 7; q0 = SEQ; kv0 = SEQ; nt = CTXL / 64; }
        const int kvh = hq >> 2;
        const attn_body::bf16* Qb = P1 + ((size_t)b * SB + q0) * NP1 + C_AQ + hq * 64;
        const attn_body::bf16* Kb = P1 + ((size_t)b * SB + kv0) * NP1 + C_AK + kvh * 64;
        const attn_body::bf16* Vb = P1 + ((size_t)b * SB + kv0) * NP1 + C_AV + kvh * 64;
        attn_body::bf16* Ob = Y + ((size_t)b * SB + q0) * DM + 256 + hq * 64;
        attn_body::attn_unit<8>(Qb, NP1, Kb, Vb, NP1, nt, Ob, DM, (char*)lds_generic + RING_OFF);
    }
}

__device__ __forceinline__ int block_count(int v, LAS int* slot  , int it, int wave, int lane) {
    v = wave_sum_i(v);
    if (lane == 0) slot[(it & 1) * 8 + wave] = v;
    BSYNC();
    int s = 0;
#pragma unroll
    for (int i = 0; i < NWAVES; ++i) s += slot[(it & 1) * 8 + i];
    return s;
}
__device__ __forceinline__ int block_excl_scan(int v, LAS int* wtot  , int wave, int lane, int& tot) {
    int inc = v;
#pragma unroll
    for (int o = 1; o < 64; o <<= 1) { const int t = __shfl_up(inc, o); if (lane >= o) inc += t; }
    BSYNC();
    if (lane == 63) wtot[wave] = inc;
    BSYNC();
    int pre = 0; tot = 0;
#pragma unroll
    for (int i = 0; i < NWAVES; ++i) { const int x = wtot[i]; if (i < wave) pre += x; tot += x; }
    return pre + inc - v;
}
__device__ __forceinline__ void ph_select(const Fr& F, const Args& A, int l) {
    const float* AFF = (const float*)(A.ws + WS_AFF); int* INV = (int*)(A.ws + WS_INV); int* IDX = (int*)(A.ws + WS_IDX); float* VAL = (float*)(A.ws + WS_VAL);
    LAS int* slot = (LAS int*)(F.lds + LDSX_OFF); LAS int* wtot = slot + 16;
    const int nun = (l == DEPTH - 1) ? 32 : 64;
    for (int u = F.bid; u < nun; u += F.G) {
        const int kind = u >> 5, b = (u >> 4) & 1, e = u & 15;
        const int n = kind ? CTXL : SEQ, cap = n / 8, sbase = kind ? SEQ : 0;
        const float* ap = AFF + ((size_t)b * 16 + e) * SB + sbase;
        unsigned key[16];
#pragma unroll
        for (int i4 = 0; i4 < 4; ++i4) { const int t = 16 * F.tid + 4 * i4; v4u x = {0u, 0u, 0u, 0u}; if (t < n) x = *(const v4u*)(ap + t); key[4 * i4] = x.x; key[4 * i4 + 1] = x.y; key[4 * i4 + 2] = x.z; key[4 * i4 + 3] = x.w; }
        const bool tv = (16 * F.tid < n);
        BSYNC();
        unsigned T = 0u; int itc = 0;
        for (int bit = 31; bit >= 0; --bit) { const unsigned cand = T | (1u << bit); int cnt = 0;
#pragma unroll
            for (int i = 0; i < 16; ++i) cnt += (tv && key[i] >= cand) ? 1 : 0;
            if (block_count(cnt, slot, itc++, F.wave, F.lane) >= cap) T = cand; }
        int cgt = 0, ceq = 0;
#pragma unroll
        for (int i = 0; i < 16; ++i) { cgt += (tv && key[i] > T) ? 1 : 0; ceq += (tv && key[i] == T) ? 1 : 0; }
        int tot_gt, tot_eq; (void)block_excl_scan(cgt, wtot, F.wave, F.lane, tot_gt);
        int eqrank = block_excl_scan(ceq, wtot, F.wave, F.lane, tot_eq);
        const int need = cap - tot_gt;
        unsigned selmask = 0u; int csel = 0;
#pragma unroll
        for (int i = 0; i < 16; ++i) { bool sel = false; if (tv) { if (key[i] > T) sel = true; else if (key[i] == T) { sel = eqrank < need; ++eqrank; } } if (sel) { selmask |= 1u << i; ++csel; } }
        int tot_sel; int sl = block_excl_scan(csel, wtot, F.wave, F.lane, tot_sel);
        if (tv) {
#pragma unroll
            for (int i = 0; i < 16; ++i) { const int t = 16 * F.tid + i; const int row = b * SB + sbase + t; int r1 = 0;
                if (selmask & (1u << i)) { const int rr = (kind ? 2048 + b * 32 : b * 1024) + sl; ++sl; IDX[e * ROWS_E + rr] = row; VAL[e * ROWS_E + rr] = __uint_as_float(key[i]); r1 = rr + 1; }
                INV[(size_t)row * 16 + e] = r1; }
        }
    }
}
__device__ __forceinline__ void ph_gather(const Fr& F, const Args& A, int l) {
    const int* IDX = (const int*)(A.ws + WS_IDX); const bf16* HN = (const bf16*)(A.ws + WS_HN); bf16* XG = (bf16*)(A.ws + WS_XG);
    const int gw = F.bid * NWAVES + F.wave, NGW = F.G * NWAVES; const int nr = (l == DEPTH - 1) ? 2048 : 2112;
    for (int it = gw; it < NE * nr; it += NGW) { const int e = it / nr, r = it % nr; const int row = IDX[e * ROWS_E + r];
        const v4u* src = (const v4u*)(HN + (size_t)row * DM) + F.lane; v4u* dst = (v4u*)(XG + ((size_t)e * ROWS_E + r) * DM) + F.lane;
        dst[0] = src[0]; dst[64] = src[64]; }
}

constexpr int NPH_PRO = 3, NPH_LAYER = 11, NPH = NPH_PRO + DEPTH * NPH_LAYER;
template <unsigned KMASK> __global__ void __launch_bounds__(NTHR, 2) mk_fwd(Args args) {
    extern __shared__ __attribute__((aligned(16))) unsigned char lds[];
    Fr F; F.lds = (LAS unsigned char*)lds; F.tid = threadIdx.x; F.lane = F.tid & 63; F.wave = __builtin_amdgcn_readfirstlane(F.tid >> 6); F.G = gridDim.x; F.bid = blockIdx.x;
    unsigned char* ws = args.ws;
    for (int u = F.tid; u < (LDS_BYTES - LDSCTL_OFF) / 4; u += NTHR) ((LAS unsigned*)(F.lds + LDSCTL_OFF))[u] = 0u;
    __syncthreads();
#if MK_SINGLE
    XcdBarrier bar = xcd_barrier_post((unsigned*)(ws + WS_CTL) + 1024, (volatile LAS unsigned*)(F.lds + MISC_OFF) + 8);
#define GRID_BAR() xcd_barrier(bar)
#else
#define GRID_BAR() do {} while (0)
#endif
    const int lo = args.ph_lo, hi = args.ph_hi;
#define IN(k) (lo <= (k) && (k) < hi)
#define KIND(q) if constexpr ((KMASK >> (q)) & 1u)
#define SEAM(k) do { if (IN(k) && IN((k) + 1)) GRID_BAR(); } while (0)
    KIND(0) if (IN(0)) { ph_convert(F, args); } SEAM(0);
    KIND(1) if (IN(1)) { ph_filters(F, args); } SEAM(1);
    KIND(2) if (IN(2)) { ph_ln_a0(F, args); } SEAM(2);
    for (int l = 0; l < DEPTH; ++l) {
        const int pb = NPH_PRO + l * NPH_LAYER; const bool lastl = (l == DEPTH - 1);
        KIND(3) if (IN(pb + 0)) {
            pg8::Gemm g{(const pg8::bf16_t*)(ws + WS_HN), (const pg8::bf16_t*)(ws + WS_WINT) + (size_t)l * NWIN * DM, MT, NWIN, DM}; pg8::StaticOrder S; S.init(MT, NWIN, F.G, F.bid);
            EpiWin E{(bf16*)(ws + WS_P1), (float*)(ws + WS_HY)};
            pg8::gemm_phase<EpiWin, pg8::StaticOrder, PG8_ALIGN, PG8_SP2>(F.lds + RING_OFF, g, S, E);
        } SEAM(pb + 0);
        KIND(4) if (IN(pb + 1)) {
#ifndef SKIP_PREP
            ph_attn_prep(F, args, l);
#endif
#ifndef SKIP_M1
            ph_mlstm_local(F, args, l);
#endif
#ifndef SKIP_HY
            ph_hyena(F, args, l);
#endif
        } SEAM(pb + 1);
        KIND(5) if (IN(pb + 2)) { ph_mlstm_carry(F, args); ph_attention(F, args, l, lds); } SEAM(pb + 2);
        KIND(6) if (IN(pb + 3)) { ph_mlstm_out(F, args, l); } SEAM(pb + 3);
        KIND(7) if (IN(pb + 4)) {
            pg8::Gemm g{(const pg8::bf16_t*)(ws + WS_Y), (const pg8::bf16_t*)(ws + WS_WOUTT) + (size_t)l * DM * DM, MT, DM, DM};
            WoutOrder S; S.ntile = lastl ? 64 : 66; S.skipctx = lastl ? 1 : 0; S.G = F.G; S.c = F.bid;
            EpiF32g E{(float*)(ws + WS_MIX), DM, 4};
            pg8::gemm_phase<EpiF32g, WoutOrder, PG8_ALIGN, PG8_SP2>(F.lds + RING_OFF, g, S, E);
        } SEAM(pb + 4);
        KIND(8) if (IN(pb + 5)) { ph_ln_b(F, args, l); } SEAM(pb + 5);
        KIND(9) if (IN(pb + 6)) { ph_select(F, args, l); } SEAM(pb + 6);
        KIND(10) if (IN(pb + 7)) { ph_gather(F, args, l); } SEAM(pb + 7);
        KIND(11) if (IN(pb + 8)) {
            pg8::Gemm g{(const pg8::bf16_t*)(ws + WS_XG), (const pg8::bf16_t*)(ws + WS_W1T) + (size_t)l * NE * (2 * FF) * DM, NE * ROWS_E, NE * 2 * FF, DM};
            GroupOrder S; S.nMe = lastl ? 8 : 9; S.nN = NT1; S.G = F.G; S.c = F.bid;
            EpiSwiglu E{(bf16*)(ws + WS_ACT)};
            pg8::gemm_phase<EpiSwiglu, GroupOrder, PG8_ALIGN, PG8_SP2>(F.lds + RING_OFF, g, S, E);
        } SEAM(pb + 8);
        KIND(12) if (IN(pb + 9)) {
            pg8::Gemm g{(const pg8::bf16_t*)(ws + WS_ACT), (const pg8::bf16_t*)(ws + WS_W2T) + (size_t)l * NE * DM * FF, NE * ROWS_E, NE * DM, FF};
            GroupOrder S; S.nMe = lastl ? 8 : 9; S.nN = 4; S.G = F.G; S.c = F.bid;
            EpiF32g E{(float*)(ws + WS_YE), DM, 4};
            pg8::gemm_phase<EpiF32g, GroupOrder, PG8_ALIGN, PG8_SP2>(F.lds + RING_OFF, g, S, E);
        } SEAM(pb + 9);
        KIND(13) if (IN(pb + 10)) { ph_ln_c(F, args, l); } if (!lastl) SEAM(pb + 10);
    }
#undef IN
#undef SEAM
#undef KIND
}

constexpr int kind_of_phase(int k) { return k < NPH_PRO ? k : 3 + (k - NPH_PRO) % NPH_LAYER; }
typedef void (*kern_t)(Args);
template <int Q> static kern_t kern_for_kind(int q) { if (q == Q) return mk_fwd<(1u << Q)>; if constexpr (Q + 1 < 14) return kern_for_kind<Q + 1>(q); else return nullptr; }
extern "C" void kernel_launch(void* const* d_in, const int* in_sizes, int n_in, void* d_out, int out_size, void* d_ws, size_t ws_size, hipStream_t stream) {
    static int grid = 0;
    if (grid == 0) {
        if (n_in != 32 || in_sizes[0] != NB * SEQ * DM || out_size != NB * SEQ * DM || ws_size < WS_END) { fprintf(stderr, "kernel_launch: unexpected shapes / workspace (n_in %d, ws %zu < %zu)\n", n_in, ws_size, (size_t)WS_END); grid = -1; return; }
        int dev = 0, cus = 0;
        if (hipGetDevice(&dev) != hipSuccess || hipDeviceGetAttribute(&cus, hipDeviceAttributeMultiprocessorCount, dev) != hipSuccess) { grid = -1; return; }
#if MK_SINGLE
        if (hipFuncSetAttribute((const void*)mk_fwd<0x3fffu>, hipFuncAttributeMaxDynamicSharedMemorySize, LDS_BYTES) != hipSuccess) { fprintf(stderr, "kernel_launch: hipFuncSetAttribute failed\n"); grid = -1; return; }
#else
        for (int q = 0; q < 14; ++q) if (hipFuncSetAttribute((const void*)kern_for_kind<0>(q), hipFuncAttributeMaxDynamicSharedMemorySize, LDS_BYTES) != hipSuccess) { fprintf(stderr, "kernel_launch: hipFuncSetAttribute failed\n"); grid = -1; return; }
#endif
        (void)hipGetLastError();
        grid = cus;
    }
    if (grid < 0) return;
    if (hipMemsetAsync((char*)d_ws + WS_CTL, 0, CTL_ZERO_BYTES, stream) != hipSuccess) return;
    Args a{};
    for (int i = 0; i < 32; ++i) a.in[i] = (const float*)d_in[i];
    a.out = (float*)d_out; a.ws = (unsigned char*)d_ws;
#if MK_SINGLE
    a.ph_lo = 0; a.ph_hi = NPH;
    hipLaunchKernelGGL(mk_fwd<0x3fffu>, dim3(grid), dim3(NTHR), LDS_BYTES, stream, a);
#else
    for (int k = 0; k < NPH; ++k) { a.ph_lo = k; a.ph_hi = k + 1; kern_t f = kern_for_kind<0>(kind_of_phase(k)); hipLaunchKernelGGL(f, dim3(grid), dim3(NTHR), LDS_BYTES, stream, a); }
#endif
}
```

```cpp
#include <hip/hip_runtime.h>
#include <hip/hip_bf16.h>
#include <cstdio>
#include <cstdint>
#include <cmath>

#ifndef MK_SINGLE
#define MK_SINGLE 1
#endif

namespace pg8 {
#define PG8_LAS __attribute__((address_space(3)))
typedef unsigned short bf16_t;
typedef short bf16x8 __attribute__((ext_vector_type(8)));
typedef float f32x4 __attribute__((ext_vector_type(4)));
typedef unsigned u32x4 __attribute__((ext_vector_type(4)));
constexpr int BM = 256, BK = 64, HALF = 128, HTB = HALF * BK * 2  , STAGE_BYTES = 8 * HTB, NXCD = 8, WGM = 8;

__host__ __device__ __forceinline__ int lds_byte(int r, int c) { const int st = (r >> 4) * 2 + (c >> 5), rr = r & 15, cc = c & 31, ob = rr * 64 + cc * 2; return st * 1024 + (ob ^ (((ob >> 9) & 1) << 5)); }
__host__ __device__ __forceinline__ void stage_rc(int b, int& R, int& C) { const int st = b / 1024, sb = b % 1024, swz = sb ^ (((sb >> 9) & 1) << 5); R = (st >> 1) * 16 + swz / 64; C = (st & 1) * 32 + (swz % 64) / 2; }
__host__ __device__ __forceinline__ int perm32(int rho) { const int n = rho >> 4, i = rho & 15; return 8 * (i >> 2) + 4 * n + (i & 3); }

struct Unit { int pm, pn; };
struct Gemm { const bf16_t* A; const bf16_t* Bt; int M, N, K; };

struct StaticOrder {
    int nM, nN, nwg, G, c;
    __host__ __device__ void init(int M, int N, int G_, int c_) { nM = M / BM; nN = N / BM; nwg = nM * nN; G = G_; c = c_; }
    __host__ __device__ bool next(int i, Unit& u) const {
        const long L = (long)i * G + c; if (L >= nwg) return false;
        int wgid = (int)L; { const int q = nwg / NXCD, r = nwg % NXCD, xcd = wgid % NXCD, off = wgid / NXCD; wgid = (xcd < r ? xcd * (q + 1) : r * (q + 1) + (xcd - r) * q) + off; }
        const int nig = WGM * nN, gid = wgid / nig, fm = gid * WGM, gsz = (nM - fm) < WGM ? (nM - fm) : WGM;
        u.pm = fm + ((wgid % nig) % gsz); u.pn = (wgid % nig) / gsz; return true;
    }
    __device__ __forceinline__ void a_ready(const Unit&) const {}
    __device__ __forceinline__ void done(const Unit&) const {}
};

__device__ __forceinline__ unsigned cvt_pk_bf16(float lo, float hi) { unsigned r; asm volatile("v_cvt_pk_bf16_f32 %0, %1, %2" : "=v"(r) : "v"(lo), "v"(hi)); return r; }
typedef float f32x2 __attribute__((ext_vector_type(2)));
__device__ __forceinline__ f32x2 gelu_pk(f32x2 v) {
    const f32x2 av = __builtin_elementwise_abs(v), d = av * 0.2316418882f + 1.0f;
    f32x2 t; t.x = __builtin_amdgcn_rcpf(d.x); t.y = __builtin_amdgcn_rcpf(d.y);
    f32x2 q = t * 0.5307027145f + (-0.7265760135f); q = q * t + 0.7107068705f; q = q * t + (-0.142248368f); q = q * t + 0.127414796f; q = q * t;
    const f32x2 s = (v * v) * (-0.72134752044f);
    f32x2 e; e.x = __builtin_amdgcn_exp2f(s.x); e.y = __builtin_amdgcn_exp2f(s.y);
    const f32x2 m = v * (q * e), r = v - m;
    f32x2 o; o.x = v.x < 0.f ? m.x : r.x; o.y = v.y < 0.f ? m.y : r.y; return o;
}

template <int ACT  > struct EpiBf16 {
    static constexpr bool PERM = true, AFTER_DRAIN = false; static_assert(ACT == 0 || ACT == 1, "EpiBf16: ACT is 0 (none) or 1 (gelu_pk)");
    bf16_t* O; int ldc; const float* bias; int split_cols; size_t split_stride; float scale0;
    __device__ __forceinline__ void operator()(const f32x4 (&acc)[2][2][4][2], const Unit& u, int wr, int wc, int fr, int fq) const {
        const int row0 = u.pm * BM + wr * 64 + fr; int colt = u.pn * BM; bf16_t* base = O;
        float sc = 1.f; if (split_cols) { const int t = colt / split_cols; base += (size_t)t * split_stride; colt -= t * split_cols; if (t == 0) sc = scale0; }
        const int col0 = colt + wc * 32 + 8 * fq, bcol0 = u.pn * BM + wc * 32 + 8 * fq;
        f32x4 bv[2][2];
#pragma unroll
        for (int bj = 0; bj < 2; ++bj)
#pragma unroll
            for (int n = 0; n < 2; ++n) bv[bj][n] = bias ? *(const f32x4*)(bias + bcol0 + bj * HALF + 4 * n) : (f32x4){0.f, 0.f, 0.f, 0.f};
#pragma unroll
        for (int ai = 0; ai < 2; ++ai)
#pragma unroll
            for (int m = 0; m < 4; ++m) { bf16_t* rowp = base + (size_t)(row0 + ai * HALF + m * 16) * ldc + col0;
#pragma unroll
                for (int bj = 0; bj < 2; ++bj) { f32x4 v0 = acc[ai][bj][m][0] + bv[bj][0], v1 = acc[ai][bj][m][1] + bv[bj][1];
                    if (ACT == 1) { f32x2 a = gelu_pk((f32x2){v0[0], v0[1]}), b = gelu_pk((f32x2){v0[2], v0[3]}), c = gelu_pk((f32x2){v1[0], v1[1]}), d = gelu_pk((f32x2){v1[2], v1[3]});
                        v0 = (f32x4){a.x, a.y, b.x, b.y}; v1 = (f32x4){c.x, c.y, d.x, d.y}; }
                    v0 = v0 * sc; v1 = v1 * sc; u32x4 w; w.x = cvt_pk_bf16(v0[0], v0[1]); w.y = cvt_pk_bf16(v0[2], v0[3]); w.z = cvt_pk_bf16(v1[0], v1[1]); w.w = cvt_pk_bf16(v1[2], v1[3]);
                    *(u32x4*)(rowp + bj * HALF) = w; } }
    }
};


template <class Epi, class Sched, bool ALIGN_EPI = false, bool SP2 = false>
__device__ __forceinline__ void gemm_phase(PG8_LAS unsigned char* lds, const Gemm g, const Sched& S, const Epi& E, const int tid) {
    const int wid = __builtin_amdgcn_readfirstlane(tid >> 6), lane = tid & 63, wr = wid >> 2, wc = wid & 3, fr = lane & 15, fq = lane >> 4;
    const int K = g.K, nt = K / BK;
    unsigned voffA[2], voffB[2];
#pragma unroll
    for (int i = 0; i < 2; ++i) { int R, C; stage_rc(tid * 16 + i * 8192, R, C); const int Rb = Epi::PERM ? ((R & ~31) + perm32(R & 31)) : R;
        voffA[i] = (unsigned)(R * K + C) * 2u; voffB[i] = (unsigned)(Rb * K + C) * 2u; }
    const size_t kstep = (size_t)(BK * 2);
    const size_t hstep = (size_t)HALF * K * 2;
    const size_t tstep = 2 * hstep;
    const unsigned ldsw = (unsigned)wid * 1024u;
    const int aoff = lds_byte(wr * 64 + fr, fq * 8), boff = lds_byte(wc * 32 + fr, fq * 8);
#define PG8_SA(b, h) (((b) * 2 + (h)) * HTB)
#define PG8_SB(b, h) ((4 + (b) * 2 + (h)) * HTB)
#define PG8_STAGE(bufoff, gbase, voff) do { _Pragma("unroll") for (int _i = 0; _i < 2; ++_i) \
        __builtin_amdgcn_global_load_lds((const unsigned*)((const char*)(gbase) + (voff)[_i]), (PG8_LAS unsigned*)(lds + (bufoff) + ldsw + _i * 8192), 16, 0, 0); } while (0)
#define PG8_LDA(dst, b, h) do { _Pragma("unroll") for (int m = 0; m < 4; ++m) _Pragma("unroll") for (int k = 0; k < 2; ++k) dst[m][k] = *(const PG8_LAS bf16x8*)(lds + PG8_SA(b, h) + aoff + m * 2048 + k * 1024); } while (0)
#define PG8_LDB(dst, b, h) do { _Pragma("unroll") for (int n = 0; n < 2; ++n) _Pragma("unroll") for (int k = 0; k < 2; ++k) dst[n][k] = *(const PG8_LAS bf16x8*)(lds + PG8_SB(b, h) + boff + n * 2048 + k * 1024); } while (0)
#define PG8_MMA(ai, bj, At, Bt) do { __builtin_amdgcn_s_setprio(1); _Pragma("unroll") for (int m = 0; m < 4; ++m) _Pragma("unroll") for (int n = 0; n < 2; ++n) _Pragma("unroll") for (int k = 0; k < 2; ++k) \
        acc[ai][bj][m][n] = __builtin_amdgcn_mfma_f32_16x16x32_bf16(Bt[n][k], At[m][k], acc[ai][bj][m][n], 0, 0, 0); __builtin_amdgcn_s_setprio(0); } while (0)
#define PG8_WAIT_V(n) asm volatile("s_waitcnt vmcnt(" #n ")" ::: "memory")
#define PG8_WAIT_L(n) asm volatile("s_waitcnt lgkmcnt(" #n ")" ::: "memory")
#define PG8_BAR __builtin_amdgcn_s_barrier()
#define PG8_SCHED __builtin_amdgcn_sched_barrier(0)
    Unit cur, nxt; int ui = 0;
    if (!S.next(0, cur)) return;
    f32x4 acc[2][2][4][2];
#pragma unroll
    for (int a = 0; a < 2; ++a)
#pragma unroll
        for (int b = 0; b < 2; ++b)
#pragma unroll
            for (int m = 0; m < 4; ++m)
#pragma unroll
                for (int n = 0; n < 2; ++n) acc[a][b][m][n] = (f32x4){0.f, 0.f, 0.f, 0.f};
    bf16x8 At[4][2], B0[2][2], B1[2][2];
    const char* cA = (const char*)g.A + (size_t)cur.pm * tstep; const char* cB = (const char*)g.Bt + (size_t)cur.pn * tstep;
    S.a_ready(cur);
    if constexpr (SP2) {
        PG8_STAGE(PG8_SB(0, 0), cB, voffB); PG8_STAGE(PG8_SB(0, 1), cB + hstep, voffB); PG8_STAGE(PG8_SA(0, 0), cA, voffA); PG8_STAGE(PG8_SA(0, 1), cA + hstep, voffA);
        if (wr == 1) PG8_BAR;
        PG8_WAIT_V(2); PG8_BAR;
        PG8_STAGE(PG8_SB(1, 0), cB + kstep, voffB); PG8_STAGE(PG8_SA(1, 0), cA + kstep, voffA); PG8_STAGE(PG8_SB(1, 1), cB + hstep + kstep, voffB);
        PG8_WAIT_V(6); PG8_BAR;
    } else {
        PG8_STAGE(PG8_SB(0, 0), cB, voffB); PG8_STAGE(PG8_SA(0, 0), cA, voffA); PG8_STAGE(PG8_SB(0, 1), cB + hstep, voffB); PG8_STAGE(PG8_SA(0, 1), cA + hstep, voffA);
        if (wr == 1) PG8_BAR;
        PG8_WAIT_V(4); PG8_BAR;
        PG8_STAGE(PG8_SB(1, 0), cB + kstep, voffB); PG8_STAGE(PG8_SA(1, 0), cA + kstep, voffA); PG8_STAGE(PG8_SB(1, 1), cB + hstep + kstep, voffB);
        PG8_WAIT_V(6); PG8_BAR;
    }
    for (;;) {
        const bool has_next = S.next(ui + 1, nxt);
        const char* nA = has_next ? (const char*)g.A + (size_t)nxt.pm * tstep : cA; const char* nB = has_next ? (const char*)g.Bt + (size_t)nxt.pn * tstep : cB;
        for (int t = 0; t < nt; t += 2) {
            const bool last = (t == nt - 2);
            const char* a1 = cA + (size_t)(t + 1) * kstep;
            const char* a2 = last ? nA : cA + (size_t)(t + 2) * kstep; const char* b2 = last ? nB : cB + (size_t)(t + 2) * kstep;
            const char* a3 = a2 + kstep; const char* b3 = b2 + kstep;
            if (last && has_next) S.a_ready(nxt);
            if constexpr (SP2) {
            PG8_LDB(B0, 0, 0); PG8_LDB(B1, 0, 1); PG8_SCHED; PG8_LDA(At, 0, 0); PG8_STAGE(PG8_SA(1, 1), a1 + hstep, voffA);
            PG8_WAIT_V(8); PG8_WAIT_L(0); PG8_BAR; PG8_MMA(0, 0, At, B0); PG8_MMA(0, 1, At, B1); PG8_BAR; PG8_SCHED;
            PG8_LDA(At, 0, 1); PG8_STAGE(PG8_SB(0, 0), b2, voffB); PG8_STAGE(PG8_SB(0, 1), b2 + hstep, voffB); PG8_STAGE(PG8_SA(0, 0), a2, voffA);
            PG8_WAIT_V(8); PG8_WAIT_L(0); PG8_BAR; PG8_MMA(1, 0, At, B0); PG8_MMA(1, 1, At, B1); PG8_BAR; PG8_SCHED;
            PG8_LDB(B0, 1, 0); PG8_LDB(B1, 1, 1); PG8_SCHED; PG8_LDA(At, 1, 0); PG8_STAGE(PG8_SA(0, 1), a2 + hstep, voffA);
            PG8_WAIT_V(8); PG8_WAIT_L(0); PG8_BAR; PG8_MMA(0, 0, At, B0); PG8_MMA(0, 1, At, B1); PG8_BAR; PG8_SCHED;
            PG8_LDA(At, 1, 1); PG8_STAGE(PG8_SB(1, 0), b3, voffB); PG8_STAGE(PG8_SB(1, 1), b3 + hstep, voffB); PG8_STAGE(PG8_SA(1, 0), a3, voffA);
            PG8_WAIT_V(8); PG8_WAIT_L(0); PG8_BAR; PG8_MMA(1, 0, At, B0); PG8_MMA(1, 1, At, B1); PG8_BAR; PG8_SCHED;
            } else {
            PG8_LDB(B0, 0, 0); PG8_SCHED; PG8_LDA(At, 0, 0); PG8_STAGE(PG8_SA(1, 1), a1 + hstep, voffA);
            PG8_WAIT_L(8); PG8_BAR; PG8_WAIT_L(0); PG8_MMA(0, 0, At, B0); PG8_BAR; PG8_SCHED;
            PG8_LDB(B1, 0, 1); PG8_STAGE(PG8_SB(0, 0), b2, voffB);
            PG8_BAR; PG8_WAIT_L(0); PG8_MMA(0, 1, At, B1); PG8_BAR;
            PG8_LDA(At, 0, 1); PG8_STAGE(PG8_SA(0, 0), a2, voffA);
            PG8_BAR; PG8_WAIT_L(0); PG8_MMA(1, 0, At, B0); PG8_BAR; PG8_SCHED;
            PG8_STAGE(PG8_SB(0, 1), b2 + hstep, voffB);
            PG8_WAIT_V(6); PG8_BAR; PG8_MMA(1, 1, At, B1); PG8_BAR;
            PG8_LDB(B0, 1, 0); PG8_SCHED; PG8_LDA(At, 1, 0); PG8_STAGE(PG8_SA(0, 1), a2 + hstep, voffA);
            PG8_WAIT_L(8); PG8_BAR; PG8_WAIT_L(0); PG8_MMA(0, 0, At, B0); PG8_BAR; PG8_SCHED;
            PG8_LDB(B1, 1, 1); PG8_STAGE(PG8_SB(1, 0), b3, voffB);
            PG8_BAR; PG8_WAIT_L(0); PG8_MMA(0, 1, At, B1); PG8_BAR;
            PG8_LDA(At, 1, 1); PG8_STAGE(PG8_SA(1, 0), a3, voffA);
            PG8_BAR; PG8_WAIT_L(0); PG8_MMA(1, 0, At, B0); PG8_BAR; PG8_SCHED;
            PG8_STAGE(PG8_SB(1, 1), b3 + hstep, voffB);
            PG8_WAIT_V(6); PG8_BAR; PG8_MMA(1, 1, At, B1); PG8_BAR;
            }
        }
        if constexpr (ALIGN_EPI) { if (wr == 0) PG8_BAR; }
        if constexpr (!Epi::AFTER_DRAIN) { E(acc, cur, wr, wc, fr, fq); S.done(cur); }
        if (!has_next) break;
#pragma unroll
        for (int a = 0; a < 2; ++a)
#pragma unroll
            for (int b = 0; b < 2; ++b)
#pragma unroll
                for (int m = 0; m < 4; ++m)
#pragma unroll
                    for (int n = 0; n < 2; ++n) acc[a][b][m][n] = (f32x4){0.f, 0.f, 0.f, 0.f};
        cur = nxt; cA = nA; cB = nB; ++ui;
        if constexpr (ALIGN_EPI) { if (wr == 1) PG8_BAR; }
    }
    PG8_WAIT_V(0);
    if constexpr (!ALIGN_EPI) { if (wr == 0) PG8_BAR; }
    PG8_BAR;
    if constexpr (Epi::AFTER_DRAIN) { E.fused(acc, cur, wr, wc, fr, fq, lds, wid, lane); S.done(cur); }
#undef PG8_SA
#undef PG8_SB
#undef PG8_STAGE
#undef PG8_LDA
#undef PG8_LDB
#undef PG8_MMA
#undef PG8_WAIT_V
#undef PG8_WAIT_L
#undef PG8_BAR
#undef PG8_SCHED
}
}

#ifndef PG8_SP2
#define PG8_SP2 true
#endif
#ifndef PG8_ALIGN
#define PG8_ALIGN true
#endif

namespace pg8 {
__host__ __device__ __forceinline__ int swz8(int q) { return (4 - q) & 3; }
__host__ __device__ __forceinline__ void stage_rc8(int b, int& R, int& Cb) { const int blk = b >> 10, d = (b & 1023) >> 4; R = (blk >> 1) * 16 + (d >> 2); Cb = 64 * (blk & 1) + 16 * ((d & 3) ^ swz8(d >> 4)); }
typedef int v8i32 __attribute__((ext_vector_type(8)));
typedef int v4i32 __attribute__((ext_vector_type(4)));
struct Gemm8 { const unsigned char* A; const unsigned char* Bt; int M, N, K; int scale_b; const PG8_LAS unsigned short* idx; };
template <class Epi, class Sched, bool ALIGN_EPI = false, bool SP2 = false, bool GATHER = false>
__device__ __forceinline__ void gemm_phase8(PG8_LAS unsigned char* lds, const Gemm8 g, const Sched& S, const Epi& E, const int tid) {
    const int wid = __builtin_amdgcn_readfirstlane(tid >> 6), lane = tid & 63, wr = wid >> 2, wc = wid & 3, fr = lane & 15, fq = lane >> 4;
    const int K = g.K, nt = K / 128;
    unsigned voffA[2], voffB[2]; int RA[2], CA[2];
#pragma unroll
    for (int i = 0; i < 2; ++i) { int R, C; stage_rc8(tid * 16 + i * 8192, R, C); const int Rb = Epi::PERM ? ((R & ~31) + perm32(R & 31)) : R;
        voffA[i] = (unsigned)(R * K + C); voffB[i] = (unsigned)(Rb * K + C); RA[i] = R; CA[i] = C; }
    const size_t kstep = (size_t)(BK * 2);
    const size_t hstep = (size_t)HALF * K;
    const size_t tstep = 2 * hstep;
#define PG8_AOFF(dst, u) do { _Pragma("unroll") for (int h_ = 0; h_ < 2; ++h_) _Pragma("unroll") for (int i_ = 0; i_ < 2; ++i_) { \
        if constexpr (GATHER) { const int e_ = (u).pm / 9, mt_ = (u).pm - e_ * 9; const unsigned r_ = g.idx[(e_ >> 3) * 2304 + mt_ * 256 + h_ * 128 + RA[i_]]; dst[h_][i_] = r_ * (unsigned)K + (unsigned)CA[i_]; } \
        else dst[h_][i_] = voffA[i_] + (unsigned)(h_ * hstep); } } while (0)
    const unsigned ldsw = (unsigned)wid * 1024u;
    const int roff = (4 * fr + (fq ^ swz8(fr >> 2))) * 16;
    const int aoff0 = (wr * 8) * 1024 + roff, aoff1 = aoff0 + 1024, boff0 = (wc * 4) * 1024 + roff, boff1 = boff0 + 1024;
#define PG8_SA(b, h) (((b) * 2 + (h)) * HTB)
#define PG8_SB(b, h) ((4 + (b) * 2 + (h)) * HTB)
#define PG8_STAGE(bufoff, gbase, voff) do { _Pragma("unroll") for (int _i = 0; _i < 2; ++_i) \
        __builtin_amdgcn_global_load_lds((const unsigned*)((const char*)(gbase) + (voff)[_i]), (PG8_LAS unsigned*)(lds + (bufoff) + ldsw + _i * 8192), 16, 0, 0); } while (0)
#define PG8_LDA(dst, b, h) do { _Pragma("unroll") for (int m = 0; m < 4; ++m) { const v4i32 lo_ = __builtin_bit_cast(v4i32, *(const PG8_LAS bf16x8*)(lds + PG8_SA(b, h) + aoff0 + m * 2048)), hi_ = __builtin_bit_cast(v4i32, *(const PG8_LAS bf16x8*)(lds + PG8_SA(b, h) + aoff1 + m * 2048)); dst[m] = __builtin_shufflevector(lo_, hi_, 0, 1, 2, 3, 4, 5, 6, 7); } } while (0)
#define PG8_LDB(dst, b, h) do { _Pragma("unroll") for (int n = 0; n < 2; ++n) { const v4i32 lo_ = __builtin_bit_cast(v4i32, *(const PG8_LAS bf16x8*)(lds + PG8_SB(b, h) + boff0 + n * 2048)), hi_ = __builtin_bit_cast(v4i32, *(const PG8_LAS bf16x8*)(lds + PG8_SB(b, h) + boff1 + n * 2048)); dst[n] = __builtin_shufflevector(lo_, hi_, 0, 1, 2, 3, 4, 5, 6, 7); } } while (0)
#define PG8_MMA(ai, bj, At, Bt) do { __builtin_amdgcn_s_setprio(1); _Pragma("unroll") for (int m = 0; m < 4; ++m) _Pragma("unroll") for (int n = 0; n < 2; ++n) \
        asm volatile("v_mfma_scale_f32_16x16x128_f8f6f4 %0, %1, %2, %0, %3, %4 op_sel_hi:[0,0,0]" : "+v"(acc[ai][bj][m][n]) : "v"(Bt[n]), "v"(At[m]), "v"(sc_b), "v"(sc_a)); __builtin_amdgcn_s_setprio(0); } while (0)
#define PG8_ACCFENCE() do { _Pragma("unroll") for (int a_ = 0; a_ < 2; ++a_) _Pragma("unroll") for (int b_ = 0; b_ < 2; ++b_) \
        asm volatile("s_nop 15\n\ts_nop 15" : "+v"(acc[a_][b_][0][0]), "+v"(acc[a_][b_][0][1]), "+v"(acc[a_][b_][1][0]), "+v"(acc[a_][b_][1][1]), "+v"(acc[a_][b_][2][0]), "+v"(acc[a_][b_][2][1]), "+v"(acc[a_][b_][3][0]), "+v"(acc[a_][b_][3][1])); } while (0)
#define PG8_WAIT_V(n) asm volatile("s_waitcnt vmcnt(" #n ")" ::: "memory")
#define PG8_WAIT_L(n) asm volatile("s_waitcnt lgkmcnt(" #n ")" ::: "memory")
#define PG8_BAR __builtin_amdgcn_s_barrier()
#define PG8_SCHED __builtin_amdgcn_sched_barrier(0)
    const int sc_b = g.scale_b, sc_a = 0x7f7f7f7f;
    Unit cur, nxt; int ui = 0;
    if (!S.next(0, cur)) return;
    f32x4 acc[2][2][4][2];
#pragma unroll
    for (int a = 0; a < 2; ++a)
#pragma unroll
        for (int b = 0; b < 2; ++b)
#pragma unroll
            for (int m = 0; m < 4; ++m)
#pragma unroll
                for (int n = 0; n < 2; ++n) acc[a][b][m][n] = (f32x4){0.f, 0.f, 0.f, 0.f};
    v8i32 At[4], B0[2], B1[2];
    const char* cA = (const char*)g.A + (GATHER ? (size_t)0 : (size_t)cur.pm * tstep); const char* cB = (const char*)g.Bt + (size_t)cur.pn * tstep;
    unsigned offA[2][2], noffA[2][2]; PG8_AOFF(offA, cur);
    S.a_ready(cur);
    if constexpr (SP2) {
        PG8_STAGE(PG8_SB(0, 0), cB, voffB); PG8_STAGE(PG8_SB(0, 1), cB + hstep, voffB); PG8_STAGE(PG8_SA(0, 0), cA, offA[0]); PG8_STAGE(PG8_SA(0, 1), cA, offA[1]);
        if (wr == 1) PG8_BAR;
        PG8_WAIT_V(2); PG8_BAR;
        PG8_STAGE(PG8_SB(1, 0), cB + kstep, voffB); PG8_STAGE(PG8_SA(1, 0), cA + kstep, offA[0]); PG8_STAGE(PG8_SB(1, 1), cB + hstep + kstep, voffB);
        PG8_WAIT_V(6); PG8_BAR;
    } else {
        PG8_STAGE(PG8_SB(0, 0), cB, voffB); PG8_STAGE(PG8_SA(0, 0), cA, offA[0]); PG8_STAGE(PG8_SB(0, 1), cB + hstep, voffB); PG8_STAGE(PG8_SA(0, 1), cA, offA[1]);
        if (wr == 1) PG8_BAR;
        PG8_WAIT_V(4); PG8_BAR;
        PG8_STAGE(PG8_SB(1, 0), cB + kstep, voffB); PG8_STAGE(PG8_SA(1, 0), cA + kstep, offA[0]); PG8_STAGE(PG8_SB(1, 1), cB + hstep + kstep, voffB);
        PG8_WAIT_V(6); PG8_BAR;
    }
    for (;;) {
        const bool has_next = S.next(ui + 1, nxt);
        const char* nA = (has_next && !GATHER) ? (const char*)g.A + (size_t)nxt.pm * tstep : cA; const char* nB = has_next ? (const char*)g.Bt + (size_t)nxt.pn * tstep : cB;
        if (has_next) { PG8_AOFF(noffA, nxt); } else { _Pragma("unroll") for (int h_ = 0; h_ < 2; ++h_) _Pragma("unroll") for (int i_ = 0; i_ < 2; ++i_) noffA[h_][i_] = offA[h_][i_]; }
        for (int t = 0; t < nt; t += 2) {
            const bool last = (t == nt - 2);
            const char* a1 = cA + (size_t)(t + 1) * kstep;
            const char* a2 = last ? nA : cA + (size_t)(t + 2) * kstep; const char* b2 = last ? nB : cB + (size_t)(t + 2) * kstep;
            const char* a3 = a2 + kstep; const char* b3 = b2 + kstep;
            unsigned o2[2][2]; _Pragma("unroll") for (int h_ = 0; h_ < 2; ++h_) _Pragma("unroll") for (int i_ = 0; i_ < 2; ++i_) o2[h_][i_] = last ? noffA[h_][i_] : offA[h_][i_];
            if (last && has_next) S.a_ready(nxt);
            if constexpr (SP2) {
            PG8_LDB(B0, 0, 0); PG8_LDB(B1, 0, 1); PG8_SCHED; PG8_LDA(At, 0, 0); PG8_STAGE(PG8_SA(1, 1), a1, offA[1]);
            PG8_WAIT_V(8); PG8_WAIT_L(0); PG8_BAR; PG8_MMA(0, 0, At, B0); PG8_MMA(0, 1, At, B1); PG8_BAR; PG8_SCHED;
            PG8_LDA(At, 0, 1); PG8_STAGE(PG8_SB(0, 0), b2, voffB); PG8_STAGE(PG8_SB(0, 1), b2 + hstep, voffB); PG8_STAGE(PG8_SA(0, 0), a2, o2[0]);
            PG8_WAIT_V(8); PG8_WAIT_L(0); PG8_BAR; PG8_MMA(1, 0, At, B0); PG8_MMA(1, 1, At, B1); PG8_BAR; PG8_SCHED;
            PG8_LDB(B0, 1, 0); PG8_LDB(B1, 1, 1); PG8_SCHED; PG8_LDA(At, 1, 0); PG8_STAGE(PG8_SA(0, 1), a2, o2[1]);
            PG8_WAIT_V(8); PG8_WAIT_L(0); PG8_BAR; PG8_MMA(0, 0, At, B0); PG8_MMA(0, 1, At, B1); PG8_BAR; PG8_SCHED;
            PG8_LDA(At, 1, 1); PG8_STAGE(PG8_SB(1, 0), b3, voffB); PG8_STAGE(PG8_SB(1, 1), b3 + hstep, voffB); PG8_STAGE(PG8_SA(1, 0), a3, o2[0]);
            PG8_WAIT_V(8); PG8_WAIT_L(0); PG8_BAR; PG8_MMA(1, 0, At, B0); PG8_MMA(1, 1, At, B1); PG8_BAR; PG8_SCHED;
            } else {
            PG8_LDB(B0, 0, 0); PG8_SCHED; PG8_LDA(At, 0, 0); PG8_STAGE(PG8_SA(1, 1), a1, offA[1]);
            PG8_WAIT_L(8); PG8_BAR; PG8_WAIT_L(0); PG8_MMA(0, 0, At, B0); PG8_BAR; PG8_SCHED;
            PG8_LDB(B1, 0, 1); PG8_STAGE(PG8_SB(0, 0), b2, voffB);
            PG8_BAR; PG8_WAIT_L(0); PG8_MMA(0, 1, At, B1); PG8_BAR;
            PG8_LDA(At, 0, 1); PG8_STAGE(PG8_SA(0, 0), a2, o2[0]);
            PG8_BAR; PG8_WAIT_L(0); PG8_MMA(1, 0, At, B0); PG8_BAR; PG8_SCHED;
            PG8_STAGE(PG8_SB(0, 1), b2 + hstep, voffB);
            PG8_WAIT_V(6); PG8_BAR; PG8_MMA(1, 1, At, B1); PG8_BAR;
            PG8_LDB(B0, 1, 0); PG8_SCHED; PG8_LDA(At, 1, 0); PG8_STAGE(PG8_SA(0, 1), a2, o2[1]);
            PG8_WAIT_L(8); PG8_BAR; PG8_WAIT_L(0); PG8_MMA(0, 0, At, B0); PG8_BAR; PG8_SCHED;
            PG8_LDB(B1, 1, 1); PG8_STAGE(PG8_SB(1, 0), b3, voffB);
            PG8_BAR; PG8_WAIT_L(0); PG8_MMA(0, 1, At, B1); PG8_BAR;
            PG8_LDA(At, 1, 1); PG8_STAGE(PG8_SA(1, 0), a3, o2[0]);
            PG8_BAR; PG8_WAIT_L(0); PG8_MMA(1, 0, At, B0); PG8_BAR; PG8_SCHED;
            PG8_STAGE(PG8_SB(1, 1), b3 + hstep, voffB);
            PG8_WAIT_V(6); PG8_BAR; PG8_MMA(1, 1, At, B1); PG8_BAR;
            }
        }
        if constexpr (ALIGN_EPI) { if (wr == 0) PG8_BAR; }
        PG8_ACCFENCE();
        if constexpr (!Epi::AFTER_DRAIN) { E(acc, cur, wr, wc, fr, fq); S.done(cur); }
        if (!has_next) break;
#pragma unroll
        for (int a = 0; a < 2; ++a)
#pragma unroll
            for (int b = 0; b < 2; ++b)
#pragma unroll
                for (int m = 0; m < 4; ++m)
#pragma unroll
                    for (int n = 0; n < 2; ++n) acc[a][b][m][n] = (f32x4){0.f, 0.f, 0.f, 0.f};
        cur = nxt; cA = nA; cB = nB; ++ui;
        _Pragma("unroll") for (int h_ = 0; h_ < 2; ++h_) _Pragma("unroll") for (int i_ = 0; i_ < 2; ++i_) offA[h_][i_] = noffA[h_][i_];
        if constexpr (ALIGN_EPI) { if (wr == 1) PG8_BAR; }
    }
    PG8_WAIT_V(0);
    if constexpr (!ALIGN_EPI) { if (wr == 0) PG8_BAR; }
    PG8_BAR;
    if constexpr (Epi::AFTER_DRAIN) { E.fused(acc, cur, wr, wc, fr, fq, lds, wid, lane); S.done(cur); }
#undef PG8_SA
#undef PG8_SB
#undef PG8_STAGE
#undef PG8_LDA
#undef PG8_LDB
#undef PG8_MMA
#undef PG8_AOFF
#undef PG8_ACCFENCE
#undef PG8_WAIT_V
#undef PG8_WAIT_L
#undef PG8_BAR
#undef PG8_SCHED
}
}

#include <hip/hip_bf16.h>
#include <cmath>
namespace attn_body {
using bf16=__hip_bfloat16;
using bf16x8=__attribute__((ext_vector_type(8)))short;
using s16x4=__attribute__((ext_vector_type(4)))short;
using f32x16=__attribute__((ext_vector_type(16)))float;
using u32x4=__attribute__((ext_vector_type(4)))unsigned;
constexpr int BATCH=2,NHEAD=16,SEQ=8192,D=64,DM=NHEAD*D;
constexpr int NW=8,QBLK=32,QB=QBLK*NW,KVBLK=64,NQB=SEQ/QB;
constexpr int ATTN_PITCH=DM, ATTN_UNIT_ROWS=QB;
__device__ __forceinline__ int crow(int r,int hi){return (r&3)+8*(r>>2)+4*hi;}
#define SBAR() __builtin_amdgcn_sched_barrier(0)
__device__ __forceinline__ void cmask(f32x16&p0,f32x16&p1,int jb,int qrel,int hi){
  const float NEG=-INFINITY; int kb=64*jb+4*hi;
  #pragma unroll
  for(int r=0;r<16;++r){int kv=kb+(r&3)+8*(r>>2); if(kv>qrel)p0[r]=NEG; if(kv+32>qrel)p1[r]=NEG;}
}

constexpr int NSLOT=3, SLOTB=8192;
constexpr int LDS_K=0, LDS_V=NSLOT*SLOTB, LDS_WS=2*NSLOT*SLOTB, LDS_OST=LDS_WS+NW*64*4, LDS_BYTES=LDS_OST+NW*4096;
constexpr float C2=0.125f*1.4426950408889634f;
__device__ __forceinline__ void glds16(const void*gsrc,unsigned lds_dst){unsigned keep;
  asm volatile("s_mov_b32 %0, m0\n\ts_mov_b32 m0, %2\n\ts_nop 0\n\tglobal_load_lds_dwordx4 %1, off\n\ts_mov_b32 m0, %0":"=&s"(keep):"v"(gsrc),"s"(lds_dst):"memory");}
__device__ __forceinline__ float max3f(float a,float b,float c){float r;asm("v_max3_f32 %0, %1, %2, %3":"=v"(r):"v"(a),"v"(b),"v"(c));return r;}
__device__ __forceinline__ float max2f(float a,float b){float r;asm("v_max_f32_e32 %0, %1, %2":"=v"(r):"v"(a),"v"(b));return r;}
__device__ __forceinline__ float fadd_s(float a,float b){float r;asm("v_add_f32_e32 %0, %1, %2":"=v"(r):"v"(a),"v"(b));return r;}
__device__ __forceinline__ float fsub_s(float a,float b){float r;asm("v_sub_f32_e32 %0, %1, %2":"=v"(r):"v"(a),"v"(b));return r;}
typedef float f32x2_t __attribute__((ext_vector_type(2))); typedef __bf16 bf16x2_t __attribute__((ext_vector_type(2)));
__device__ __forceinline__ unsigned cvtpk_s(float lo,float hi){f32x2_t v={lo,hi};bf16x2_t b=__builtin_convertvector(v,bf16x2_t);return __builtin_bit_cast(unsigned,b);}
#define WAIT_BAR(N) asm volatile("s_waitcnt vmcnt(" #N ") lgkmcnt(0)\n\ts_barrier":::"memory")

__device__ __forceinline__ void qkt(f32x16&p0,f32x16&p1,const char*Kslot,const bf16x8*qr,const f32x16&negm,int r32,int hi){
  const char*kb=Kslot+hi*1024+r32*16;
  #pragma unroll
  for(int d0=0;d0<4;++d0){
    const bf16x8 b0=*reinterpret_cast<const bf16x8*>(kb+d0*2048);
    const bf16x8 b1=*reinterpret_cast<const bf16x8*>(kb+d0*2048+512);
    if(d0==0){p0=__builtin_amdgcn_mfma_f32_32x32x16_bf16(b0,qr[0],negm,0,0,0);p1=__builtin_amdgcn_mfma_f32_32x32x16_bf16(b1,qr[0],negm,0,0,0);}
    else{p0=__builtin_amdgcn_mfma_f32_32x32x16_bf16(b0,qr[d0],p0,0,0,0);p1=__builtin_amdgcn_mfma_f32_32x32x16_bf16(b1,qr[d0],p1,0,0,0);}}
}
typedef __attribute__((address_space(3))) const char* lds_cptr;
typedef short v4i16_t __attribute__((ext_vector_type(4)));
__device__ __forceinline__ void kload8(bf16x8*kf,lds_cptr kp){
  kf[0]=*(const __attribute__((address_space(3))) bf16x8*)(kp);      kf[1]=*(const __attribute__((address_space(3))) bf16x8*)(kp+512);
  kf[2]=*(const __attribute__((address_space(3))) bf16x8*)(kp+2048); kf[3]=*(const __attribute__((address_space(3))) bf16x8*)(kp+2560);
  kf[4]=*(const __attribute__((address_space(3))) bf16x8*)(kp+4096); kf[5]=*(const __attribute__((address_space(3))) bf16x8*)(kp+4608);
  kf[6]=*(const __attribute__((address_space(3))) bf16x8*)(kp+6144); kf[7]=*(const __attribute__((address_space(3))) bf16x8*)(kp+6656);
}
__device__ __forceinline__ void kload2(bf16x8*kf,lds_cptr kp,int j){ kf[2*j]=*(const __attribute__((address_space(3))) bf16x8*)(kp+j*2048); kf[2*j+1]=*(const __attribute__((address_space(3))) bf16x8*)(kp+j*2048+512); }
__device__ __forceinline__ s16x4 vtr(lds_cptr p){ return __builtin_bit_cast(s16x4,__builtin_amdgcn_ds_read_tr16_b64_v4i16((__attribute__((address_space(3))) v4i16_t*)p)); }
__device__ __forceinline__ float rowmax(const f32x16&p0,const f32x16&p1){
  float a=max3f(p0[0],p0[1],p1[0]),b=max3f(p0[2],p0[3],p1[1]);a=max3f(a,p1[2],p1[3]);
  #pragma unroll
  for(int r=4;r<16;r+=4){a=max3f(a,p0[r],p0[r+1]);b=max3f(b,p0[r+2],p0[r+3]);a=max3f(a,p1[r],p1[r+1]);b=max3f(b,p1[r+2],p1[r+3]);}
  const float m=max2f(a,b);
  auto rr=__builtin_amdgcn_permlane32_swap(__float_as_uint(m),__float_as_uint(m),false,false);
  return max2f(__uint_as_float(rr[0]),__uint_as_float(rr[1]));
}
__device__ __forceinline__ void pv(f32x16*o,int vb,bf16x8 pa0,bf16x8 pa1,bf16x8 pa2,bf16x8 pa3){
  #pragma unroll
  for(int d0=0;d0<2;++d0){s16x4 lo[4],hi[4];
    #pragma unroll
    for(int ks=0;ks<4;++ks){
      asm volatile("ds_read_b64_tr_b16 %0,%1 offset:%c2":"=&v"(lo[ks]):"v"(vb),"i"(d0*4096+ks*1024):"memory");
      asm volatile("ds_read_b64_tr_b16 %0,%1 offset:%c2":"=&v"(hi[ks]):"v"(vb),"i"(d0*4096+ks*1024+512):"memory");}
    asm volatile("s_waitcnt lgkmcnt(0)":::"memory");SBAR();
    #define PK(k) (bf16x8){lo[k][0],lo[k][1],lo[k][2],lo[k][3],hi[k][0],hi[k][1],hi[k][2],hi[k][3]}
    o[d0]=__builtin_amdgcn_mfma_f32_32x32x16_bf16(pa0,PK(0),o[d0],0,0,0);
    o[d0]=__builtin_amdgcn_mfma_f32_32x32x16_bf16(pa1,PK(1),o[d0],0,0,0);
    o[d0]=__builtin_amdgcn_mfma_f32_32x32x16_bf16(pa2,PK(2),o[d0],0,0,0);
    o[d0]=__builtin_amdgcn_mfma_f32_32x32x16_bf16(pa3,PK(3),o[d0],0,0,0);
    #undef PK
  }
}

#ifndef ATTN_STORE16
#define ATTN_STORE16(p,v) (*(u32x4*)(p)=(v))
#endif
template<int THRL> __device__ __forceinline__ void attn_unit(const bf16*Qbase,const int QP,const bf16*__restrict__ Kh,const bf16*__restrict__ Vh,const int KP,const int VP,const int NT,bf16*Obase,const int OP,char*shm,const int tid){
  const int lane=tid&63,r32=lane&31,hi=lane>>5; const int wid=__builtin_amdgcn_readfirstlane(tid>>6);
  const bf16*Qw=Qbase+(long)(wid*QBLK)*QP;
  const unsigned lds0=(unsigned)(uintptr_t)shm;
  float*wsf=(float*)(shm+LDS_WS)+wid*64;
  const bf16*ksrc=Kh+(long)lane*KP+wid*8;
  const bf16*vsrc=Vh+(long)(16*(wid&3)+(lane>>2))*VP+(wid>>2)*32+(lane&3)*8;
  const unsigned kdst=lds0+LDS_K+wid*1024, vdst=lds0+LDS_V+wid*1024;
  #define DMA_K(t,slot) glds16(ksrc+(long)(t)*KVBLK*KP,(unsigned)__builtin_amdgcn_readfirstlane(kdst+(slot)))
  #define DMA_V(t,slot) glds16(vsrc+(long)(t)*KVBLK*VP,(unsigned)__builtin_amdgcn_readfirstlane(vdst+(slot)))
  const int vb0=(int)(lds0+LDS_V)+((lane>>4)&1)*32+(lane&3)*8+(4*hi+((lane&15)>>2))*64;
  const char*Kbase=shm+LDS_K; bf16x8 kf[8];
  const lds_cptr shm3=(lds_cptr)shm; const lds_cptr kp0=shm3+LDS_K+hi*1024+r32*16; const lds_cptr vp0=shm3+LDS_V+((lane>>4)&1)*32+(lane&3)*8+(4*hi+((lane&15)>>2))*64;
  DMA_K(0,0);DMA_V(0,0);DMA_K(1,SLOTB);
  bf16x8 qr[4];
  #pragma unroll
  for(int d0=0;d0<4;++d0)qr[d0]=*reinterpret_cast<const bf16x8*>(&Qw[(long)r32*QP+d0*16+hi*8]);
  f32x16 o[2];o[0]=f32x16{};o[1]=f32x16{};f32x16 o2=f32x16{};const bf16x8 ones8={0x3F80,0x3F80,0x3F80,0x3F80,0x3F80,0x3F80,0x3F80,0x3F80};    float zl_=0.f;asm volatile("":"+v"(zl_));f32x16 negm;
  _Pragma("unroll") for(int r=0;r<16;++r)negm[r]=zl_;
  asm volatile("":"+v"(negm));
  #define CMASK(P0,P1,t) do{}while(0)
  #define START(P0,P1) do{ _Pragma("unroll") for(int r=0;r<16;++r)P0[r]=__builtin_amdgcn_exp2f(P0[r]); }while(0)
  #define RESC() do{}while(0)
  f32x16 pA0,pA1,pB0,pB1;
  int sl_prev=0,sl_cur=0,sl_next=SLOTB;
  #define ROT() do{sl_prev=sl_cur;sl_cur=sl_next;sl_next=(sl_next==(NSLOT-1)*SLOTB)?0:sl_next+SLOTB;}while(0)
  DMA_K(2,2*SLOTB);
  WAIT_BAR(3);
  qkt(pA0,pA1,Kbase,qr,negm,r32,hi);asm volatile("s_nop 15\n\ts_nop 7":"+v"(pA0),"+v"(pA1));CMASK(pA0,pA1,0);
  START(pA0,pA1);
  _Pragma("unroll") for(int r=0;r<16;++r)pA1[r]=__builtin_amdgcn_exp2f(pA1[r]);
  WAIT_BAR(0);
  DMA_K(3,0);DMA_V(1,SLOTB);
  ROT();
  kload8(kf,kp0+sl_cur);
  WAIT_BAR(2);
  s16x4 vlo[8],vhi[8]; u32x4 pw0,pw1,pw2,pw3;
  #define PKW(P,B) cvtpk_s(P[B],P[B+1])
  #define PAF(k) __builtin_bit_cast(bf16x8,pw##k)
  #define VFR(i) (bf16x8){vlo[i][0],vlo[i][1],vlo[i][2],vlo[i][3],vhi[i][0],vhi[i][1],vhi[i][2],vhi[i][3]}
  #define PIN(x) asm volatile("":"+v"(x))
  #define MX3(a,b,c) __builtin_fmaxf(__builtin_fmaxf((a),(b)),(c))
  #define GAPA(MF,A0,A1,A2,A3,W0,W1,PW) do{ MF; W0; W1; PIN(PW); SBAR(); }while(0)
  #define EX(v) __builtin_amdgcn_exp2f(v)
  #define GAPB(MF,X,B) do{ MF; X[B]=EX(X[B]); X[B+1]=EX(X[B+1]); X[B+2]=EX(X[B+2]); X[B+3]=EX(X[B+3]); PIN(X); SBAR(); }while(0)
  #define VRD(i) do{ vlo[i]=vtr(vp_+(((i)>>2)*4096+((i)&3)*1024)); vhi[i]=vtr(vp_+(((i)>>2)*4096+((i)&3)*1024+512)); }while(0)
  #define KRD(G,j) do{ if(G){ kload2(kf,kp0+sl_next,j); SBAR(); } }while(0)
  #define STEP(C0,C1,P0,P1,t,GK,GV,GL) do{ SBAR(); \
    const lds_cptr vp_=vp0+sl_prev; \
    VRD(0); SBAR(); \
    GAPA(C0=__builtin_amdgcn_mfma_f32_32x32x16_bf16(kf[0],qr[0],negm,0,0,0), P0[2],P0[3],P0[4],P0[5],     pw0[0]=PKW(P0,0), pw0[1]=PKW(P0,2), pw0); \
    VRD(4); SBAR(); GAPA(C1=__builtin_amdgcn_mfma_f32_32x32x16_bf16(kf[1],qr[0],negm,0,0,0), P0[6],P0[7],P0[8],P0[9],     pw0[2]=PKW(P0,4), pw0[3]=PKW(P0,6), pw0); \
    VRD(1); SBAR(); GAPA(C0=__builtin_amdgcn_mfma_f32_32x32x16_bf16(kf[2],qr[1],C0,0,0,0),   P0[10],P0[11],P0[12],P0[13], pw1[0]=PKW(P0,8), pw1[1]=PKW(P0,10), pw1); \
    VRD(5); SBAR(); GAPA(C1=__builtin_amdgcn_mfma_f32_32x32x16_bf16(kf[3],qr[1],C1,0,0,0),   P0[14],P0[15],P1[0],P1[1],   pw1[2]=PKW(P0,12),pw1[3]=PKW(P0,14), pw1); \
    VRD(2); SBAR(); GAPA(C0=__builtin_amdgcn_mfma_f32_32x32x16_bf16(kf[4],qr[2],C0,0,0,0),   P1[2],P1[3],P1[4],P1[5],     pw2[0]=PKW(P1,0), pw2[1]=PKW(P1,2), pw2); \
    VRD(6); SBAR(); GAPA(C1=__builtin_amdgcn_mfma_f32_32x32x16_bf16(kf[5],qr[2],C1,0,0,0),   P1[6],P1[7],P1[8],P1[9],     pw2[2]=PKW(P1,4), pw2[3]=PKW(P1,6), pw2); \
    VRD(3); SBAR(); GAPA(C0=__builtin_amdgcn_mfma_f32_32x32x16_bf16(kf[6],qr[3],C0,0,0,0),   P1[10],P1[11],P1[12],P1[13], pw3[0]=PKW(P1,8), pw3[1]=PKW(P1,10), pw3); \
    VRD(7); SBAR(); GAPA(C1=__builtin_amdgcn_mfma_f32_32x32x16_bf16(kf[7],qr[3],C1,0,0,0),   P1[14],P1[15],0.f,0.f,       pw3[2]=PKW(P1,12),pw3[3]=PKW(P1,14), pw3); \
    if(GK){DMA_K((t)+3,sl_cur);} if(GV){DMA_V((t)+1,sl_next);} \
    CMASK(C0,C1,t); \
    SBAR(); \
    GAPB(o[0]=__builtin_amdgcn_mfma_f32_32x32x16_bf16(PAF(0),VFR(0),o[0],0,0,0), C0,0); \
    GAPB(o[1]=__builtin_amdgcn_mfma_f32_32x32x16_bf16(PAF(0),VFR(4),o[1],0,0,0), C0,4); \
    o2=__builtin_amdgcn_mfma_f32_32x32x16_bf16(PAF(0),ones8,o2,0,0,0); SBAR(); \
    KRD(GL,0); GAPB(o[0]=__builtin_amdgcn_mfma_f32_32x32x16_bf16(PAF(1),VFR(1),o[0],0,0,0), C0,8); \
    KRD(GL,1); GAPB(o[1]=__builtin_amdgcn_mfma_f32_32x32x16_bf16(PAF(1),VFR(5),o[1],0,0,0), C0,12); \
    o2=__builtin_amdgcn_mfma_f32_32x32x16_bf16(PAF(1),ones8,o2,0,0,0); SBAR(); \
    KRD(GL,2); GAPB(o[0]=__builtin_amdgcn_mfma_f32_32x32x16_bf16(PAF(2),VFR(2),o[0],0,0,0), C1,0); \
    KRD(GL,3); GAPB(o[1]=__builtin_amdgcn_mfma_f32_32x32x16_bf16(PAF(2),VFR(6),o[1],0,0,0), C1,4); \
    o2=__builtin_amdgcn_mfma_f32_32x32x16_bf16(PAF(2),ones8,o2,0,0,0); SBAR(); \
    GAPB(o[0]=__builtin_amdgcn_mfma_f32_32x32x16_bf16(PAF(3),VFR(3),o[0],0,0,0), C1,8); \
    GAPB(o[1]=__builtin_amdgcn_mfma_f32_32x32x16_bf16(PAF(3),VFR(7),o[1],0,0,0), C1,12); \
    o2=__builtin_amdgcn_mfma_f32_32x32x16_bf16(PAF(3),ones8,o2,0,0,0); SBAR(); \
    }while(0)
  int t=1;
  #undef CMASK
  #define CMASK(P0,P1,t) do{}while(0)
  for(;t+5<NT;t+=2){
    STEP(pB0,pB1,pA0,pA1,t,true,true,true);     WAIT_BAR(2); RESC(); ROT();
    STEP(pA0,pA1,pB0,pB1,t+1,true,true,true);   WAIT_BAR(2); RESC(); ROT();
  }
  #undef CMASK
  #define CMASK(P0,P1,t) do{}while(0)
  #define ENDW(tt) do{ if((tt)+3<NT){WAIT_BAR(2);} else if((tt)+2<NT){WAIT_BAR(1);} else {WAIT_BAR(0);} }while(0)
  for(;t+1<NT;t+=2){
    STEP(pB0,pB1,pA0,pA1,t,(t+3<NT),(t+1<NT),(t+1<NT));       ENDW(t);   RESC(); ROT();
    STEP(pA0,pA1,pB0,pB1,t+1,(t+4<NT),(t+2<NT),(t+2<NT));     ENDW(t+1); RESC(); ROT();
  }
  STEP(pB0,pB1,pA0,pA1,NT-1,false,false,false); RESC();
  {
    pw0=(u32x4){PKW(pB0,0),PKW(pB0,2),PKW(pB0,4),PKW(pB0,6)};pw1=(u32x4){PKW(pB0,8),PKW(pB0,10),PKW(pB0,12),PKW(pB0,14)};pw2=(u32x4){PKW(pB1,0),PKW(pB1,2),PKW(pB1,4),PKW(pB1,6)};pw3=(u32x4){PKW(pB1,8),PKW(pB1,10),PKW(pB1,12),PKW(pB1,14)};
    SBAR(); pv(o,vb0+sl_cur,PAF(0),PAF(1),PAF(2),PAF(3));
    o2=__builtin_amdgcn_mfma_f32_32x32x16_bf16(PAF(0),ones8,o2,0,0,0);o2=__builtin_amdgcn_mfma_f32_32x32x16_bf16(PAF(1),ones8,o2,0,0,0);o2=__builtin_amdgcn_mfma_f32_32x32x16_bf16(PAF(2),ones8,o2,0,0,0);o2=__builtin_amdgcn_mfma_f32_32x32x16_bf16(PAF(3),ones8,o2,0,0,0); }
  #undef PKW
  #undef PAF
  #undef VFR
  #undef PIN
  #undef MX3
  #undef GAPA
  #undef GAPB
  #undef EX
  #undef VRD
  #undef KRD
  #undef STEP
  #undef ENDW
  float rli[16];
  #pragma unroll
  for(int r=0;r<16;++r)rli[r]=__builtin_amdgcn_rcpf(o2[r]);
  bf16*Ow=Obase+(long)(wid*QBLK)*OP;
  { bf16*stg=(bf16*)(shm+LDS_OST)+wid*2048;
    #pragma unroll
    for(int r=0;r<16;++r){const int orow=crow(r,hi);
      #pragma unroll
      for(int d0=0;d0<2;++d0)stg[orow*64+d0*32+r32]=__float2bfloat16(o[d0][r]*rli[r]);}
    asm volatile("s_waitcnt lgkmcnt(0)":::"memory");
    #pragma unroll
    for(int i=0;i<4;++i){const int row=i*8+(lane>>3),ch=lane&7; const u32x4 v=*(const u32x4*)(stg+row*64+ch*8); ATTN_STORE16(Ow+(long)row*OP+ch*8,v);} }
  asm volatile("s_waitcnt lgkmcnt(0)\n\ts_barrier":::"memory");
  #undef DMA_K
  #undef DMA_V
  #undef CMASK
  #undef START
  #undef RESC
  #undef ROT
}
constexpr int ATTN_LDS_BYTES=LDS_BYTES;
#undef SBAR
#undef WAIT_BAR
}

constexpr int DM = 1024, NB = 2, SEQ = 8192, CTXL = 256, SB = SEQ + CTXL, MT = NB * SB, DEPTH = 2;
constexpr int NIN = 2576, NWIN = 2816, NP1 = 1792, NQK = 640;
constexpr int C_MQ = 0, C_MK = 256, C_MV = 512, C_MO = 768, C_AQ = 1024, C_AK = 1536, C_AV = 1664;
constexpr int NE = 16, FF = 2816, ROWS_E = 2304, NT1 = 22;
constexpr int NFFT = 16384;
constexpr float LN_EPS = 1e-5f, RMS_EPS = 1e-6f, ALPHA = 1.41421356237309515f;
constexpr float W1_MUL = 64.f, W2_MUL = 256.f; constexpr int W1_SCALE = 0x79797979, W2_SCALE = 0x77777777;
constexpr int SST = 4224;
constexpr int NPOS = 66;

constexpr size_t MiB = 1u << 20;
constexpr size_t WS_CTL = 0, CTL_ZERO_BYTES = 64 * 1024;
constexpr size_t WS_MODP = 1 * MiB, WS_MOD = 4 * MiB, WS_TW = 6 * MiB, WS_HID = 7 * MiB, WS_TAPC = 12 * MiB;
constexpr size_t WS_ROPE = 14 * MiB;
constexpr size_t WS_WINT = 16 * MiB, WS_WOUTT = 28 * MiB, WS_HF = 32 * MiB, WS_W1T = 160 * MiB, WS_W2T = 512 * MiB, WS_HN = 688 * MiB;
constexpr size_t WS_R = 722 * MiB;
constexpr size_t WS_P1 = WS_R, WS_HY = WS_R + 58 * MiB, WS_SLOC = WS_R + 108 * MiB, WS_SCAR = WS_R + 126 * MiB, WS_Y = WS_R + 144 * MiB, WS_MIX = WS_R + 178 * MiB;
constexpr size_t WS_TAPS = WS_R;
constexpr size_t WS_Z1 = WS_R + 250 * MiB;
constexpr size_t WS_ACT = WS_R + 72 * MiB, WS_YE = WS_R + 270 * MiB;
constexpr size_t WS_XS = WS_R + 414 * MiB, WS_XS2 = WS_XS + 66 * MiB, WS_QKP = WS_XS2 + 66 * MiB, WS_AFF = WS_QKP + 22 * MiB, WS_GT = WS_AFF + 2 * MiB, WS_INV = WS_GT + 2 * MiB, WS_IDX = WS_INV + 2 * MiB, WS_VAL = WS_IDX + 1 * MiB, WS_END = WS_VAL + 1 * MiB;
static_assert(WS_END <= 1408 * MiB, "workspace");
static_assert((size_t)MT * NP1 * 2 <= 58 * MiB && (size_t)NB * 768 * SB * 4 <= 50 * MiB && (size_t)16 * NPOS * SST * 4 <= 18 * MiB && (size_t)MT * DM * 2 <= 34 * MiB && (size_t)MT * DM * 4 <= 66 * MiB, "mix region");
static_assert((size_t)NE * ROWS_E * FF <= 198 * MiB && (size_t)NE * ROWS_E * DM * 2 <= 144 * MiB, "moe region");
static_assert(WS_MIX + 66 * MiB <= WS_XS, "mix region end");

constexpr int RING_OFF = 0;
constexpr int IDXL_OFF = 131072;
constexpr int LDSX_OFF = 139264;
constexpr int LDSCTL_OFF = 143360, MISC_OFF = LDSCTL_OFF + 320;
constexpr int LDS_BYTES = 147456;
constexpr int NWAVES = 8, NTHR = 512;

#define GAS __attribute__((address_space(1)))
#define LAS __attribute__((address_space(3)))
typedef unsigned short bf16;
typedef unsigned v4u __attribute__((ext_vector_type(4)));
typedef float f32x4 __attribute__((ext_vector_type(4)));
typedef short bf16x8 __attribute__((ext_vector_type(8)));
typedef GAS unsigned gu32;
typedef GAS unsigned long long gu64;
#define RLX_AGENT __ATOMIC_RELAXED, __HIP_MEMORY_SCOPE_AGENT
#define LDS_WAIT() asm volatile("s_waitcnt lgkmcnt(0)" ::: "memory")
#define VM_WAIT() asm volatile("s_waitcnt vmcnt(0)" ::: "memory")
__device__ __forceinline__ unsigned long long rt() { return __builtin_amdgcn_s_memrealtime(); }
__device__ __forceinline__ unsigned f2bf(float f) { unsigned u = __builtin_bit_cast(unsigned, f); return (u + 0x7fffu + ((u >> 16) & 1u)) >> 16; }
__device__ __forceinline__ unsigned pk2(float lo, float hi) { return f2bf(lo) | (f2bf(hi) << 16); }

#define XB_TMO      128
#define XB_XCNT(j)  (256  + 64 * (j))
#define XB_XSUB(j)  (1280 + 64 * (j))
#define XB_XGEN(j)  (2304 + 64 * (j))
#define XB_TOP      3328
#define XB_TOPGEN   3392
#define XCD_BAR_WORDS 3456
#define XB_SPIN_CAP (1u << 18)

__device__ __forceinline__ unsigned xb_ld(unsigned* p)              { return __hip_atomic_load(p, __ATOMIC_RELAXED, __HIP_MEMORY_SCOPE_AGENT); }
__device__ __forceinline__ unsigned xb_add(unsigned* p, unsigned v) { return __hip_atomic_fetch_add(p, v, __ATOMIC_RELAXED, __HIP_MEMORY_SCOPE_AGENT); }
__device__ __forceinline__ unsigned xb_xcc_id() { return (unsigned)__builtin_amdgcn_s_getreg((3 << 11) | 20) & 0xFu; }
#define XB_SPIN(cond, bar) do { unsigned _sp = 0; while (cond) { __builtin_amdgcn_s_sleep(1); \
    if ((++_sp & 255u) == 0u) { if (xb_ld(&(bar)[XB_TMO])) break; if (_sp > XB_SPIN_CAP) { atomicAdd(&(bar)[XB_TMO], 1u); break; } } } } while (0)

struct XcdBarrier {
    unsigned* bar; unsigned x;
    volatile LAS unsigned* st;
};

__device__ __forceinline__ XcdBarrier xcd_barrier_post(unsigned* bar, volatile LAS unsigned* st) {
    XcdBarrier b; b.bar = bar; b.x = xb_xcc_id(); b.st = st;
    if (threadIdx.x == 0) (void)xb_add(&bar[XB_XCNT(b.x)], 1u);
    return b;
}
__device__ __forceinline__ void xcd_barrier_complete(unsigned* bar, unsigned x, unsigned& nloc, unsigned& nx) {
    const unsigned G = gridDim.x * gridDim.y * gridDim.z;
    unsigned sum, cnt, mine, sp = 0u;
    for (;;) {
        sum = 0u; cnt = 0u; mine = 0u;
#pragma unroll
        for (unsigned j = 0; j < 16; ++j) { const unsigned c = xb_ld(&bar[XB_XCNT(j)]); sum += c; cnt += (c > 0u) ? 1u : 0u; mine = (j == x) ? c : mine; }
        if (sum == G) break;
        __builtin_amdgcn_s_sleep(1);
        if ((++sp & 255u) == 0u) { if (xb_ld(&bar[XB_TMO])) break; if (sp > XB_SPIN_CAP) { atomicAdd(&bar[XB_TMO], 1u); break; } }
    }
    nloc = mine > 0u ? mine : 1u; nx = cnt > 0u ? cnt : 1u;
}

__device__ __forceinline__ void xcd_barrier(const XcdBarrier& b) {
    asm volatile("s_waitcnt vmcnt(0)" ::: "memory");
    __syncthreads();
    if (threadIdx.x == 0) {
        unsigned* bar = b.bar;
        __builtin_amdgcn_s_waitcnt(0);
        unsigned nloc = b.st[0], nx = b.st[1];
        if (nloc == 0u) { xcd_barrier_complete(bar, b.x, nloc, nx); b.st[0] = nloc; b.st[1] = nx; }
        const unsigned old = xb_add(&bar[XB_XSUB(b.x)], 1u);
        const unsigned gen = old / nloc;
        if (old + 1u == (gen + 1u) * nloc) {
            __builtin_amdgcn_fence(__ATOMIC_RELEASE, "agent");
            asm volatile("s_waitcnt vmcnt(0)" ::: "memory");
            const unsigned og = xb_add(&bar[XB_TOP], 1u);
            const unsigned tg = og / nx;
            if (og + 1u == (tg + 1u) * nx) xb_add(&bar[XB_TOPGEN], 1u);
            else XB_SPIN(xb_ld(&bar[XB_TOPGEN]) == tg, bar);
            __builtin_amdgcn_fence(__ATOMIC_ACQUIRE, "agent");
            xb_add(&bar[XB_XGEN(b.x)], 1u);
            asm volatile("s_waitcnt vmcnt(0)" ::: "memory");
        } else {
            XB_SPIN(xb_ld(&bar[XB_XGEN(b.x)]) == gen, bar);
            __builtin_amdgcn_fence(__ATOMIC_ACQUIRE, "agent");
            asm volatile("s_waitcnt vmcnt(0)" ::: "memory");
        }
    }
    __syncthreads();
}


typedef float f32x16 __attribute__((ext_vector_type(16)));
typedef float f32x2 __attribute__((ext_vector_type(2)));
#ifndef MK_WT
#define MK_WT 0
#endif
__device__ __forceinline__ void st16(void* p, v4u v) {
#if MK_WT
    asm volatile("global_store_dwordx4 %0, %1, off sc1\n\ts_nop 1" ::"v"(p), "v"(v) : "memory");
#else
    *(v4u*)p = v;
#endif
}
__device__ __forceinline__ void st8(void* p, unsigned long long v) {
#if MK_WT
    asm volatile("global_store_dwordx2 %0, %1, off sc1\n\ts_nop 1" ::"v"(p), "v"(v) : "memory");
#else
    *(unsigned long long*)p = v;
#endif
}
__device__ __forceinline__ void st4(void* p, unsigned v) {
#if MK_WT
    asm volatile("global_store_dword %0, %1, off sc1\n\ts_nop 1" ::"v"(p), "v"(v) : "memory");
#else
    *(unsigned*)p = v;
#endif
}

struct Args { const float* in[32]; float* out; unsigned char* ws; int ph_lo, ph_hi; };

struct Fr { LAS unsigned char* lds; int tid, lane, wave, G, bid; };
__device__ __forceinline__ Fr fr_fresh(const Fr& F) { Fr P = F; int t = F.tid; asm volatile("" : "+v"(t)); P.tid = t; P.lane = t & 63; P.wave = __builtin_amdgcn_readfirstlane(t >> 6); return P; }

template <int CTRL> __device__ __forceinline__ float dppf(float v) { return __builtin_bit_cast(float, __builtin_amdgcn_update_dpp(0, __builtin_bit_cast(int, v), CTRL, 0xf, 0xf, true)); }
template <int CTRL> __device__ __forceinline__ int dppi(int v) { return __builtin_amdgcn_update_dpp(0, v, CTRL, 0xf, 0xf, true); }
__device__ __forceinline__ float rlanef(float v, int l) { return __builtin_bit_cast(float, __builtin_amdgcn_readlane(__builtin_bit_cast(int, v), l)); }
__device__ __forceinline__ float wave_sum(float v) {
    v += dppf<0xB1>(v); v += dppf<0x4E>(v); v += dppf<0x141>(v); v += dppf<0x140>(v);
    return (rlanef(v, 0) + rlanef(v, 16)) + (rlanef(v, 32) + rlanef(v, 48));
}
__device__ __forceinline__ float wave_max(float v) {
    v = fmaxf(v, dppf<0xB1>(v)); v = fmaxf(v, dppf<0x4E>(v)); v = fmaxf(v, dppf<0x141>(v)); v = fmaxf(v, dppf<0x140>(v));
    return fmaxf(fmaxf(rlanef(v, 0), rlanef(v, 16)), fmaxf(rlanef(v, 32), rlanef(v, 48)));
}
__device__ __forceinline__ int wave_sum_i(int v) {
    v += dppi<0xB1>(v); v += dppi<0x4E>(v); v += dppi<0x141>(v); v += dppi<0x140>(v);
    return (__builtin_amdgcn_readlane(v, 0) + __builtin_amdgcn_readlane(v, 16)) + (__builtin_amdgcn_readlane(v, 32) + __builtin_amdgcn_readlane(v, 48));
}
__device__ __forceinline__ float bf2f(unsigned short b) { return __uint_as_float(((unsigned)b) << 16); }
__device__ __forceinline__ float bflo(unsigned w) { return __uint_as_float(w << 16); }
__device__ __forceinline__ float bfhi(unsigned w) { return __uint_as_float(w & 0xffff0000u); }
__device__ __forceinline__ float sigmoidf_(float x) { return __builtin_amdgcn_rcpf(1.f + __builtin_amdgcn_exp2f(x * -1.44269504088896341f)); }
__device__ __forceinline__ float siluf_(float x) { return x * sigmoidf_(x); }
__device__ __forceinline__ float fexp(float x) { return __builtin_amdgcn_exp2f(x * 1.44269504088896341f); }
#define BSYNC() __syncthreads()

template <int MODE> __device__ __forceinline__ int tr_row(int n) {
    if (MODE == 0) return n;
    if (MODE == 1) return n < 1024 ? n : (n < 1040 ? 2560 + (n - 1024) : (n < NIN ? n - 16 : -1));
    if (MODE == 2) return (n >> 7) * 256 + (n & 127);
    return (n >> 7) * 256 + 128 + (n & 127);
}
template <int MODE> __device__ __forceinline__ void tr_item(const float* __restrict__ W, int K, int N, bf16* WT, LAS unsigned* scr, int item, int lane) {
    const int nblk = (N + 63) / 64, kb = item / nblk, nb = item % nblk, k0 = 64 * kb, n0 = 64 * nb;
    const int n4 = lane & 15, kq = lane >> 4; const int ncol = n0 + 4 * n4; const bool ok = ncol < N;
    f32x4 va[8], vb[8];
    const float* src = W + (size_t)(k0 + 2 * kq) * N + ncol;
#pragma unroll
    for (int i = 0; i < 8; ++i) { va[i] = ok ? __builtin_nontemporal_load((const f32x4*)(src + (size_t)(8 * i) * N)) : (f32x4){0.f, 0.f, 0.f, 0.f};
                                  vb[i] = ok ? __builtin_nontemporal_load((const f32x4*)(src + (size_t)(8 * i + 1) * N)) : (f32x4){0.f, 0.f, 0.f, 0.f}; }
#pragma unroll
    for (int i = 0; i < 8; ++i) { const int kd = 4 * i + kq;
        scr[(4 * n4 + 0) * 36 + kd] = pk2(va[i].x, vb[i].x); scr[(4 * n4 + 1) * 36 + kd] = pk2(va[i].y, vb[i].y); scr[(4 * n4 + 2) * 36 + kd] = pk2(va[i].z, vb[i].z); scr[(4 * n4 + 3) * 36 + kd] = pk2(va[i].w, vb[i].w); }
    LDS_WAIT(); asm volatile("" ::: "memory");
#pragma unroll
    for (int j = 0; j < 8; ++j) { const int n = 8 * j + (lane >> 3), c = lane & 7; const v4u o = *(const LAS v4u*)(scr + n * 36 + 4 * c);
        const int row = (n0 + n < N) ? tr_row<MODE>(n0 + n) : -1;
        if (row >= 0) *(GAS v4u*)(WT + (size_t)row * K + k0 + 8 * c) = o; }
    LDS_WAIT(); asm volatile("" ::: "memory");
}

__device__ __forceinline__ unsigned pk4_fp8(float a, float b, float c, float d) { int w = 0; w = __builtin_amdgcn_cvt_pk_fp8_f32(a, b, w, false); w = __builtin_amdgcn_cvt_pk_fp8_f32(c, d, w, true); return (unsigned)w; }
struct F8Job { const float* W; unsigned char* WT; int K, N, item, mode; float mul; };
__device__ __forceinline__ F8Job f8_job(const Args& A, int l, int q  ) {
    constexpr int I_M = 352, S_M = NE * I_M;
    F8Job j; const int kind = q / S_M, r = q - kind * S_M, e = r / I_M, le = l * NE + e; j.item = r - e * I_M;
    if (kind == 0) { j.W = A.in[27] + (size_t)le * DM * FF; j.WT = (unsigned char*)(A.ws + WS_W1T) + (size_t)le * (2 * FF) * DM; j.K = DM; j.N = FF; j.mode = 2; j.mul = W1_MUL; }
    else if (kind == 1) { j.W = A.in[28] + (size_t)le * DM * FF; j.WT = (unsigned char*)(A.ws + WS_W1T) + (size_t)le * (2 * FF) * DM; j.K = DM; j.N = FF; j.mode = 3; j.mul = W1_MUL; }
    else { j.W = A.in[29] + (size_t)le * FF * DM; j.WT = (unsigned char*)(A.ws + WS_W2T) + (size_t)le * DM * FF; j.K = FF; j.N = DM; j.mode = 0; j.mul = W2_MUL; }
    return j;
}
__device__ __forceinline__ void f8_load(const F8Job& j, int h, f32x4 (&v)[4][4], int lane) {
    const int nblk = j.N / 64, kb = j.item / nblk, nb = j.item % nblk, k0 = 128 * kb + 64 * h, n0 = 64 * nb;
    const int n4 = lane & 15, kq = lane >> 4;
    const float* src = j.W + (size_t)(k0 + 4 * kq) * j.N + n0 + 4 * n4;
#pragma unroll
    for (int i = 0; i < 4; ++i)
#pragma unroll
        for (int q = 0; q < 4; ++q) v[i][q] = __builtin_nontemporal_load((const f32x4*)(src + (size_t)(16 * i + q) * j.N));
}
__device__ __forceinline__ void f8_pack(const f32x4 (&v)[4][4], int h, float mul, LAS unsigned* scr, int lane) {
    const int n4 = lane & 15, kq = lane >> 4; const int sw = (n4 >> 1) & 7;
#pragma unroll
    for (int i = 0; i < 4; ++i) { const int kd = 4 * ((4 * h + i) ^ sw) + kq;
        scr[(4 * n4 + 0) * 36 + kd] = pk4_fp8(v[i][0].x * mul, v[i][1].x * mul, v[i][2].x * mul, v[i][3].x * mul);
        scr[(4 * n4 + 1) * 36 + kd] = pk4_fp8(v[i][0].y * mul, v[i][1].y * mul, v[i][2].y * mul, v[i][3].y * mul);
        scr[(4 * n4 + 2) * 36 + kd] = pk4_fp8(v[i][0].z * mul, v[i][1].z * mul, v[i][2].z * mul, v[i][3].z * mul);
        scr[(4 * n4 + 3) * 36 + kd] = pk4_fp8(v[i][0].w * mul, v[i][1].w * mul, v[i][2].w * mul, v[i][3].w * mul); }
}
__device__ __forceinline__ void f8_store(const F8Job& j, LAS unsigned* scr, int lane) {
    const int nblk = j.N / 64, kb = j.item / nblk, nb = j.item % nblk, k0 = 128 * kb, n0 = 64 * nb;
    LDS_WAIT(); asm volatile("" ::: "memory");
#pragma unroll
    for (int jj = 0; jj < 8; ++jj) { const int n = 8 * jj + (lane >> 3), c = lane & 7; const v4u o = *(const LAS v4u*)(scr + n * 36 + 4 * (c ^ ((n >> 3) & 7)));
        const int nn = n0 + n; const int row = j.mode == 0 ? nn : (nn >> 7) * 256 + (j.mode == 3 ? 128 : 0) + (nn & 127);
        *(GAS v4u*)(j.WT + (size_t)row * j.K + k0 + 16 * c) = o; }
    LDS_WAIT(); asm volatile("" ::: "memory");
}

__device__ __forceinline__ void ph_convert_experts(const Fr& F, const Args& A, int l) {
    LAS unsigned* scr = (LAS unsigned*)(F.lds + RING_OFF + F.wave * 16384);
    const int gw = F.bid * NWAVES + F.wave, NGW = F.G * NWAVES;
    __syncthreads();
#pragma unroll 1
    for (int it = (gw + NGW - 640) % NGW; it < 3 * NE * 352; it += NGW) {
        const F8Job j = f8_job(A, l, it);
        f32x4 va[4][4], vb[4][4];
        f8_load(j, 0, va, F.lane); f8_load(j, 1, vb, F.lane);
        f8_pack(va, 0, j.mul, scr, F.lane); f8_pack(vb, 1, j.mul, scr, F.lane);
        f8_store(j, scr, F.lane);
    }
    __syncthreads();
}
__device__ __forceinline__ void ph_convert(const Fr& F, const Args& A) {
    unsigned char* ws = A.ws;
    LAS unsigned* scr = (LAS unsigned*)(F.lds + RING_OFF + F.wave * 16384);
    const int gw = F.bid * NWAVES + F.wave, NGW = F.G * NWAVES;
    const int gid = F.bid * NTHR + F.tid, NG = F.G * NTHR;
    constexpr int I_WIN = 16 * 41, I_WOUT = 16 * 16, I_GU = 16 * 44, I_DN = 44 * 16;
    constexpr int S_A = DEPTH * I_WIN, S_B = S_A + DEPTH * I_WOUT;
    for (int it = gw; it < S_B; it += NGW) {
        if (it < S_A) { const int l = it / I_WIN, r = it % I_WIN; tr_item<1>(A.in[6] + (size_t)l * DM * NIN, DM, NIN, (bf16*)(ws + WS_WINT) + (size_t)l * NWIN * DM, scr, r, F.lane); }
        else { const int q = it - S_A, l = q / I_WOUT, r = q % I_WOUT; tr_item<0>(A.in[22] + (size_t)l * DM * DM, DM, DM, (bf16*)(ws + WS_WOUTT) + (size_t)l * DM * DM, scr, r, F.lane); }
    }
    f32x2* TW = (f32x2*)(ws + WS_TW);
    for (int i = gid; i < NFFT / 2; i += NG) { float s, c; sincospif((float)i * (1.f / 8192.f), &s, &c); TW[i] = (f32x2){c, -s}; }
    { f32x2* ROPE = (f32x2*)(ws + WS_ROPE);
      for (int i = gid; i < 128 * 16; i += NG) { const float ang = (float)(i >> 4) * exp2f(-(float)(i & 15) * (13.287712379549449f / 16.f)); ROPE[i] = (f32x2){cosf(ang), sinf(ang)}; } }
    float* MODP = (float*)(ws + WS_MODP);
    for (int it = gw; it < DEPTH * 16 * 24; it += NGW) {
        const int l = it / (16 * 24), kc = (it / 24) % 16, nb = it % 24;
        const int k = kc * 64 + F.lane;
        const float s0 = siluf_(A.in[1][k]), s1 = siluf_(A.in[1][DM + k]), s2 = siluf_(A.in[3][k]);
        f32x4 a0 = {0.f, 0.f, 0.f, 0.f}, a1 = a0, a2 = a0;
        const float* wp = A.in[4] + ((size_t)l * DM + kc * 64) * 6144 + nb * 256 + 4 * F.lane;
#pragma unroll 4
        for (int kk = 0; kk < 64; ++kk) { const f32x4 w = *(const f32x4*)(wp + (size_t)kk * 6144);
            const float t0 = __shfl(s0, kk), t1 = __shfl(s1, kk), t2 = __shfl(s2, kk); a0 += w * t0; a1 += w * t1; a2 += w * t2; }
        float* o = MODP + ((size_t)(l * 3) * 16 + kc) * 6144 + nb * 256 + 4 * F.lane;
        *(f32x4*)(o) = a0; *(f32x4*)(o + (size_t)16 * 6144) = a1; *(f32x4*)(o + (size_t)32 * 6144) = a2;
    }
    float* HID = (float*)(ws + WS_HID);
    for (int it = gw; it < DEPTH * SB; it += NGW) {
        const int l = it / SB, pos = it % SB; const int n = pos < SEQ ? SEQ : CTXL, i = pos < SEQ ? pos : pos - SEQ;
        const int k = F.lane; float feat = 0.f;
        if (k == 0) feat = (float)i / (float)n;
        else if (k <= 16) feat = cospif((float)(2 * i * k) / (float)n);
        else if (k <= 32) feat = sinpif((float)(2 * i * (k - 16)) / (float)n);
        const float* w1 = A.in[15] + (size_t)l * 33 * 64; const float* w2 = A.in[18] + (size_t)l * 64 * 64;
        float acc = A.in[16][l * 64 + k];
#pragma unroll
        for (int q = 0; q < 33; ++q) acc += __shfl(feat, q) * w1[q * 64 + k];
        const float h1 = sinf(A.in[17][l * 128 + k] * acc);
        float acc2 = A.in[19][l * 64 + k];
#pragma unroll 8
        for (int q = 0; q < 64; ++q) acc2 += __shfl(h1, q) * w2[q * 64 + k];
        HID[((size_t)l * SB + pos) * 64 + k] = sinf(A.in[17][l * 128 + 64 + k] * acc2);
    }
}

__device__ __forceinline__ int fphys(int i) { return i + ((i >> 6) << 2); }
__device__ __forceinline__ f32x2 cmul(f32x2 a, f32x2 b) { return (f32x2){a.x * b.x - a.y * b.y, a.x * b.y + a.y * b.x}; }
__device__ __forceinline__ f32x2 cmulc(f32x2 a, f32x2 b) { return (f32x2){a.x * b.x + a.y * b.y, a.y * b.x - a.x * b.y}; }
template <int NUM, int DEN> struct RotC {
    static constexpr int K16 = NUM * (16 / DEN);
    static constexpr float C = K16 == 0 ? 1.f : K16 == 1 ? 0.92387953251128674f : K16 == 2 ? 0.70710678118654752f : K16 == 3 ? 0.38268343236508977f : K16 == 4 ? 0.f : K16 == 5 ? -0.38268343236508977f : K16 == 6 ? -0.70710678118654752f : -0.92387953251128674f;
    static constexpr float S = K16 == 0 ? 0.f : K16 == 1 ? 0.38268343236508977f : K16 == 2 ? 0.70710678118654752f : K16 == 3 ? 0.92387953251128674f : K16 == 4 ? 1.f : K16 == 5 ? 0.92387953251128674f : K16 == 6 ? 0.70710678118654752f : 0.38268343236508977f;
};
template <int NUM, int DEN> __device__ __forceinline__ f32x2 crot(f32x2 a) {
    constexpr int K16 = RotC<NUM, DEN>::K16; constexpr float C = RotC<NUM, DEN>::C, S = RotC<NUM, DEN>::S;
    if (K16 == 0) return a;
    if (K16 == 4) return (f32x2){a.y, -a.x};
    if (K16 == 2) return (f32x2){(a.x + a.y) * C, (a.y - a.x) * C};
    if (K16 == 6) return (f32x2){(a.y - a.x) * S, -(a.x + a.y) * S};
    return (f32x2){a.x * C + a.y * S, a.y * C - a.x * S};
}
template <int NUM, int DEN> __device__ __forceinline__ f32x2 crotc(f32x2 a) {
    constexpr int K16 = RotC<NUM, DEN>::K16; constexpr float C = RotC<NUM, DEN>::C, S = RotC<NUM, DEN>::S;
    if (K16 == 0) return a;
    if (K16 == 4) return (f32x2){-a.y, a.x};
    if (K16 == 2) return (f32x2){(a.x - a.y) * C, (a.x + a.y) * C};
    if (K16 == 6) return (f32x2){-(a.x + a.y) * S, (a.x - a.y) * S};
    return (f32x2){a.x * C - a.y * S, a.y * C + a.x * S};
}
template <int R, int RS, int J, bool INV> __device__ __forceinline__ void fft_bfly(f32x2 (&x)[1 << R], const f32x2 wb) {
    constexpr int E = 1 << R, hj = E >> (RS + 1);
    if constexpr (J < E) {
        if constexpr ((J & hj) == 0) {
            constexpr int jp = J & (hj - 1);
            const f32x2 a = x[J], b = x[J + hj];
            if (!INV) { x[J] = a + b; x[J + hj] = crot<jp, 2 * hj>(cmul(a - b, wb)); }
            else { const f32x2 v = crotc<jp, 2 * hj>(cmulc(b, wb)); x[J] = a + v; x[J + hj] = a - v; }
        }
        fft_bfly<R, RS, J + 1, INV>(x, wb);
    }
}
template <int R, int RS, bool INV> __device__ __forceinline__ void fft_stage(f32x2 (&x)[1 << R], const f32x2* __restrict__ TW, const int s, const int pos) {
    const f32x2 wb = TW[(pos << (s + RS)) & (NFFT / 2 - 1)];
    fft_bfly<R, RS, 0, INV>(x, wb);
}
template <int R, bool INV> __device__ __forceinline__ void fft_pass(LAS f32x2* d, const f32x2* __restrict__ TW, const int s, const int tid) {
    constexpr int E = 1 << R;
    const int lq = 14 - s - R, q = 1 << lq;
#pragma unroll 1
    for (int w = tid; w < (NFFT >> R); w += NTHR) {
        const int grp = w >> lq, pos = w & (q - 1);
        const int base = (grp << (lq + R)) + pos;
        f32x2 x[E];
#pragma unroll
        for (int j = 0; j < E; ++j) x[j] = d[fphys(base + j * q)];
        if constexpr (R == 4) {
            if (!INV) { fft_stage<4, 0, false>(x, TW, s, pos); fft_stage<4, 1, false>(x, TW, s, pos); fft_stage<4, 2, false>(x, TW, s, pos); fft_stage<4, 3, false>(x, TW, s, pos); }
            else { fft_stage<4, 3, true>(x, TW, s, pos); fft_stage<4, 2, true>(x, TW, s, pos); fft_stage<4, 1, true>(x, TW, s, pos); fft_stage<4, 0, true>(x, TW, s, pos); }
        } else if constexpr (R == 3) {
            if (!INV) { fft_stage<3, 0, false>(x, TW, s, pos); fft_stage<3, 1, false>(x, TW, s, pos); fft_stage<3, 2, false>(x, TW, s, pos); }
            else { fft_stage<3, 2, true>(x, TW, s, pos); fft_stage<3, 1, true>(x, TW, s, pos); fft_stage<3, 0, true>(x, TW, s, pos); }
        } else {
            if (!INV) { fft_stage<2, 0, false>(x, TW, s, pos); fft_stage<2, 1, false>(x, TW, s, pos); }
            else { fft_stage<2, 1, true>(x, TW, s, pos); fft_stage<2, 0, true>(x, TW, s, pos); }
        }
#pragma unroll
        for (int j = 0; j < E; ++j) d[fphys(base + j * q)] = x[j];
    }
}
__device__ __forceinline__ void fft_fwd(LAS f32x2* d, const f32x2* TW, int tid) {
    fft_pass<4, false>(d, TW, 0, tid); BSYNC(); fft_pass<4, false>(d, TW, 4, tid); BSYNC(); fft_pass<4, false>(d, TW, 8, tid); BSYNC(); fft_pass<2, false>(d, TW, 12, tid); BSYNC();
}
__device__ __forceinline__ void fft_inv(LAS f32x2* d, const f32x2* TW, int tid) {
    fft_pass<2, true>(d, TW, 12, tid); BSYNC(); fft_pass<4, true>(d, TW, 8, tid); BSYNC(); fft_pass<4, true>(d, TW, 4, tid); BSYNC(); fft_pass<4, true>(d, TW, 0, tid); BSYNC();
}

__device__ __forceinline__ float block_sum(float v, LAS float* red, int wave, int lane) {
    v = wave_sum(v);
    BSYNC();
    if (lane == 0) red[wave] = v;
    BSYNC();
    float s = 0.f;
#pragma unroll
    for (int i = 0; i < NWAVES; ++i) s += red[i];
    return s;
}

__device__ __forceinline__ void ph_taps(const Fr& F, const Args& A) {
    unsigned char* ws = A.ws;
    const int gid = F.bid * NTHR + F.tid, NG = F.G * NTHR;
    { float* MOD = (float*)(ws + WS_MOD); const float* MODP = (const float*)(ws + WS_MODP);
      for (int i = gid; i < DEPTH * 3 * 6144; i += NG) { const int l = i / (3 * 6144), n = i % 6144; float a = A.in[5][l * 6144 + n]; const float* p = MODP + (size_t)(i / 6144) * 16 * 6144 + n;
#pragma unroll
          for (int kc = 0; kc < 16; ++kc) a += p[(size_t)kc * 6144];
          MOD[i] = a; } }
    const float* HID = (const float*)(ws + WS_HID); float* TAPS = (float*)(ws + WS_TAPS);
    LAS float* hs = (LAS float*)(F.lds + RING_OFF);
    const float log_target = 4.605170185988091f; const float dlo = log_target / 1.5f, dhi = log_target / 0.3f;
    const int r = F.lane & 31, hh = F.lane >> 5;
    for (int u = F.bid; u < DEPTH * (SB / 64); u += F.G) {
        const int l = u / (SB / 64), pos0 = (u % (SB / 64)) * 64;
        BSYNC();
#pragma unroll
        for (int k = 0; k < 2; ++k) { const int idx = F.tid + NTHR * k, p = idx >> 4, c4 = idx & 15; const f32x4 v = *(const f32x4*)(HID + ((size_t)l * SB + pos0 + p) * 64 + 4 * c4);
            hs[p * 65 + 4 * c4] = v.x; hs[p * 65 + 4 * c4 + 1] = v.y; hs[p * 65 + 4 * c4 + 2] = v.z; hs[p * 65 + 4 * c4 + 3] = v.w; }
        BSYNC();
        const float* w3 = A.in[20] + (size_t)l * 64 * 1024;
#pragma unroll 1
        for (int task = F.wave; task < 16; task += NWAVES) {
            const int ph = task >> 3, col0 = (task & 7) * 128;
            f32x16 acc[4];
#pragma unroll
            for (int n = 0; n < 4; ++n) acc[n] = (f32x16){};
            const LAS float* ap = hs + (ph * 32 + r) * 65 + hh; const float* bp = w3 + (size_t)hh * 1024 + col0 + r;
#pragma unroll 4
            for (int kk = 0; kk < 32; ++kk) { const float a = ap[2 * kk];
#pragma unroll
                for (int n = 0; n < 4; ++n) acc[n] = __builtin_amdgcn_mfma_f32_32x32x2f32(a, bp[(size_t)(2 * kk) * 1024 + 32 * n], acc[n], 0, 0, 0); }
#pragma unroll
            for (int n = 0; n < 4; ++n) { const int col = col0 + 32 * n + r; const float de = dlo + (dhi - dlo) * (float)(col & 255) / 255.f;
                float* op = TAPS + ((size_t)l * 1024 + col) * SB + pos0 + ph * 32 + 4 * hh;
#pragma unroll
                for (int q = 0; q < 4; ++q) { f32x4 o;
#pragma unroll
                    for (int i = 0; i < 4; ++i) { const int pos = pos0 + ph * 32 + 8 * q + 4 * hh + i; const float t = pos < SEQ ? (float)pos / 8192.f : (float)(pos - SEQ) / 256.f; o[i] = acc[n][4 * q + i] * (expf(-t * de) + 0.05f); }
                    *(f32x4*)(op + 8 * q) = o; } }
        }
    }
}
__device__ __forceinline__ void ph_filters(const Fr& F, const Args& A) {
    unsigned char* ws = A.ws;
    const int gw = F.bid * NWAVES + F.wave, NGW = F.G * NWAVES;
    const float* TAPS = (const float*)(ws + WS_TAPS);
    { float* TAPC = (float*)(ws + WS_TAPC);
      for (int it = gw; it < DEPTH * 2 * 256; it += NGW) {
          const int l = it / 512, o = (it / 256) & 1, c = it & 255;
          const float* fw = TAPS + ((size_t)l * 1024 + o * 256 + c) * SB + SEQ; const float* bw = TAPS + ((size_t)l * 1024 + 512 + o * 256 + c) * SB + SEQ;
          float fv[4], gv[4]; float l1 = 0.f;
#pragma unroll
          for (int i = 0; i < 4; ++i) { const int s = F.lane + 64 * i; fv[i] = fw[s]; gv[i] = s ? bw[s] : 0.f; l1 += fabsf(fv[i]) + fabsf(gv[i]); }
          l1 = wave_sum(l1); const float inv = 1.f / l1; float* T = TAPC + (size_t)it * 512;
#pragma unroll
          for (int i = 0; i < 4; ++i) { const int s = F.lane + 64 * i; T[256 + s] = fv[i] * inv; if (s >= 1) T[256 - s] = gv[i] * inv; }
          if (F.lane == 0) T[0] = 0.f;
      } }
    LAS f32x2* d = (LAS f32x2*)(F.lds + RING_OFF); LAS float* xs = (LAS float*)(F.lds + LDSX_OFF);
    const f32x2* TW = (const f32x2*)(ws + WS_TW); f32x2* HF = (f32x2*)(ws + WS_HF);
    for (int u = F.bid; u < DEPTH * 256; u += F.G) {
        const int l = u / 256, c = u & 255;
        const float* fw0 = TAPS + ((size_t)l * 1024 + c) * SB; const float* bw0 = TAPS + ((size_t)l * 1024 + 512 + c) * SB;
        const float* fw1 = fw0 + (size_t)256 * SB; const float* bw1 = bw0 + (size_t)256 * SB;
        BSYNC();
        float l1a = 0.f, l1b = 0.f;
#pragma unroll 4
        for (int s = F.tid; s < SEQ; s += NTHR) { const float f0 = fw0[s], g0 = bw0[s], f1 = fw1[s], g1 = bw1[s];
            d[fphys(s)] = (f32x2){f0, f1};
            if (s >= 1) { d[fphys(NFFT - s)] = (f32x2){g0, g1}; l1a += fabsf(g0); l1b += fabsf(g1); } else d[fphys(SEQ)] = (f32x2){0.f, 0.f};
            l1a += fabsf(f0); l1b += fabsf(f1); }
        l1a = block_sum(l1a, xs + 128, F.wave, F.lane);
        l1b = block_sum(l1b, xs + 144, F.wave, F.lane);
        const float sca = 0.5f / (l1a * (float)NFFT), scb = 0.5f / (l1b * (float)NFFT);
        fft_fwd(d, TW, F.tid);
        f32x2* outa = HF + ((size_t)(l * 2 + 0) * 256 + c) * NFFT; f32x2* outb = HF + ((size_t)(l * 2 + 1) * 256 + c) * NFFT;
#pragma unroll 4
        for (int i = F.tid; i < NFFT; i += NTHR) { const int k = (int)(__brev((unsigned)i) >> 18), kp = (NFFT - k) & (NFFT - 1), ip = (int)(__brev((unsigned)kp) >> 18);
            const f32x2 v = d[fphys(i)], w = d[fphys(ip)];
            outa[i] = (f32x2){(v.x + w.x) * sca, (v.y - w.y) * sca};
            outb[i] = (f32x2){(v.y + w.y) * scb, (w.x - v.x) * scb}; }
    }
}

struct Row { f32x4 v[4]; };
__device__ __forceinline__ Row row_load(const float* p, int lane) { Row r; const f32x4* q = (const f32x4*)p + lane;
#pragma unroll
    for (int j = 0; j < 4; ++j) r.v[j] = q[64 * j];
    return r; }
__device__ __forceinline__ Row row_load_bf16(const bf16* p, int lane) { Row r; const unsigned long long* q = (const unsigned long long*)p + lane;
#pragma unroll
    for (int j = 0; j < 4; ++j) { const unsigned long long w = q[64 * j]; const unsigned lo = (unsigned)w, hi = (unsigned)(w >> 32); r.v[j] = (f32x4){bflo(lo), bfhi(lo), bflo(hi), bfhi(hi)}; }
    return r; }
__device__ __forceinline__ void row_store_fp8(unsigned char* p, const Row& r, int lane) { unsigned* q = (unsigned*)p + lane;
#pragma unroll
    for (int j = 0; j < 4; ++j) st4(q + 64 * j, pk4_fp8(r.v[j].x, r.v[j].y, r.v[j].z, r.v[j].w)); }
__device__ __forceinline__ void row_store(float* p, const Row& r, int lane) { f32x4* q = (f32x4*)p + lane;
#pragma unroll
    for (int j = 0; j < 4; ++j) st16(q + 64 * j, __builtin_bit_cast(v4u, r.v[j])); }
__device__ __forceinline__ void row_store_bf16(bf16* p, const Row& r, int lane) { unsigned long long* q = (unsigned long long*)p + lane;
#pragma unroll
    for (int j = 0; j < 4; ++j) st8(q + 64 * j, (unsigned long long)pk2(r.v[j].x, r.v[j].y) | ((unsigned long long)pk2(r.v[j].z, r.v[j].w) << 32)); }
__device__ __forceinline__ Row row_load_lds(const LAS float* p, int lane) { Row r; const LAS f32x4* q = (const LAS f32x4*)p + lane;
#pragma unroll
    for (int j = 0; j < 4; ++j) r.v[j] = q[64 * j];
    return r; }
constexpr int LNPV_OFF = 65536;
__device__ __forceinline__ const LAS float* ln_pv(const Fr& F, int row, int k) { const int b = row / SB, s = row % SB; return (const LAS float*)(F.lds + RING_OFF + LNPV_OFF) + ((s < SEQ ? b : 2) * 5 + k) * DM; }
__device__ __forceinline__ void ln_pv_fill(const Fr& F, int k, const float* v0, const float* v1, const float* v2) {
    LAS float* pv = (LAS float*)(F.lds + RING_OFF + LNPV_OFF);
    for (int i = F.tid; i < DM; i += NTHR) { pv[(0 * 5 + k) * DM + i] = v0[i]; pv[(1 * 5 + k) * DM + i] = v1[i]; pv[(2 * 5 + k) * DM + i] = v2[i]; }
}
__device__ __forceinline__ void row_norm(Row& r) {
    float s = 0.f;
#pragma unroll
    for (int j = 0; j < 4; ++j) s += (r.v[j].x + r.v[j].y) + (r.v[j].z + r.v[j].w);
    const float mean = wave_sum(s) * (1.f / DM); float s2 = 0.f;
#pragma unroll
    for (int j = 0; j < 4; ++j) { r.v[j] = r.v[j] - mean; s2 += (r.v[j].x * r.v[j].x + r.v[j].y * r.v[j].y) + (r.v[j].z * r.v[j].z + r.v[j].w * r.v[j].w); }
    const float rstd = 1.f / sqrtf(wave_sum(s2) * (1.f / DM) + LN_EPS);
#pragma unroll
    for (int j = 0; j < 4; ++j) r.v[j] = r.v[j] * rstd;
}
__device__ __forceinline__ void row_mod_lds(Row& r, const LAS float* shift, const LAS float* scale, int lane) {
    const Row sh = row_load_lds(shift, lane), sc = row_load_lds(scale, lane);
#pragma unroll
    for (int j = 0; j < 4; ++j) r.v[j] = r.v[j] * (sc.v[j] + 1.f) + sh.v[j];
}
__device__ __forceinline__ void row_affine_lds(Row& r, const LAS float* w, const LAS float* b, int lane) {
    const Row ww = row_load_lds(w, lane), bb = row_load_lds(b, lane);
#pragma unroll
    for (int j = 0; j < 4; ++j) r.v[j] = r.v[j] * ww.v[j] + bb.v[j];
}
__device__ __forceinline__ void row_dot16x2(const Row& ra, const Row& rb, const LAS float* W16, int lane, float& da, float& db) {
    f32x2 p[16];
#pragma unroll
    for (int e = 0; e < 16; ++e) { const LAS f32x4* w = (const LAS f32x4*)(W16 + e * DM) + lane; f32x2 a = {0.f, 0.f};
#pragma unroll
        for (int j = 0; j < 4; ++j) { const f32x4 x = w[64 * j];
            a += (f32x2){ra.v[j].x, rb.v[j].x} * x.x; a += (f32x2){ra.v[j].y, rb.v[j].y} * x.y; a += (f32x2){ra.v[j].z, rb.v[j].z} * x.z; a += (f32x2){ra.v[j].w, rb.v[j].w} * x.w; }
        p[e] = a; }
    const bool b0 = (lane & 1) != 0, b1 = (lane & 2) != 0;
    float res[2];
#pragma unroll
    for (int c = 0; c < 2; ++c) {
        float q[8];
#pragma unroll
        for (int i = 0; i < 8; ++i) { const float keep = b0 ? p[2 * i + 1][c] : p[2 * i][c], send = b0 ? p[2 * i][c] : p[2 * i + 1][c]; q[i] = keep + dppf<0xB1>(send); }
        float t[4];
#pragma unroll
        for (int i = 0; i < 4; ++i) { const float keep = b1 ? q[2 * i + 1] : q[2 * i], send = b1 ? q[2 * i] : q[2 * i + 1]; t[i] = keep + dppf<0x4E>(send); }
#pragma unroll
        for (int i = 0; i < 4; ++i) { t[i] += dppf<0x124>(t[i]); t[i] += dppf<0x128>(t[i]); t[i] += __shfl_xor(t[i], 16); t[i] += __shfl_xor(t[i], 32); }
        const int sel = (lane >> 2) & 3;
        res[c] = sel == 0 ? t[0] : (sel == 1 ? t[1] : (sel == 2 ? t[2] : t[3]));
    }
    da = res[0]; db = res[1];
}
__device__ __forceinline__ const float* row_input(const Args& A, int l, int row) {
    if (l > 0) return (const float*)(A.ws + WS_XS2) + (size_t)row * DM;
    const int b = row / SB, s = row % SB;
    return s < SEQ ? A.in[0] + ((size_t)b * SEQ + s) * DM : A.in[2] + ((size_t)b * CTXL + (s - SEQ)) * DM;
}
__device__ __forceinline__ Row ln_a_head(const Fr& F, const Args& A, int row, Row r, int lane) {
    row_norm(r); row_mod_lds(r, ln_pv(F, row, 3), ln_pv(F, row, 4), lane);
    row_store_bf16((bf16*)(A.ws + WS_HN) + (size_t)row * DM, r, lane);
    return r;
}
__device__ __forceinline__ void ph_ln_a0(const Fr& F, const Args& A) {
    BSYNC();
    { const float* M = (const float*)(A.ws + WS_MOD); ln_pv_fill(F, 3, M, M + 6144, M + 2 * 6144); ln_pv_fill(F, 4, M + DM, M + 6144 + DM, M + 2 * 6144 + DM); BSYNC(); }
    const int gw = F.bid * NWAVES + F.wave, NGW = F.G * NWAVES;
    for (int row = gw; row < MT; row += 2 * NGW) { asm volatile("" ::: "memory");
        const int row2 = row + NGW < MT ? row + NGW : row;
        (void)ln_a_head(F, A, row, row_load(row_input(A, 0, row), F.lane), F.lane); if (row2 != row) (void)ln_a_head(F, A, row2, row_load(row_input(A, 0, row2), F.lane), F.lane); }
}
__device__ __forceinline__ void ph_ln_b(const Fr& F, const Args& A, int l) {
    LAS float* RW = (LAS float*)(F.lds + RING_OFF);
    BSYNC();
    for (int i = F.tid; i < 16 * DM; i += NTHR) { const int e = i >> 10, k = i & 1023; RW[i] = A.in[25][((size_t)l * DM + k) * 16 + e]; }
    { const float* M = (const float*)(A.ws + WS_MOD) + (size_t)l * 3 * 6144; const float* w = A.in[23] + l * DM; const float* bb = A.in[24] + l * DM;
      ln_pv_fill(F, 0, M + 2 * DM, M + 6144 + 2 * DM, M + 2 * 6144 + 2 * DM); ln_pv_fill(F, 1, w, w, w); ln_pv_fill(F, 2, bb, bb, bb);
      ln_pv_fill(F, 3, M + 3 * DM, M + 6144 + 3 * DM, M + 2 * 6144 + 3 * DM); ln_pv_fill(F, 4, M + 4 * DM, M + 6144 + 4 * DM, M + 2 * 6144 + 4 * DM); }
    BSYNC();
    const int gw = F.bid * NWAVES + F.wave, NGW = F.G * NWAVES; const bool last = (l == DEPTH - 1);
    const int NR = last ? NB * SEQ : MT;
#define LNROW(i_) (last ? (i_) + ((i_) >= SEQ ? CTXL : 0) : (i_))
    for (int idx = gw; idx < NR; idx += 2 * NGW) {
        asm volatile("" ::: "memory");
        const int rows[2] = {LNROW(idx), idx + NGW < NR ? LNROW(idx + NGW) : LNROW(idx)};
        Row h[2];
#pragma unroll
        for (int c = 0; c < 2; ++c) { const int row = rows[c];
            Row r = row_load(row_input(A, l, row), F.lane); const Row mx = row_load_bf16((const bf16*)(A.ws + WS_MIX) + (size_t)row * DM, F.lane), g1 = row_load_lds(ln_pv(F, row, 0), F.lane);
#pragma unroll
            for (int j = 0; j < 4; ++j) r.v[j] = r.v[j] * ALPHA + g1.v[j] * mx.v[j];
            row_norm(r); row_affine_lds(r, ln_pv(F, row, 1), ln_pv(F, row, 2), F.lane);
            row_store((float*)(A.ws + WS_XS) + (size_t)row * DM, r, F.lane);
            row_norm(r); row_mod_lds(r, ln_pv(F, row, 3), ln_pv(F, row, 4), F.lane);
            row_store_fp8((unsigned char*)(A.ws + WS_HN) + (size_t)row * DM, r, F.lane);
            h[c] = r; }
        float lgs[2]; row_dot16x2(h[0], h[1], RW, F.lane, lgs[0], lgs[1]);
#pragma unroll
        for (int c = 0; c < 2; ++c) { const int row = rows[c]; const int b = row / SB, s = row % SB;
            const float lg = lgs[c] + A.in[26][l * 16 + (F.lane & 15)];
            float mxv = lg;
#pragma unroll
            for (int o = 1; o < 16; o <<= 1) mxv = fmaxf(mxv, __shfl_xor(mxv, o));
            const float ex = expf(lg - mxv); float sm = ex;
#pragma unroll
            for (int o = 1; o < 16; o <<= 1) sm += __shfl_xor(sm, o);
            if (F.lane < 16) ((float*)(A.ws + WS_AFF))[((size_t)b * 16 + F.lane) * SB + s] = ex / sm; }
    }
#undef LNROW
}
__device__ __forceinline__ void ph_ln_c(const Fr& F, const Args& A, int l) {
    const bool last = (l == DEPTH - 1);
    { const float* M = (const float*)(A.ws + WS_MOD) + (size_t)l * 3 * 6144; const float* w = A.in[30] + l * DM; const float* bb = A.in[31] + l * DM; BSYNC();
      ln_pv_fill(F, 0, M + 5 * DM, M + 6144 + 5 * DM, M + 2 * 6144 + 5 * DM); ln_pv_fill(F, 1, w, w, w); ln_pv_fill(F, 2, bb, bb, bb);
      if (!last) { const float* M1 = M + 3 * 6144; ln_pv_fill(F, 3, M1, M1 + 6144, M1 + 2 * 6144); ln_pv_fill(F, 4, M1 + DM, M1 + 6144 + DM, M1 + 2 * 6144 + DM); }
      BSYNC(); }
    const int gw = F.bid * NWAVES + F.wave, NGW = F.G * NWAVES;
    const int* INV = (const int*)(A.ws + WS_INV); const float* VAL = (const float*)(A.ws + WS_VAL); const bf16* YE = (const bf16*)(A.ws + WS_YE);
    const int NR = last ? NB * SEQ : MT;
#define LNROW(i_) (last ? (i_) + ((i_) >= SEQ ? CTXL : 0) : (i_))
    for (int idx = gw; idx < NR; idx += 2 * NGW) {
        asm volatile("" ::: "memory");
        const int rows[2] = {LNROW(idx), idx + NGW < NR ? LNROW(idx + NGW) : LNROW(idx)};
        Row h[2];
#pragma unroll
        for (int c = 0; c < 2; ++c) { const int row = rows[c]; const int b = row / SB, s = row % SB;
            const int myinv = (F.lane < 16) ? INV[(size_t)row * 16 + F.lane] : 0;
            Row f;
#pragma unroll
            for (int j = 0; j < 4; ++j) f.v[j] = (f32x4){0.f, 0.f, 0.f, 0.f};
            for (int e = 0; e < 16; ++e) { const int r1 = __builtin_amdgcn_readlane(myinv, e);
                if (r1 != 0) { const size_t rr = (size_t)e * ROWS_E + (r1 - 1); const float val = VAL[rr]; const Row y = row_load_bf16(YE + rr * DM, F.lane);
#pragma unroll
                    for (int j = 0; j < 4; ++j) f.v[j] += y.v[j] * val; } }
            Row r = row_load((const float*)(A.ws + WS_XS) + (size_t)row * DM, F.lane); const Row g2 = row_load_lds(ln_pv(F, row, 0), F.lane);
#pragma unroll
            for (int j = 0; j < 4; ++j) r.v[j] = r.v[j] * ALPHA + g2.v[j] * f.v[j];
            row_norm(r); row_affine_lds(r, ln_pv(F, row, 1), ln_pv(F, row, 2), F.lane);
            if (last) row_store(A.out + ((size_t)b * SEQ + s) * DM, r, F.lane);
            else { row_store((float*)(A.ws + WS_XS2) + (size_t)row * DM, r, F.lane); (void)ln_a_head(F, A, row, r, F.lane); } }
    }
#undef LNROW
}

struct EpiWin {
    static constexpr bool PERM = true, AFTER_DRAIN = false;
    bf16* P1; float* HY; float* GT;
    __device__ __forceinline__ void operator()(const pg8::f32x4 (&acc)[2][2][4][2], const pg8::Unit& u, int wr, int wc, int fr, int fq) const {
        const int row0 = u.pm * 256 + wr * 64 + fr;
        if (u.pn == 10) {
            if (wc == 0 && fq < 2) {
#pragma unroll
                for (int ai = 0; ai < 2; ++ai)
#pragma unroll
                    for (int m = 0; m < 4; ++m) { float* gp = GT + (size_t)(row0 + ai * 128 + m * 16) * 16 + 8 * fq; *(pg8::f32x4*)gp = acc[ai][0][m][0]; *(pg8::f32x4*)(gp + 4) = acc[ai][0][m][1]; } }
        } else if (u.pn < 7) {
            const int col0 = u.pn * 256 + wc * 32 + 8 * fq;
#pragma unroll
            for (int ai = 0; ai < 2; ++ai)
#pragma unroll
                for (int m = 0; m < 4; ++m) { bf16* rowp = P1 + (size_t)(row0 + ai * 128 + m * 16) * NP1 + col0;
#pragma unroll
                    for (int bj = 0; bj < 2; ++bj) { const pg8::f32x4 v0 = acc[ai][bj][m][0], v1 = acc[ai][bj][m][1]; pg8::u32x4 w;
                        w.x = pg8::cvt_pk_bf16(v0[0], v0[1]); w.y = pg8::cvt_pk_bf16(v0[2], v0[3]); w.z = pg8::cvt_pk_bf16(v1[0], v1[1]); w.w = pg8::cvt_pk_bf16(v1[2], v1[3]);
                        st16(rowp + bj * 128, __builtin_bit_cast(v4u, w)); } }
        } else {
            const int b = u.pm / 33, s0 = (u.pm % 33) * 256 + wr * 64 + fr; const int ch0 = (u.pn - 7) * 256 + wc * 32 + 8 * fq;
            float* base = HY + (size_t)b * 768 * SB;
#pragma unroll
            for (int ai = 0; ai < 2; ++ai)
#pragma unroll
                for (int m = 0; m < 4; ++m) { const int s = s0 + ai * 128 + m * 16;
#pragma unroll
                    for (int bj = 0; bj < 2; ++bj)
#pragma unroll
                        for (int n = 0; n < 2; ++n)
#pragma unroll
                            for (int i = 0; i < 4; ++i) st4(base + (size_t)(ch0 + bj * 128 + 4 * n + i) * SB + s, __float_as_uint(acc[ai][bj][m][n][i])); }
        }
    }
};
struct EpiF32g {
    static constexpr bool PERM = false, AFTER_DRAIN = false;
    float* C; int ldc; int ntn;
    __device__ __forceinline__ void operator()(const pg8::f32x4 (&acc)[2][2][4][2], const pg8::Unit& u, int wr, int wc, int fr, int fq) const {
        const int row0 = u.pm * 256 + wr * 64 + fr, col0 = (u.pn % ntn) * 256 + wc * 32 + 4 * fq;
#pragma unroll
        for (int ai = 0; ai < 2; ++ai)
#pragma unroll
            for (int m = 0; m < 4; ++m) { float* rowp = C + (size_t)(row0 + ai * 128 + m * 16) * ldc + col0;
#pragma unroll
                for (int bj = 0; bj < 2; ++bj)
#pragma unroll
                    for (int n = 0; n < 2; ++n) *(pg8::f32x4*)(rowp + bj * 128 + n * 16) = acc[ai][bj][m][n]; }
    }
};
struct EpiBf16g {
    static constexpr bool PERM = true, AFTER_DRAIN = false;
    bf16* O; int ldc; int ntn;
    __device__ __forceinline__ void operator()(const pg8::f32x4 (&acc)[2][2][4][2], const pg8::Unit& u, int wr, int wc, int fr, int fq) const {
        const int row0 = u.pm * 256 + wr * 64 + fr, col0 = (u.pn % ntn) * 256 + wc * 32 + 8 * fq;
#pragma unroll
        for (int ai = 0; ai < 2; ++ai)
#pragma unroll
            for (int m = 0; m < 4; ++m) { bf16* rowp = O + (size_t)(row0 + ai * 128 + m * 16) * ldc + col0;
#pragma unroll
                for (int bj = 0; bj < 2; ++bj) { const pg8::f32x4 v0 = acc[ai][bj][m][0], v1 = acc[ai][bj][m][1]; pg8::u32x4 w;
                    w.x = pg8::cvt_pk_bf16(v0[0], v0[1]); w.y = pg8::cvt_pk_bf16(v0[2], v0[3]); w.z = pg8::cvt_pk_bf16(v1[0], v1[1]); w.w = pg8::cvt_pk_bf16(v1[2], v1[3]);
                    st16(rowp + bj * 128, __builtin_bit_cast(v4u, w)); } }
    }
};
struct EpiSwiglu {
    static constexpr bool PERM = true, AFTER_DRAIN = false;
    unsigned char* ACT;
    __device__ __forceinline__ void operator()(const pg8::f32x4 (&acc)[2][2][4][2], const pg8::Unit& u, int wr, int wc, int fr, int fq) const {
        const int row0 = u.pm * 256 + wr * 64 + fr, col0 = (u.pn % NT1) * 128 + wc * 32 + 8 * fq;
#pragma unroll
        for (int ai = 0; ai < 2; ++ai)
#pragma unroll
            for (int m = 0; m < 4; ++m) { float o[8];
#pragma unroll
                for (int n = 0; n < 2; ++n)
#pragma unroll
                    for (int i = 0; i < 4; ++i) { const float g = acc[ai][0][m][n][i], uu = acc[ai][1][m][n][i]; o[4 * n + i] = g * __builtin_amdgcn_rcpf(1.f + __builtin_amdgcn_exp2f(g * -1.44269504088896341f)) * uu; }
                st8(ACT + (size_t)(row0 + ai * 128 + m * 16) * FF + col0, (unsigned long long)pk4_fp8(o[0], o[1], o[2], o[3]) | ((unsigned long long)pk4_fp8(o[4], o[5], o[6], o[7]) << 32)); }
    }
};
struct OrderBase { __device__ __forceinline__ void a_ready(const pg8::Unit&) const {} __device__ __forceinline__ void done(const pg8::Unit&) const {} };
struct GroupOrder : OrderBase { int nMe, nN, G, c;
    __device__ __forceinline__ bool next(int i, pg8::Unit& u) const {
        if ((G & 7) == 0) { const int xcd = c & 7, j = (c >> 3) + (G >> 3) * i; const int tl = j / nMe, mt = j - tl * nMe; if (tl >= 2 * nN) return false; const int e = xcd + 8 * (tl / nN), nt = tl % nN;
            u.pm = e * 9 + mt; u.pn = e * nN + nt; return true; }
        const int L = i * G + c, per = nMe * nN; if (L >= NE * per) return false; const int e = L / per, r = L % per; u.pm = e * 9 + r % nMe; u.pn = e * nN + r / nMe; return true; } };
struct WoutOrder : OrderBase { int ntile, skipctx, G, c;
    __device__ __forceinline__ bool next(int i, pg8::Unit& u) const { const int L = i * G + c; if (L >= ntile * 4) return false; int t = L >> 2; if (skipctx) t += (t >= 32); u.pm = t; u.pn = L & 3; return true; } };

__device__ __forceinline__ void prep8(const bf16* p, bf16* dst, const float* wv  , bool rope, const f32x2* rp  , bool hi_half) {
    const v4u x = *(const v4u*)p; float v[8] = {bflo(x.x), bfhi(x.x), bflo(x.y), bfhi(x.y), bflo(x.z), bfhi(x.z), bflo(x.w), bfhi(x.w)};
    float ss = 0.f;
#pragma unroll
    for (int i = 0; i < 8; ++i) ss += v[i] * v[i];
    ss += dppf<0xB1>(ss); ss += dppf<0x4E>(ss); ss += dppf<0x141>(ss);
    const float rs = 1.f / sqrtf(ss * (1.f / 64.f) + RMS_EPS);
#pragma unroll
    for (int i = 0; i < 8; ++i) v[i] = v[i] * rs * wv[i];
    if (rope) {
#pragma unroll
        for (int i = 0; i < 8; ++i) { const float partner = dppf<0x4E>(v[i]); const f32x2 cs = rp[i]; v[i] = v[i] * cs.x + (hi_half ? partner : -partner) * cs.y; }
    }
    *(v4u*)dst = (v4u){pk2(v[0], v[1]), pk2(v[2], v[3]), pk2(v[4], v[5]), pk2(v[6], v[7])};
}
__device__ __forceinline__ void ph_attn_prep(const Fr& F, const Args& A, int l) {
    const bf16* P1 = (const bf16*)(A.ws + WS_P1); bf16* QKP = (bf16*)(A.ws + WS_QKP); const f32x2* ROPE = (const f32x2*)(A.ws + WS_ROPE);
    const int gw = F.bid * NWAVES + F.wave, NGW = F.G * NWAVES;
    const int d0 = (F.lane & 7) * 8;
    float qw[8], kw[8];
#pragma unroll
    for (int i = 0; i < 8; ++i) { qw[i] = A.in[11][l * 64 + d0 + i] * attn_body::C2; kw[i] = A.in[12][l * 64 + d0 + i]; }
    const bool hi_half = ((d0 >> 4) & 1) != 0; const bool lastl = (l == DEPTH - 1);
    for (int row = gw; row < MT; row += NGW) {
        const int s = row % SB; const bool lat = s < SEQ;
        const int pos = (d0 < 32) ? (s >> 6) : (s & 63);
        const f32x2* rp = ROPE + (lat ? pos : 0) * 16 + (F.lane & 1) * 8;
        const bf16* rowp = P1 + (size_t)row * NP1; bf16* dstp = QKP + (size_t)row * NQK;
        if (lat || !lastl) prep8(rowp + C_AQ + F.lane * 8, dstp + F.lane * 8, qw, lat, rp, hi_half);
        if (F.lane < 16) prep8(rowp + C_AK + (F.lane & 15) * 8, dstp + 512 + (F.lane & 15) * 8, kw, lat, rp, hi_half);
    }
}

typedef short s16x8 __attribute__((ext_vector_type(8)));
template <int CTRL> __device__ __forceinline__ float dpp_keep(float ident, float v) { return __builtin_bit_cast(float, __builtin_amdgcn_update_dpp(__builtin_bit_cast(int, ident), __builtin_bit_cast(int, v), CTRL, 0xf, 0xf, false)); }
__device__ __forceinline__ float wave_scan_add(float v, int lane) {
    v += dpp_keep<0x111>(0.f, v); v += dpp_keep<0x112>(0.f, v); v += dpp_keep<0x114>(0.f, v); v += dpp_keep<0x118>(0.f, v);
    const float r0 = rlanef(v, 15), r1 = rlanef(v, 31), r2 = rlanef(v, 47); const int row = lane >> 4;
    return v + (row == 0 ? 0.f : (row == 1 ? r0 : (row == 2 ? r0 + r1 : (r0 + r1) + r2)));
}
__device__ __forceinline__ float wave_scan_max(float v, int lane) {
    const float NI = -INFINITY;
    v = fmaxf(v, dpp_keep<0x111>(NI, v)); v = fmaxf(v, dpp_keep<0x112>(NI, v)); v = fmaxf(v, dpp_keep<0x114>(NI, v)); v = fmaxf(v, dpp_keep<0x118>(NI, v));
    const float r0 = rlanef(v, 15), r1 = rlanef(v, 31), r2 = rlanef(v, 47); const int row = lane >> 4;
    return fmaxf(v, row == 0 ? NI : (row == 1 ? r0 : (row == 2 ? fmaxf(r0, r1) : fmaxf(fmaxf(r0, r1), r2))));
}
__device__ __forceinline__ float logsigmoidf_(float x) { return fminf(x, 0.f) - log1pf(expf(-fabsf(x))); }
__device__ __forceinline__ int mpos(int dir, int blk) { return dir == 0 ? (blk >= 64 ? blk - 64 : blk + 2) : (blk >= 64 ? 65 - blk : 65 - blk); }
__device__ __forceinline__ void gate_scan(const Args& A, int l, int row0, int dir, int h, LAS float* BC, LAS float* GG, LAS float* PM, int lane) {
    const float* GT = (const float*)(A.ws + WS_GT); const float bi = A.in[9][((l * 2 + dir) * 2 + 0) * 4 + h], bfg = A.in[9][((l * 2 + dir) * 2 + 1) * 4 + h];
    const int o0 = 2 * lane, o1 = 2 * lane + 1; const int t0 = dir ? 127 - o0 : o0, t1 = dir ? 127 - o1 : o1;
    const float li0 = GT[(size_t)(row0 + t0) * 16 + dir * 8 + h] + bi, li1 = GT[(size_t)(row0 + t1) * 16 + dir * 8 + h] + bi;
    const float lf0 = logsigmoidf_(GT[(size_t)(row0 + t0) * 16 + dir * 8 + 4 + h] + bfg), lf1 = logsigmoidf_(GT[(size_t)(row0 + t1) * 16 + dir * 8 + 4 + h] + bfg);
    const float S = wave_scan_add(lf0 + lf1, lane); const float b0 = S - lf1, b1 = S;
    const float g0 = li0 - b0, g1 = li1 - b1;
    const float M = wave_scan_max(fmaxf(g0, g1), lane); float Mprev = __shfl_up(M, 1); if (lane == 0) Mprev = -INFINITY;
    BC[t0] = b0; BC[t1] = b1; GG[t0] = g0; GG[t1] = g1; PM[t0] = fmaxf(Mprev, g0); PM[t1] = M;
}
__device__ __forceinline__ void qk_conv8(const bf16* P1, const float* cw  , const float* cb, int row, int seq_lo, int seq_hi, int ch, float scale, float (&o)[8]) {
    const v4u z = {0u, 0u, 0u, 0u};
    const v4u xm = (row - 1 >= seq_lo) ? *(const v4u*)(P1 + (size_t)(row - 1) * NP1 + ch) : z;
    const v4u x0 = *(const v4u*)(P1 + (size_t)row * NP1 + ch);
    const v4u xp = (row + 1 < seq_hi) ? *(const v4u*)(P1 + (size_t)(row + 1) * NP1 + ch) : z;
    const f32x4 w0a = *(const f32x4*)(cw + ch), w0b = *(const f32x4*)(cw + ch + 4), w1a = *(const f32x4*)(cw + 512 + ch), w1b = *(const f32x4*)(cw + 512 + ch + 4), w2a = *(const f32x4*)(cw + 1024 + ch), w2b = *(const f32x4*)(cw + 1024 + ch + 4);
    const f32x4 ba = *(const f32x4*)(cb + ch), bb = *(const f32x4*)(cb + ch + 4);
    const unsigned am[4] = {xm.x, xm.y, xm.z, xm.w}, a0[4] = {x0.x, x0.y, x0.z, x0.w}, ap[4] = {xp.x, xp.y, xp.z, xp.w};
#pragma unroll
    for (int i = 0; i < 4; ++i) {
        const float wl0 = i < 2 ? w0a[2 * i] : w0b[2 * i - 4], wh0 = i < 2 ? w0a[2 * i + 1] : w0b[2 * i - 3];
        const float wl1 = i < 2 ? w1a[2 * i] : w1b[2 * i - 4], wh1 = i < 2 ? w1a[2 * i + 1] : w1b[2 * i - 3];
        const float wl2 = i < 2 ? w2a[2 * i] : w2b[2 * i - 4], wh2 = i < 2 ? w2a[2 * i + 1] : w2b[2 * i - 3];
        const float bl = i < 2 ? ba[2 * i] : bb[2 * i - 4], bh = i < 2 ? ba[2 * i + 1] : bb[2 * i - 3];
        const float ul = bl + wl0 * bflo(am[i]) + wl1 * bflo(a0[i]) + wl2 * bflo(ap[i]);
        const float uh = bh + wh0 * bfhi(am[i]) + wh1 * bfhi(a0[i]) + wh2 * bfhi(ap[i]);
        o[2 * i] = siluf_(ul) * scale; o[2 * i + 1] = siluf_(uh) * scale;
    }
}
constexpr int ML_QT = 0, ML_KN = 18432, ML_AP = 36864, ML_BTP = 88064, ML_VEC = 113664;
constexpr int ML_VT = 36864, ML_KT = 36864 + 26112;
__device__ __forceinline__ void ph_mlstm_local(const Fr& F, const Args& A, int l) {
    const bf16* P1 = (const bf16*)(A.ws + WS_P1); float* SLOC = (float*)(A.ws + WS_SLOC);
    LAS unsigned char* L = F.lds + RING_OFF;
    LAS unsigned short* VT = (LAS unsigned short*)(L + ML_VT); LAS unsigned short* KT = (LAS unsigned short*)(L + ML_KT);
    LAS float* BC = (LAS float*)(L + ML_VEC); LAS float* GG = BC + 256; LAS float* PM = GG + 256; LAS float* WW = PM + 256;
    const float* cw = A.in[7] + (size_t)l * 3 * 512; const float* cb = A.in[8] + l * 512;
    for (int u = F.bid; u < NB * 4 * NPOS; u += F.G) {
        const int b = u / (4 * NPOS), h = (u / NPOS) & 3, blk = u % NPOS;
        const int row0 = b * SB + blk * 128; const int seq_lo = blk < 64 ? b * SB : b * SB + SEQ, seq_hi = blk < 64 ? b * SB + SEQ : (b + 1) * SB;
        BSYNC();
        if (F.wave < 2) gate_scan(A, l, row0, F.wave, h, BC + F.wave * 128, GG + F.wave * 128, PM + F.wave * 128, F.lane);
#pragma unroll
        for (int it = 0; it < 2; ++it) { const int idx = F.tid + it * NTHR, t = idx >> 3, c8 = idx & 7; float o[8];
            qk_conv8(P1, cw, cb, row0 + t, seq_lo, seq_hi, C_MK + h * 64 + c8 * 8, 1.f, o);
#pragma unroll
            for (int i = 0; i < 8; ++i) KT[(c8 * 8 + i) * 136 + t] = (unsigned short)f2bf(o[i]); }
        BSYNC();
        for (int dir = 0; dir < 2; ++dir) {
            const float pmall = dir ? PM[128 + 0] : PM[127];
            const float atot = dir ? BC[128 + 0] : BC[127];
            if (F.tid < 128) { const float wv = fexp(GG[dir * 128 + F.tid] - pmall); WW[dir * 128 + F.tid] = wv; VT[64 * 136 + F.tid] = (unsigned short)f2bf(wv); }
            BSYNC();
#pragma unroll
            for (int it = 0; it < 2; ++it) { const int idx = F.tid + it * NTHR, t = idx >> 3, c8 = idx & 7; const float w = WW[dir * 128 + t];
                const v4u x = *(const v4u*)(P1 + (size_t)(row0 + t) * NP1 + C_MV + h * 64 + c8 * 8); const unsigned xa[4] = {x.x, x.y, x.z, x.w};
#pragma unroll
                for (int i = 0; i < 4; ++i) { VT[(c8 * 8 + 2 * i) * 136 + t] = (unsigned short)f2bf(w * bflo(xa[i])); VT[(c8 * 8 + 2 * i + 1) * 136 + t] = (unsigned short)f2bf(w * bfhi(xa[i])); } }
            BSYNC();
            const int stream = (dir * 2 + b) * 4 + h, p = mpos(dir, blk);
            float* rec = SLOC + ((size_t)stream * NPOS + p) * SST;
            if (F.wave < 6) {
                const int be = F.wave >> 1, bd = F.wave & 1, r = F.lane & 31, hh = F.lane >> 5; f32x16 acc = {};
#pragma unroll
                for (int kk = 0; kk < 8; ++kk) { const s16x8 a = *(const LAS s16x8*)(VT + (be * 32 + r) * 136 + kk * 16 + hh * 8), bb = *(const LAS s16x8*)(KT + (bd * 32 + r) * 136 + kk * 16 + hh * 8);
                    acc = __builtin_amdgcn_mfma_f32_32x32x16_bf16(a, bb, acc, 0, 0, 0); }
                if (be < 2) {
#pragma unroll
                    for (int g = 0; g < 16; ++g) { const int e = be * 32 + (g & 3) + 8 * (g >> 2) + 4 * hh; rec[e * 64 + bd * 32 + r] = acc[g]; }
                } else if (hh == 0) rec[4096 + bd * 32 + r] = acc[0];
            } else if (F.wave == 6 && F.lane == 0) { rec[4160] = atot; rec[4161] = atot + pmall; }
            BSYNC();
        }
    }
}
__device__ __forceinline__ void ph_mlstm_carry(const Fr& F, const Args& A) {
    const float* __restrict__ SLOC = (const float*)(A.ws + WS_SLOC); float* __restrict__ SCAR = (float*)(A.ws + WS_SCAR);
    const int vb = F.G - 1 - F.bid; const int gid = vb * NTHR + F.tid, NG = F.G * NTHR;
    for (int i = gid; i < 16 * 4160; i += NG) {
        const int stream = i / 4160, el = i % 4160; float m = 0.f, val = 0.f;
        const float* __restrict__ sl = SLOC + (size_t)stream * NPOS * SST; float* __restrict__ sc = SCAR + (size_t)stream * NPOS * SST;
#pragma unroll 1
        for (int p0 = 0; p0 < NPOS; p0 += 6) {
            float a[6], ml[6], dl[6];
#pragma unroll
            for (int q = 0; q < 6; ++q) { const size_t o = (size_t)(p0 + q) * SST; a[q] = sl[o + 4160]; ml[q] = sl[o + 4161]; dl[q] = sl[o + el]; }
#pragma unroll
            for (int q = 0; q < 6; ++q) { const size_t o = (size_t)(p0 + q) * SST;
                sc[o + el] = val; if (el == 0) sc[o + 4160] = m;
                const float mn = fmaxf(a[q] + m, ml[q]);
                val = fexp(a[q] + m - mn) * val + fexp(ml[q] - mn) * dl[q]; m = mn; }
        }
    }
}
constexpr int M3_QT = 0, M3_KN = 18432, M3_AP = 36864, M3_VT = 88064, M3_C0 = 105472, M3_VEC = 123904;
__device__ __forceinline__ void ph_mlstm_out(const Fr& F, const Args& A, int l, int u_lo, int u_hi, int boff) {
    const bf16* P1 = (const bf16*)(A.ws + WS_P1); const float* SCAR = (const float*)(A.ws + WS_SCAR); const float* SLOC = (const float*)(A.ws + WS_SLOC); bf16* Y = (bf16*)(A.ws + WS_Y);
    LAS unsigned char* L = F.lds + RING_OFF;
    LAS unsigned short* QT = (LAS unsigned short*)(L + M3_QT); LAS unsigned short* KN = (LAS unsigned short*)(L + M3_KN);
    LAS unsigned short* AP = (LAS unsigned short*)(L + M3_AP); LAS unsigned short* VT = (LAS unsigned short*)(L + M3_VT); LAS unsigned short* C0B = (LAS unsigned short*)(L + M3_C0);
    LAS float* BC = (LAS float*)(L + M3_VEC); LAS float* GG = BC + 256; LAS float* PM = GG + 256;
    LAS float* MM = PM + 256; LAS float* WI = MM + 256; LAS float* DEN = WI + 256; LAS float* N0 = DEN + 256; LAS float* SS = N0 + 128; LAS float* M0 = SS + 512;
    const float* cw = A.in[7] + (size_t)l * 3 * 512; const float* cb = A.in[8] + l * 512;
    const int r = F.lane & 31, hh = F.lane >> 5;
    for (int u = u_lo + ((F.bid + F.G - boff) % F.G); u < u_hi; u += F.G) {
        int b, h, blk;
        if (u < 512) { b = u >> 8; h = (u >> 6) & 3; blk = u & 63; } else { const int v = u - 512; b = v >> 3; h = (v >> 1) & 3; blk = 64 + (v & 1); }
        const int row0 = b * SB + blk * 128; const int seq_lo = blk < 64 ? b * SB : b * SB + SEQ, seq_hi = blk < 64 ? b * SB + SEQ : (b + 1) * SB;
        BSYNC();
        if (F.wave < 2) gate_scan(A, l, row0, F.wave, h, BC + F.wave * 128, GG + F.wave * 128, PM + F.wave * 128, F.lane);
#pragma unroll
        for (int dir = 0; dir < 2; ++dir) {
            const int stream = (dir * 2 + b) * 4 + h, p = mpos(dir, blk);
            const float* rec = p >= 2 ? SCAR + ((size_t)stream * NPOS + p) * SST : SLOC + ((size_t)stream * NPOS) * SST;
            float m0, sc;
            if (p >= 2) { m0 = rec[4160]; sc = 1.f; } else if (p == 1) { const float a0 = rec[4160], ml = rec[4161]; m0 = fmaxf(a0, ml); sc = expf(ml - m0); } else { m0 = 0.f; sc = 0.f; }
            { const int e = F.tid >> 3, d0 = (F.tid & 7) * 8; const f32x4 c0 = *(const f32x4*)(rec + e * 64 + d0), c1 = *(const f32x4*)(rec + e * 64 + d0 + 4);
              *(LAS v4u*)(C0B + (dir * 64 + e) * 72 + d0) = (v4u){pk2(c0.x * sc, c0.y * sc), pk2(c0.z * sc, c0.w * sc), pk2(c1.x * sc, c1.y * sc), pk2(c1.z * sc, c1.w * sc)}; }
            if (F.tid < 64) N0[dir * 64 + F.tid] = rec[4096 + F.tid] * sc;
            if (F.tid == 64) M0[dir] = m0;
        }
#pragma unroll
        for (int it = 0; it < 2; ++it) { const int idx = F.tid + it * NTHR, t = idx >> 3, c8 = idx & 7; float o[8];
            qk_conv8(P1, cw, cb, row0 + t, seq_lo, seq_hi, C_MQ + h * 64 + c8 * 8, 0.125f, o);
            *(LAS v4u*)(QT + t * 72 + c8 * 8) = (v4u){pk2(o[0], o[1]), pk2(o[2], o[3]), pk2(o[4], o[5]), pk2(o[6], o[7])};
            qk_conv8(P1, cw, cb, row0 + t, seq_lo, seq_hi, C_MK + h * 64 + c8 * 8, 1.f, o);
            *(LAS v4u*)(KN + t * 72 + c8 * 8) = (v4u){pk2(o[0], o[1]), pk2(o[2], o[3]), pk2(o[4], o[5]), pk2(o[6], o[7])};
            const v4u x = *(const v4u*)(P1 + (size_t)(row0 + t) * NP1 + C_MV + h * 64 + c8 * 8); const unsigned xa[4] = {x.x, x.y, x.z, x.w};
#pragma unroll
            for (int i = 0; i < 4; ++i) { VT[(c8 * 8 + 2 * i) * 136 + t] = (unsigned short)(xa[i] & 0xffffu); VT[(c8 * 8 + 2 * i + 1) * 136 + t] = (unsigned short)(xa[i] >> 16); } }
        BSYNC();
        if (F.tid < 256) { const int dir = F.tid >> 7, j = F.tid & 127; const float m0 = M0[dir]; const float mm = fmaxf(m0, PM[dir * 128 + j]); MM[F.tid] = mm; WI[F.tid] = fexp(m0 - mm); }
        BSYNC();
        f32x16 osum = {};
        const int bj = F.wave >> 1, be = F.wave & 1;
#pragma unroll 1
        for (int dir = 0; dir < 2; ++dir) {
#pragma unroll
            for (int it = 0; it < 2; ++it) { const int idx = F.tid + it * NTHR, t = idx >> 3, c8 = idx & 7; const float w = WI[dir * 128 + t];
                const v4u x = *(const LAS v4u*)(QT + t * 72 + c8 * 8);
                *(LAS v4u*)(AP + t * 200 + 128 + c8 * 8) = (v4u){pk2(bflo(x.x) * w, bfhi(x.x) * w), pk2(bflo(x.y) * w, bfhi(x.y) * w), pk2(bflo(x.z) * w, bfhi(x.z) * w), pk2(bflo(x.w) * w, bfhi(x.w) * w)}; }
#pragma unroll
            for (int q2 = 0; q2 < 2; ++q2) { const int blkid = F.wave * 2 + q2, bi = blkid >> 2, bs = blkid & 3; f32x16 acc = {};
                const bool need = dir ? (bs >= bi) : (bs <= bi);
                if (need) {
#pragma unroll
                    for (int kk = 0; kk < 4; ++kk) { const s16x8 a = *(const LAS s16x8*)(KN + (bs * 32 + r) * 72 + kk * 16 + hh * 8), bb = *(const LAS s16x8*)(QT + (bi * 32 + r) * 72 + kk * 16 + hh * 8);
                        acc = __builtin_amdgcn_mfma_f32_32x32x16_bf16(a, bb, acc, 0, 0, 0); } }
                const int j = bi * 32 + r; const float mmj = MM[dir * 128 + j];
#pragma unroll
                for (int q = 0; q < 4; ++q) { const int s0 = bs * 32 + 8 * q + 4 * hh; const f32x4 gs = *(const LAS f32x4*)(GG + dir * 128 + s0); float v[4];
#pragma unroll
                    for (int i = 0; i < 4; ++i) { const int sidx = s0 + i; const bool valid = dir ? (sidx >= j) : (sidx <= j); v[i] = valid ? acc[4 * q + i] * fexp(gs[i] - mmj) : 0.f; }
                    *(LAS unsigned long long*)(AP + j * 200 + s0) = (unsigned long long)pk2(v[0], v[1]) | ((unsigned long long)pk2(v[2], v[3]) << 32); } }
            BSYNC();
            { const int j = F.tid >> 2, part = F.tid & 3; float a = 0.f;
#pragma unroll
              for (int i = 0; i < 6; ++i) { const int k0 = part * 48 + 8 * i; const v4u x = *(const LAS v4u*)(AP + j * 200 + k0); const float f[8] = {bflo(x.x), bfhi(x.x), bflo(x.y), bfhi(x.y), bflo(x.z), bfhi(x.z), bflo(x.w), bfhi(x.w)};
                  if (k0 < 128) { a += ((f[0] + f[1]) + (f[2] + f[3])) + ((f[4] + f[5]) + (f[6] + f[7])); }
                  else { const LAS float* nn = N0 + dir * 64 + (k0 - 128);
#pragma unroll
                      for (int q = 0; q < 8; ++q) a += f[q] * nn[q]; } }
              a += dppf<0xB1>(a); a += dppf<0x4E>(a); if (part == 0) DEN[dir * 128 + j] = a; }
            f32x16 acc = {};
#pragma unroll
            for (int kk = 0; kk < 12; ++kk) { const s16x8 a = *(const LAS s16x8*)(AP + (bj * 32 + r) * 200 + kk * 16 + hh * 8);
                const s16x8 bb = kk < 8 ? *(const LAS s16x8*)(VT + (be * 32 + r) * 136 + kk * 16 + hh * 8) : *(const LAS s16x8*)(C0B + (dir * 64 + be * 32 + r) * 72 + (kk - 8) * 16 + hh * 8);
                acc = __builtin_amdgcn_mfma_f32_32x32x16_bf16(a, bb, acc, 0, 0, 0); }
            BSYNC();
#pragma unroll
            for (int g = 0; g < 16; ++g) { const int j = bj * 32 + (g & 3) + 8 * (g >> 2) + 4 * hh; const float den = fmaxf(fabsf(DEN[dir * 128 + j]), fexp(-(BC[dir * 128 + j] + MM[dir * 128 + j]))); osum[g] += acc[g] * __builtin_amdgcn_rcpf(den); }
        }
        float ssq[16];
#pragma unroll
        for (int g = 0; g < 16; ++g) { float q = osum[g] * osum[g]; q += dppf<0xB1>(q); q += dppf<0x4E>(q); q += dppf<0x141>(q); q += dppf<0x140>(q); ssq[g] = q; }
        if ((F.lane & 15) == 0) {
#pragma unroll
            for (int g = 0; g < 16; ++g) SS[(be * 2 + ((F.lane >> 4) & 1)) * 128 + bj * 32 + (g & 3) + 8 * (g >> 2) + 4 * hh] = ssq[g]; }
        BSYNC();
        const int e = be * 32 + r; const float nw = A.in[10][l * 256 + h * 64 + e];
#pragma unroll
        for (int g = 0; g < 16; ++g) { const int j = bj * 32 + (g & 3) + 8 * (g >> 2) + 4 * hh; const float tot = (SS[j] + SS[128 + j]) + (SS[256 + j] + SS[384 + j]);
            const float og = bf2f(P1[(size_t)(row0 + j) * NP1 + C_MO + h * 64 + e]);
            const float y = osum[g] * (1.f / sqrtf(tot * (1.f / 64.f) + RMS_EPS)) * nw * sigmoidf_(og);
            Y[(size_t)(row0 + j) * DM + h * 64 + e] = (bf16)f2bf(y); }
    }
}

__device__ __forceinline__ float hy_conv(const float* p, int t, int n, float w0, float w1, float w2, float bb) {
    const float xm = t > 0 ? p[t - 1] : 0.f, x0 = p[t], xp = t + 1 < n ? p[t + 1] : 0.f; return bb + w0 * xm + w1 * x0 + w2 * xp; }
__device__ __forceinline__ void hy_row16(const float* p, int t0, float w0, float w1, float w2, float bb, float (&out)[16]) {
    const f32x4 a = *(const f32x4*)(p + t0), b = *(const f32x4*)(p + t0 + 4), c = *(const f32x4*)(p + t0 + 8), d = *(const f32x4*)(p + t0 + 12);
    const float lo = t0 > 0 ? p[t0 - 1] : 0.f, hi = t0 + 16 < SEQ ? p[t0 + 16] : 0.f;
    const float x[18] = {lo, a.x, a.y, a.z, a.w, b.x, b.y, b.z, b.w, c.x, c.y, c.z, c.w, d.x, d.y, d.z, d.w, hi};
#pragma unroll
    for (int i = 0; i < 16; ++i) out[i] = bb + w0 * x[i] + w1 * x[i + 1] + w2 * x[i + 2];
}
__device__ __forceinline__ void hy_spectrum_mul(LAS f32x2* d, const f32x2* __restrict__ hf, int tid) {
#pragma unroll 1
    for (int i0 = 0; i0 < NFFT; i0 += 16 * NTHR) { f32x2 h[16];
#pragma unroll
        for (int k = 0; k < 16; ++k) h[k] = hf[i0 + k * NTHR + tid];
#pragma unroll
        for (int k = 0; k < 16; ++k) { const int i = i0 + k * NTHR + tid; d[fphys(i)] = cmul(d[fphys(i)], h[k]); } }
}
__device__ __forceinline__ void ph_hyena(const Fr& F, const Args& A, int l) {
    const float* HY = (const float*)(A.ws + WS_HY); bf16* Y = (bf16*)(A.ws + WS_Y); float* ZT = (float*)(A.ws + WS_Z1);
    const f32x2* TW = (const f32x2*)(A.ws + WS_TW); const f32x2* HF = (const f32x2*)(A.ws + WS_HF);
    LAS f32x2* d = (LAS f32x2*)(F.lds + RING_OFF);
    const bool lastl = (l == DEPTH - 1);
    for (int c = F.bid; c < 256; c += F.G) {
        const float* cwp = A.in[13] + (size_t)l * 3 * 768; const float* cbp = A.in[14] + l * 768;
        float cw[3][3], cbv[3];
#pragma unroll
        for (int w = 0; w < 3; ++w) { cbv[w] = cbp[w * 256 + c];
#pragma unroll
            for (int j = 0; j < 3; ++j) cw[w][j] = cwp[j * 768 + w * 256 + c]; }
        const float sk0 = A.in[21][(l * 2 + 0) * 256 + c], sk1 = A.in[21][(l * 2 + 1) * 256 + c];
        const float* hb0 = HY + ((size_t)(0 * 768 + c)) * SB; const float* hb1 = HY + ((size_t)(1 * 768 + c)) * SB;
        const int t0 = 16 * F.tid; const int pb = fphys(t0);
        float z0[16], z1[16];
        BSYNC();
        hy_row16(hb0, t0, cw[0][0], cw[0][1], cw[0][2], cbv[0], z0); hy_row16(hb1, t0, cw[0][0], cw[0][1], cw[0][2], cbv[0], z1);
#pragma unroll
        for (int i = 0; i < 16; ++i) { d[pb + i] = (f32x2){z0[i], z1[i]}; d[fphys(SEQ + t0) + i] = (f32x2){0.f, 0.f}; }
        BSYNC();
#pragma unroll 1
        for (int o = 0; o < 2; ++o) {
            fft_fwd(d, TW, F.tid);
            hy_spectrum_mul(d, HF + ((size_t)(l * 2 + o) * 256 + c) * NFFT, F.tid);
            BSYNC();
            fft_inv(d, TW, F.tid);
            float x0[16], x1[16]; const int w = 1 + o; const float sk = o ? sk1 : sk0;
            hy_row16(hb0 + (size_t)(w * 256) * SB, t0, cw[w][0], cw[w][1], cw[w][2], cbv[w], x0); hy_row16(hb1 + (size_t)(w * 256) * SB, t0, cw[w][0], cw[w][1], cw[w][2], cbv[w], x1);
#pragma unroll
            for (int i = 0; i < 16; ++i) { const f32x2 cv = d[pb + i]; z0[i] = x0[i] * (cv.x + sk * z0[i]); z1[i] = x1[i] * (cv.y + sk * z1[i]); }
            if (o == 0) {
#pragma unroll
                for (int i = 0; i < 16; ++i) { d[pb + i] = (f32x2){z0[i], z1[i]}; d[fphys(SEQ + t0) + i] = (f32x2){0.f, 0.f}; }
            }
            BSYNC();
        }
        { float* o0 = ZT + ((size_t)(0 * 256 + c)) * SEQ + t0; float* o1 = ZT + ((size_t)(1 * 256 + c)) * SEQ + t0;
#pragma unroll
          for (int i4 = 0; i4 < 4; ++i4) { st16(o0 + 4 * i4, __builtin_bit_cast(v4u, (f32x4){z0[4 * i4], z0[4 * i4 + 1], z0[4 * i4 + 2], z0[4 * i4 + 3]})); st16(o1 + 4 * i4, __builtin_bit_cast(v4u, (f32x4){z1[4 * i4], z1[4 * i4 + 1], z1[4 * i4 + 2], z1[4 * i4 + 3]})); } }
        if (!lastl) {
            LAS float* zc = (LAS float*)(F.lds + RING_OFF); LAS float* tp = zc + 512;
            const float* TAPC = (const float*)(A.ws + WS_TAPC) + ((size_t)(l * 2) * 256 + c) * 512;
            const int b = F.tid >> 8, t = F.tid & 255;
            const float* base = HY + ((size_t)(b * 768 + c)) * SB + SEQ;
            const float vc = hy_conv(base, t, CTXL, cw[0][0], cw[0][1], cw[0][2], cbv[0]);
            const float x1c = hy_conv(base + (size_t)256 * SB, t, CTXL, cw[1][0], cw[1][1], cw[1][2], cbv[1]);
            const float x2c = hy_conv(base + (size_t)512 * SB, t, CTXL, cw[2][0], cw[2][1], cw[2][2], cbv[2]);
            BSYNC();
            zc[F.tid] = vc; tp[F.tid] = TAPC[F.tid]; tp[512 + F.tid] = TAPC[(size_t)256 * 512 + F.tid];
            BSYNC();
            float y = 0.f; for (int q = 0; q < 256; ++q) y += tp[256 + t - q] * zc[b * 256 + q];
            const float zz1 = x1c * (y + sk0 * vc);
            BSYNC(); zc[F.tid] = zz1; BSYNC();
            float y2 = 0.f; for (int q = 0; q < 256; ++q) y2 += tp[512 + 256 + t - q] * zc[b * 256 + q];
            const float zz2 = x2c * (y2 + sk1 * zz1);
            Y[((size_t)b * SB + SEQ + t) * DM + 768 + c] = (bf16)f2bf(zz2);
        }
    }
}

__device__ __forceinline__ void ph_hy_transpose(const Fr& F, const Args& A) {
    const float* ZT = (const float*)(A.ws + WS_Z1); bf16* Y = (bf16*)(A.ws + WS_Y);
    LAS float* tile = (LAS float*)(F.lds + RING_OFF);
    for (int u = F.bid; u < NB * (SEQ / 64); u += F.G) {
        const int b = u / (SEQ / 64), t0 = (u % (SEQ / 64)) * 64;
        BSYNC();
#pragma unroll
        for (int k = 0; k < 8; ++k) { const int idx = F.tid + NTHR * k, c = idx >> 4, f4 = idx & 15; const f32x4 v = *(const f32x4*)(ZT + ((size_t)(b * 256 + c)) * SEQ + t0 + 4 * f4);
            tile[(4 * f4 + 0) * 257 + c] = v.x; tile[(4 * f4 + 1) * 257 + c] = v.y; tile[(4 * f4 + 2) * 257 + c] = v.z; tile[(4 * f4 + 3) * 257 + c] = v.w; }
        BSYNC();
#pragma unroll
        for (int k = 0; k < 4; ++k) { const int idx = F.tid + NTHR * k, t = idx >> 5, c8 = idx & 31; const LAS float* sp = tile + t * 257 + c8 * 8;
            *(v4u*)(Y + ((size_t)b * SB + t0 + t) * DM + 768 + c8 * 8) = (v4u){pk2(sp[0], sp[1]), pk2(sp[2], sp[3]), pk2(sp[4], sp[5]), pk2(sp[6], sp[7])}; }
    }
}

__device__ __forceinline__ void ph_attention(const Fr& F, const Args& A, int l, unsigned char* lds_generic, int i_lo, int i_hi) {
    const attn_body::bf16* P1 = (const attn_body::bf16*)(A.ws + WS_P1); const attn_body::bf16* QKP = (const attn_body::bf16*)(A.ws + WS_QKP); attn_body::bf16* Y = (attn_body::bf16*)(A.ws + WS_Y);
    const int nun = (l == DEPTH - 1) ? 512 : 528;
    for (int i = i_lo; i < i_hi; ++i) { const int u = F.bid + i * F.G; if (u >= nun) break;
        int b, hq, q0, kv0, nt;
        if (u < 512) { b = u >> 8; hq = (u >> 5) & 7; q0 = (u & 31) * 256; kv0 = 0; nt = SB / 64; }
        else { const int v = u - 512; b = v >> 3; hq = v & 7; q0 = SEQ; kv0 = SEQ; nt = CTXL / 64; }
        const int kvh = hq >> 2;
        const attn_body::bf16* Qb = QKP + ((size_t)b * SB + q0) * NQK + hq * 64;
        const attn_body::bf16* Kb = QKP + ((size_t)b * SB + kv0) * NQK + 512 + kvh * 64;
        const attn_body::bf16* Vb = P1 + ((size_t)b * SB + kv0) * NP1 + C_AV + kvh * 64;
        attn_body::bf16* Ob = Y + ((size_t)b * SB + q0) * DM + 256 + hq * 64;
        attn_body::attn_unit<8>(Qb, NQK, Kb, Vb, NQK, NP1, nt, Ob, DM, (char*)lds_generic + RING_OFF, F.tid);
    }
}

__device__ __forceinline__ int block_count(int v, LAS int* slot  , int it, int wave, int lane) {
    v = wave_sum_i(v);
    if (lane == 0) slot[(it & 1) * 8 + wave] = v;
    BSYNC();
    int s = 0;
#pragma unroll
    for (int i = 0; i < NWAVES; ++i) s += slot[(it & 1) * 8 + i];
    return s;
}
__device__ __forceinline__ int block_excl_scan(int v, LAS int* wtot  , int wave, int lane, int& tot) {
    int inc = v;
#pragma unroll
    for (int o = 1; o < 64; o <<= 1) { const int t = __shfl_up(inc, o); if (lane >= o) inc += t; }
    BSYNC();
    if (lane == 63) wtot[wave] = inc;
    BSYNC();
    int pre = 0; tot = 0;
#pragma unroll
    for (int i = 0; i < NWAVES; ++i) { const int x = wtot[i]; if (i < wave) pre += x; tot += x; }
    return pre + inc - v;
}
__device__ __forceinline__ void ph_select(const Fr& F, const Args& A, int l) {
    const float* AFF = (const float*)(A.ws + WS_AFF); int* INV = (int*)(A.ws + WS_INV); int* IDX = (int*)(A.ws + WS_IDX); float* VAL = (float*)(A.ws + WS_VAL);
    LAS int* slot = (LAS int*)(F.lds + LDSX_OFF); LAS int* wtot = slot + 16;
    const int nun = (l == DEPTH - 1) ? 32 : 64;
    for (int u = F.bid; u < nun; u += F.G) {
        const int kind = u >> 5, b = (u >> 4) & 1, e = u & 15;
        const int n = kind ? CTXL : SEQ, cap = n / 8, sbase = kind ? SEQ : 0;
        const float* ap = AFF + ((size_t)b * 16 + e) * SB + sbase;
        unsigned key[16];
#pragma unroll
        for (int i4 = 0; i4 < 4; ++i4) { const int t = 16 * F.tid + 4 * i4; v4u x = {0u, 0u, 0u, 0u}; if (t < n) x = *(const v4u*)(ap + t); key[4 * i4] = x.x; key[4 * i4 + 1] = x.y; key[4 * i4 + 2] = x.z; key[4 * i4 + 3] = x.w; }
        const bool tv = (16 * F.tid < n);
        BSYNC();
        unsigned T = 0u; int itc = 0;
        for (int bit = 31; bit >= 0; --bit) { const unsigned cand = T | (1u << bit); int cnt = 0;
#pragma unroll
            for (int i = 0; i < 16; ++i) cnt += (tv && key[i] >= cand) ? 1 : 0;
            if (block_count(cnt, slot, itc++, F.wave, F.lane) >= cap) T = cand; }
        int cgt = 0, ceq = 0;
#pragma unroll
        for (int i = 0; i < 16; ++i) { cgt += (tv && key[i] > T) ? 1 : 0; ceq += (tv && key[i] == T) ? 1 : 0; }
        int tot_gt, tot_eq; (void)block_excl_scan(cgt, wtot, F.wave, F.lane, tot_gt);
        int eqrank = block_excl_scan(ceq, wtot, F.wave, F.lane, tot_eq);
        const int need = cap - tot_gt;
        unsigned selmask = 0u; int csel = 0;
#pragma unroll
        for (int i = 0; i < 16; ++i) { bool sel = false; if (tv) { if (key[i] > T) sel = true; else if (key[i] == T) { sel = eqrank < need; ++eqrank; } } if (sel) { selmask |= 1u << i; ++csel; } }
        int tot_sel; int sl = block_excl_scan(csel, wtot, F.wave, F.lane, tot_sel);
        if (tv) {
#pragma unroll
            for (int i = 0; i < 16; ++i) { const int t = 16 * F.tid + i; const int row = b * SB + sbase + t; int r1 = 0;
                if (selmask & (1u << i)) { const int rr = (kind ? 2048 + b * 32 : b * 1024) + sl; ++sl; IDX[e * ROWS_E + rr] = row; VAL[e * ROWS_E + rr] = __uint_as_float(key[i]); r1 = rr + 1; }
                INV[(size_t)row * 16 + e] = r1; }
        }
    }
}
constexpr int NPH_PRO = 3, NPH_LAYER = 10, NPH = NPH_PRO + DEPTH * NPH_LAYER;
template <unsigned KMASK> __global__ void __launch_bounds__(NTHR, 2) mk_fwd(Args args) {
    extern __shared__ __attribute__((aligned(16))) unsigned char lds[];
    Fr F; F.lds = (LAS unsigned char*)lds; F.tid = threadIdx.x; F.lane = F.tid & 63; F.wave = __builtin_amdgcn_readfirstlane(F.tid >> 6); F.G = gridDim.x; F.bid = blockIdx.x;
    unsigned char* ws = args.ws;
    for (int u = F.tid; u < (LDS_BYTES - LDSCTL_OFF) / 4; u += NTHR) ((LAS unsigned*)(F.lds + LDSCTL_OFF))[u] = 0u;
    __syncthreads();
#if MK_SINGLE
    XcdBarrier bar = xcd_barrier_post((unsigned*)(ws + WS_CTL) + 1024, (volatile LAS unsigned*)(F.lds + MISC_OFF) + 8);
#ifdef PROBE_DBLBAR
#define GRID_BAR() do { xcd_barrier(bar); xcd_barrier(bar); } while (0)
#else
#define GRID_BAR() xcd_barrier(bar)
#endif
#else
#define GRID_BAR() do {} while (0)
#endif
    const int lo = args.ph_lo, hi = args.ph_hi;
#define IN(k) (lo <= (k) && (k) < hi)
#define KIND(q) if constexpr ((KMASK >> (q)) & 1u)
#ifndef PROBE_KIND
#define PROBE_KIND -1
#endif
#ifndef PROBE_REPS
#define PROBE_REPS 0
#endif
#ifdef PROBE_REPBAR
#define REP(q) for (int rep_ = 0; rep_ < (((q) == PROBE_KIND || PROBE_KIND == 99) ? 1 + PROBE_REPS : 1); ++rep_, (rep_ < (((q) == PROBE_KIND || PROBE_KIND == 99) ? 1 + PROBE_REPS : 1) ? (void)(GRID_BAR()) : (void)0))
#else
#define REP(q) for (int rep_ = 0; rep_ < (((q) == PROBE_KIND || PROBE_KIND == 99) ? 1 + PROBE_REPS : 1); ++rep_)
#endif
#define SEAM(k) do { if (IN(k) && IN((k) + 1)) GRID_BAR(); } while (0)
    KIND(0) if (IN(0)) REP(0) { const Fr Fp = fr_fresh(F); ph_convert(Fp, args); } SEAM(0);
    KIND(1) if (IN(1)) REP(1) { const Fr Fp = fr_fresh(F); ph_taps(Fp, args); } SEAM(1);
    KIND(2) if (IN(2)) { REP(2) { const Fr Fp = fr_fresh(F); ph_ln_a0(Fp, args); } REP(17) { const Fr Fp = fr_fresh(F); ph_filters(Fp, args); } } SEAM(2);
    for (int l = 0; l < DEPTH; ++l) {
        const int pb = NPH_PRO + l * NPH_LAYER; const bool lastl = (l == DEPTH - 1);
        KIND(3) if (IN(pb + 0)) REP(3) {
            const Fr Fp = fr_fresh(F);
            pg8::Gemm g{(const pg8::bf16_t*)(ws + WS_HN), (const pg8::bf16_t*)(ws + WS_WINT) + (size_t)l * NWIN * DM, MT, NWIN, DM}; pg8::StaticOrder S; S.init(MT, NWIN, Fp.G, Fp.bid);
            EpiWin E{(bf16*)(ws + WS_P1), (float*)(ws + WS_HY), (float*)(ws + WS_GT)};
            pg8::gemm_phase<EpiWin, pg8::StaticOrder, PG8_ALIGN, PG8_SP2>(Fp.lds + RING_OFF, g, S, E, Fp.tid);
        } SEAM(pb + 0);
        KIND(4) if (IN(pb + 1)) {
            REP(4) { const Fr Fp = fr_fresh(F); ph_attn_prep(Fp, args, l); }
            REP(14) { const Fr Fp = fr_fresh(F); ph_mlstm_local(Fp, args, l); }
            REP(15) { const Fr Fp = fr_fresh(F); ph_hyena(Fp, args, l); }
        } SEAM(pb + 1);
        KIND(5) if (IN(pb + 2)) { REP(16) { const Fr Fp = fr_fresh(F); ph_mlstm_carry(Fp, args); } if (!lastl) REP(18) { const Fr Fp = fr_fresh(F); ph_mlstm_out(Fp, args, l, 512, 528, 64); } REP(19) { const Fr Fp = fr_fresh(F); ph_hy_transpose(Fp, args); } REP(5) { const Fr Fp = fr_fresh(F); const int grp = (Fp.bid >> 3) % 3;
#pragma unroll 1
                for (int i = 0; i < 3; ++i) { if (i == grp && rep_ == 0) { const Fr Fq = fr_fresh(F); ph_convert_experts(Fq, args, l); } const Fr Fa = fr_fresh(F); ph_attention(Fa, args, l, lds, i, i + 1); } } } SEAM(pb + 2);
        KIND(6) if (IN(pb + 3)) REP(6) { const Fr Fp = fr_fresh(F); ph_mlstm_out(Fp, args, l, 0, 512, 0); } SEAM(pb + 3);
        KIND(7) if (IN(pb + 4)) REP(7) {
            const Fr Fp = fr_fresh(F);
            pg8::Gemm g{(const pg8::bf16_t*)(ws + WS_Y), (const pg8::bf16_t*)(ws + WS_WOUTT) + (size_t)l * DM * DM, MT, DM, DM};
            WoutOrder S; S.ntile = lastl ? 64 : 66; S.skipctx = lastl ? 1 : 0; S.G = Fp.G; S.c = Fp.bid;
            EpiBf16g E{(bf16*)(ws + WS_MIX), DM, 4};
            pg8::gemm_phase<EpiBf16g, WoutOrder, PG8_ALIGN, PG8_SP2>(Fp.lds + RING_OFF, g, S, E, Fp.tid);
        } SEAM(pb + 4);
        KIND(8) if (IN(pb + 5)) REP(8) { const Fr Fp = fr_fresh(F); ph_ln_b(Fp, args, l); } SEAM(pb + 5);
        KIND(9) if (IN(pb + 6)) REP(9) { const Fr Fp = fr_fresh(F); ph_select(Fp, args, l); } SEAM(pb + 6);
        KIND(11) if (IN(pb + 7)) REP(11) {
            const Fr Fp = fr_fresh(F);
            LAS unsigned short* idxl = (LAS unsigned short*)(Fp.lds + IDXL_OFF);
            { const int* IDX = (const int*)(ws + WS_IDX); const int e0 = Fp.bid & 7;
              __syncthreads();
              for (int i = Fp.tid; i < 2 * ROWS_E; i += NTHR) { const int e = e0 + 8 * (i / ROWS_E); const unsigned v = (unsigned)IDX[e * ROWS_E + (i % ROWS_E)]; idxl[i] = (unsigned short)(v < (unsigned)MT ? v : 0u); }
              __syncthreads(); }
            pg8::Gemm8 g{(const unsigned char*)(ws + WS_HN), (const unsigned char*)(ws + WS_W1T) + (size_t)l * NE * (2 * FF) * DM, NE * ROWS_E, NE * 2 * FF, DM, W1_SCALE, idxl};
            GroupOrder S; S.nMe = lastl ? 8 : 9; S.nN = NT1; S.G = Fp.G; S.c = Fp.bid;
            EpiSwiglu E{(unsigned char*)(ws + WS_ACT)};
            pg8::gemm_phase8<EpiSwiglu, GroupOrder, PG8_ALIGN, false, true>(Fp.lds + RING_OFF, g, S, E, Fp.tid);
        } SEAM(pb + 7);
        KIND(12) if (IN(pb + 8)) REP(12) {
            const Fr Fp = fr_fresh(F);
            pg8::Gemm8 g{(const unsigned char*)(ws + WS_ACT), (const unsigned char*)(ws + WS_W2T) + (size_t)l * NE * DM * FF, NE * ROWS_E, NE * DM, FF, W2_SCALE, nullptr};
            GroupOrder S; S.nMe = lastl ? 8 : 9; S.nN = 4; S.G = Fp.G; S.c = Fp.bid;
            EpiBf16g E{(bf16*)(ws + WS_YE), DM, 4};
            pg8::gemm_phase8<EpiBf16g, GroupOrder, PG8_ALIGN, false>(Fp.lds + RING_OFF, g, S, E, Fp.tid);
        } SEAM(pb + 8);
        KIND(13) if (IN(pb + 9)) REP(13) { const Fr Fp = fr_fresh(F); ph_ln_c(Fp, args, l); } if (!lastl) SEAM(pb + 9);
    }
#undef IN
#undef SEAM
#undef KIND
#undef REP
}

constexpr int kind_of_phase(int k) { return k < NPH_PRO ? k : (3 + (k - NPH_PRO) % NPH_LAYER < 10 ? 3 + (k - NPH_PRO) % NPH_LAYER : 4 + (k - NPH_PRO) % NPH_LAYER); }
typedef void (*kern_t)(Args);
template <int Q> static kern_t kern_for_kind(int q) { if (q == Q) return mk_fwd<(1u << Q)>; if constexpr (Q + 1 < 14) return kern_for_kind<Q + 1>(q); else return nullptr; }
extern "C" void kernel_launch(void* const* d_in, const int* in_sizes, int n_in, void* d_out, int out_size, void* d_ws, size_t ws_size, hipStream_t stream) {
    static int grid = 0;
    if (grid == 0) {
        if (n_in != 32 || in_sizes[0] != NB * SEQ * DM || out_size != NB * SEQ * DM || ws_size < WS_END) { fprintf(stderr, "kernel_launch: unexpected shapes / workspace (n_in %d, ws %zu < %zu)\n", n_in, ws_size, (size_t)WS_END); grid = -1; return; }
        int dev = 0, cus = 0;
        if (hipGetDevice(&dev) != hipSuccess || hipDeviceGetAttribute(&cus, hipDeviceAttributeMultiprocessorCount, dev) != hipSuccess) { grid = -1; return; }
#if MK_SINGLE
        if (hipFuncSetAttribute((const void*)mk_fwd<0x3fffu>, hipFuncAttributeMaxDynamicSharedMemorySize, LDS_BYTES) != hipSuccess) { fprintf(stderr, "kernel_launch: hipFuncSetAttribute failed\n"); grid = -1; return; }
#else
        for (int q = 0; q < 14; ++q) if (hipFuncSetAttribute((const void*)kern_for_kind<0>(q), hipFuncAttributeMaxDynamicSharedMemorySize, LDS_BYTES) != hipSuccess) { fprintf(stderr, "kernel_launch: hipFuncSetAttribute failed\n"); grid = -1; return; }
#endif
        (void)hipGetLastError();
        grid = cus & ~7;
    }
    if (grid < 0) return;
    if (hipMemsetAsync((char*)d_ws + WS_CTL, 0, CTL_ZERO_BYTES, stream) != hipSuccess) return;
    Args a{};
    for (int i = 0; i < 32; ++i) a.in[i] = (const float*)d_in[i];
    a.out = (float*)d_out; a.ws = (unsigned char*)d_ws;
#if MK_SINGLE
    a.ph_lo = 0; a.ph_hi = NPH;
    hipLaunchKernelGGL(mk_fwd<0x3fffu>, dim3(grid), dim3(NTHR), LDS_BYTES, stream, a);
#else
    for (int k = 0; k < NPH; ++k) { a.ph_lo = k; a.ph_hi = k + 1; kern_t f = kern_for_kind<0>(kind_of_phase(k)); hipLaunchKernelGGL(f, dim3(grid), dim3(NTHR), LDS_BYTES, stream, a); }
#endif
}
```

```cpp
#include <hip/hip_runtime.h>
#include <hip/hip_bf16.h>
#include <cstdio>
#include <cstdint>
#include <cmath>

#ifndef MK_SINGLE
#define MK_SINGLE 1
#endif

namespace pg8 {
#define PG8_LAS __attribute__((address_space(3)))
typedef unsigned short bf16_t;
typedef short bf16x8 __attribute__((ext_vector_type(8)));
typedef float f32x4 __attribute__((ext_vector_type(4)));
typedef unsigned u32x4 __attribute__((ext_vector_type(4)));
constexpr int BM = 256, BK = 64, HALF = 128, HTB = HALF * BK * 2  , STAGE_BYTES = 8 * HTB, NXCD = 8, WGM = 8;

__host__ __device__ __forceinline__ int lds_byte(int r, int c) { const int st = (r >> 4) * 2 + (c >> 5), rr = r & 15, cc = c & 31, ob = rr * 64 + cc * 2; return st * 1024 + (ob ^ (((ob >> 9) & 1) << 5)); }
__host__ __device__ __forceinline__ void stage_rc(int b, int& R, int& C) { const int st = b / 1024, sb = b % 1024, swz = sb ^ (((sb >> 9) & 1) << 5); R = (st >> 1) * 16 + swz / 64; C = (st & 1) * 32 + (swz % 64) / 2; }
__host__ __device__ __forceinline__ int perm32(int rho) { const int n = rho >> 4, i = rho & 15; return 8 * (i >> 2) + 4 * n + (i & 3); }

struct Unit { int pm, pn; };
struct Gemm { const bf16_t* A; const bf16_t* Bt; int M, N, K; };

struct StaticOrder {
    int nM, nN, nwg, G, c;
    __host__ __device__ void init(int M, int N, int G_, int c_) { nM = M / BM; nN = N / BM; nwg = nM * nN; G = G_; c = c_; }
    __host__ __device__ bool next(int i, Unit& u) const {
        const long L = (long)i * G + c; if (L >= nwg) return false;
        int wgid = (int)L; { const int q = nwg / NXCD, r = nwg % NXCD, xcd = wgid % NXCD, off = wgid / NXCD; wgid = (xcd < r ? xcd * (q + 1) : r * (q + 1) + (xcd - r) * q) + off; }
        const int nig = WGM * nN, gid = wgid / nig, fm = gid * WGM, gsz = (nM - fm) < WGM ? (nM - fm) : WGM;
        u.pm = fm + ((wgid % nig) % gsz); u.pn = (wgid % nig) / gsz; return true;
    }
    __device__ __forceinline__ void a_ready(const Unit&) const {}
    __device__ __forceinline__ void done(const Unit&) const {}
};

__device__ __forceinline__ unsigned cvt_pk_bf16(float lo, float hi) { unsigned r; asm volatile("v_cvt_pk_bf16_f32 %0, %1, %2" : "=v"(r) : "v"(lo), "v"(hi)); return r; }
typedef float f32x2 __attribute__((ext_vector_type(2)));
__device__ __forceinline__ f32x2 gelu_pk(f32x2 v) {
    const f32x2 av = __builtin_elementwise_abs(v), d = av * 0.2316418882f + 1.0f;
    f32x2 t; t.x = __builtin_amdgcn_rcpf(d.x); t.y = __builtin_amdgcn_rcpf(d.y);
    f32x2 q = t * 0.5307027145f + (-0.7265760135f); q = q * t + 0.7107068705f; q = q * t + (-0.142248368f); q = q * t + 0.127414796f; q = q * t;
    const f32x2 s = (v * v) * (-0.72134752044f);
    f32x2 e; e.x = __builtin_amdgcn_exp2f(s.x); e.y = __builtin_amdgcn_exp2f(s.y);
    const f32x2 m = v * (q * e), r = v - m;
    f32x2 o; o.x = v.x < 0.f ? m.x : r.x; o.y = v.y < 0.f ? m.y : r.y; return o;
}

template <int ACT  > struct EpiBf16 {
    static constexpr bool PERM = true, AFTER_DRAIN = false; static_assert(ACT == 0 || ACT == 1, "EpiBf16: ACT is 0 (none) or 1 (gelu_pk)");
    bf16_t* O; int ldc; const float* bias; int split_cols; size_t split_stride; float scale0;
    __device__ __forceinline__ void operator()(const f32x4 (&acc)[2][2][4][2], const Unit& u, int wr, int wc, int fr, int fq) const {
        const int row0 = u.pm * BM + wr * 64 + fr; int colt = u.pn * BM; bf16_t* base = O;
        float sc = 1.f; if (split_cols) { const int t = colt / split_cols; base += (size_t)t * split_stride; colt -= t * split_cols; if (t == 0) sc = scale0; }
        const int col0 = colt + wc * 32 + 8 * fq, bcol0 = u.pn * BM + wc * 32 + 8 * fq;
        f32x4 bv[2][2];
#pragma unroll
        for (int bj = 0; bj < 2; ++bj)
#pragma unroll
            for (int n = 0; n < 2; ++n) bv[bj][n] = bias ? *(const f32x4*)(bias + bcol0 + bj * HALF + 4 * n) : (f32x4){0.f, 0.f, 0.f, 0.f};
#pragma unroll
        for (int ai = 0; ai < 2; ++ai)
#pragma unroll
            for (int m = 0; m < 4; ++m) { bf16_t* rowp = base + (size_t)(row0 + ai * HALF + m * 16) * ldc + col0;
#pragma unroll
                for (int bj = 0; bj < 2; ++bj) { f32x4 v0 = acc[ai][bj][m][0] + bv[bj][0], v1 = acc[ai][bj][m][1] + bv[bj][1];
                    if (ACT == 1) { f32x2 a = gelu_pk((f32x2){v0[0], v0[1]}), b = gelu_pk((f32x2){v0[2], v0[3]}), c = gelu_pk((f32x2){v1[0], v1[1]}), d = gelu_pk((f32x2){v1[2], v1[3]});
                        v0 = (f32x4){a.x, a.y, b.x, b.y}; v1 = (f32x4){c.x, c.y, d.x, d.y}; }
                    v0 = v0 * sc; v1 = v1 * sc; u32x4 w; w.x = cvt_pk_bf16(v0[0], v0[1]); w.y = cvt_pk_bf16(v0[2], v0[3]); w.z = cvt_pk_bf16(v1[0], v1[1]); w.w = cvt_pk_bf16(v1[2], v1[3]);
                    *(u32x4*)(rowp + bj * HALF) = w; } }
    }
};


template <class Epi, class Sched, bool ALIGN_EPI = false, bool SP2 = false>
__device__ __forceinline__ void gemm_phase(PG8_LAS unsigned char* lds, const Gemm g, const Sched& S, const Epi& E, const int tid) {
    const int wid = __builtin_amdgcn_readfirstlane(tid >> 6), lane = tid & 63, wr = wid >> 2, wc = wid & 3, fr = lane & 15, fq = lane >> 4;
    const int K = g.K, nt = K / BK;
    unsigned voffA[2], voffB[2];
#pragma unroll
    for (int i = 0; i < 2; ++i) { int R, C; stage_rc(tid * 16 + i * 8192, R, C); const int Rb = Epi::PERM ? ((R & ~31) + perm32(R & 31)) : R;
        voffA[i] = (unsigned)(R * K + C) * 2u; voffB[i] = (unsigned)(Rb * K + C) * 2u; }
    const size_t kstep = (size_t)(BK * 2);
    const size_t hstep = (size_t)HALF * K * 2;
    const size_t tstep = 2 * hstep;
    const unsigned ldsw = (unsigned)wid * 1024u;
    const int aoff = lds_byte(wr * 64 + fr, fq * 8), boff = lds_byte(wc * 32 + fr, fq * 8);
#define PG8_SA(b, h) (((b) * 2 + (h)) * HTB)
#define PG8_SB(b, h) ((4 + (b) * 2 + (h)) * HTB)
#define PG8_STAGE(bufoff, gbase, voff) do { _Pragma("unroll") for (int _i = 0; _i < 2; ++_i) \
        __builtin_amdgcn_global_load_lds((const unsigned*)((const char*)(gbase) + (voff)[_i]), (PG8_LAS unsigned*)(lds + (bufoff) + ldsw + _i * 8192), 16, 0, 0); } while (0)
#define PG8_LDA(dst, b, h) do { _Pragma("unroll") for (int m = 0; m < 4; ++m) _Pragma("unroll") for (int k = 0; k < 2; ++k) dst[m][k] = *(const PG8_LAS bf16x8*)(lds + PG8_SA(b, h) + aoff + m * 2048 + k * 1024); } while (0)
#define PG8_LDB(dst, b, h) do { _Pragma("unroll") for (int n = 0; n < 2; ++n) _Pragma("unroll") for (int k = 0; k < 2; ++k) dst[n][k] = *(const PG8_LAS bf16x8*)(lds + PG8_SB(b, h) + boff + n * 2048 + k * 1024); } while (0)
#define PG8_MMA(ai, bj, At, Bt) do { __builtin_amdgcn_s_setprio(1); _Pragma("unroll") for (int m = 0; m < 4; ++m) _Pragma("unroll") for (int n = 0; n < 2; ++n) _Pragma("unroll") for (int k = 0; k < 2; ++k) \
        acc[ai][bj][m][n] = __builtin_amdgcn_mfma_f32_16x16x32_bf16(Bt[n][k], At[m][k], acc[ai][bj][m][n], 0, 0, 0); __builtin_amdgcn_s_setprio(0); } while (0)
#define PG8_WAIT_V(n) asm volatile("s_waitcnt vmcnt(" #n ")" ::: "memory")
#define PG8_WAIT_L(n) asm volatile("s_waitcnt lgkmcnt(" #n ")" ::: "memory")
#define PG8_BAR __builtin_amdgcn_s_barrier()
#define PG8_SCHED __builtin_amdgcn_sched_barrier(0)
    Unit cur, nxt; int ui = 0;
    if (!S.next(0, cur)) return;
    f32x4 acc[2][2][4][2];
#pragma unroll
    for (int a = 0; a < 2; ++a)
#pragma unroll
        for (int b = 0; b < 2; ++b)
#pragma unroll
            for (int m = 0; m < 4; ++m)
#pragma unroll
                for (int n = 0; n < 2; ++n) acc[a][b][m][n] = (f32x4){0.f, 0.f, 0.f, 0.f};
    bf16x8 At[4][2], B0[2][2], B1[2][2];
    const char* cA = (const char*)g.A + (size_t)cur.pm * tstep; const char* cB = (const char*)g.Bt + (size_t)cur.pn * tstep;
    S.a_ready(cur);
    if constexpr (SP2) {
        PG8_STAGE(PG8_SB(0, 0), cB, voffB); PG8_STAGE(PG8_SB(0, 1), cB + hstep, voffB); PG8_STAGE(PG8_SA(0, 0), cA, voffA); PG8_STAGE(PG8_SA(0, 1), cA + hstep, voffA);
        if (wr == 1) PG8_BAR;
        PG8_WAIT_V(2); PG8_BAR;
        PG8_STAGE(PG8_SB(1, 0), cB + kstep, voffB); PG8_STAGE(PG8_SA(1, 0), cA + kstep, voffA); PG8_STAGE(PG8_SB(1, 1), cB + hstep + kstep, voffB);
        PG8_WAIT_V(6); PG8_BAR;
    } else {
        PG8_STAGE(PG8_SB(0, 0), cB, voffB); PG8_STAGE(PG8_SA(0, 0), cA, voffA); PG8_STAGE(PG8_SB(0, 1), cB + hstep, voffB); PG8_STAGE(PG8_SA(0, 1), cA + hstep, voffA);
        if (wr == 1) PG8_BAR;
        PG8_WAIT_V(4); PG8_BAR;
        PG8_STAGE(PG8_SB(1, 0), cB + kstep, voffB); PG8_STAGE(PG8_SA(1, 0), cA + kstep, voffA); PG8_STAGE(PG8_SB(1, 1), cB + hstep + kstep, voffB);
        PG8_WAIT_V(6); PG8_BAR;
    }
    for (;;) {
        const bool has_next = S.next(ui + 1, nxt);
        const char* nA = has_next ? (const char*)g.A + (size_t)nxt.pm * tstep : cA; const char* nB = has_next ? (const char*)g.Bt + (size_t)nxt.pn * tstep : cB;
        for (int t = 0; t < nt; t += 2) {
            const bool last = (t == nt - 2);
            const char* a1 = cA + (size_t)(t + 1) * kstep;
            const char* a2 = last ? nA : cA + (size_t)(t + 2) * kstep; const char* b2 = last ? nB : cB + (size_t)(t + 2) * kstep;
            const char* a3 = a2 + kstep; const char* b3 = b2 + kstep;
            if (last && has_next) S.a_ready(nxt);
            if constexpr (SP2) {
            PG8_LDB(B0, 0, 0); PG8_LDB(B1, 0, 1); PG8_SCHED; PG8_LDA(At, 0, 0); PG8_STAGE(PG8_SA(1, 1), a1 + hstep, voffA);
            PG8_WAIT_V(8); PG8_WAIT_L(0); PG8_BAR; PG8_MMA(0, 0, At, B0); PG8_MMA(0, 1, At, B1); PG8_BAR; PG8_SCHED;
            PG8_LDA(At, 0, 1); PG8_STAGE(PG8_SB(0, 0), b2, voffB); PG8_STAGE(PG8_SB(0, 1), b2 + hstep, voffB); PG8_STAGE(PG8_SA(0, 0), a2, voffA);
            PG8_WAIT_V(8); PG8_WAIT_L(0); PG8_BAR; PG8_MMA(1, 0, At, B0); PG8_MMA(1, 1, At, B1); PG8_BAR; PG8_SCHED;
            PG8_LDB(B0, 1, 0); PG8_LDB(B1, 1, 1); PG8_SCHED; PG8_LDA(At, 1, 0); PG8_STAGE(PG8_SA(0, 1), a2 + hstep, voffA);
            PG8_WAIT_V(8); PG8_WAIT_L(0); PG8_BAR; PG8_MMA(0, 0, At, B0); PG8_MMA(0, 1, At, B1); PG8_BAR; PG8_SCHED;
            PG8_LDA(At, 1, 1); PG8_STAGE(PG8_SB(1, 0), b3, voffB); PG8_STAGE(PG8_SB(1, 1), b3 + hstep, voffB); PG8_STAGE(PG8_SA(1, 0), a3, voffA);
            PG8_WAIT_V(8); PG8_WAIT_L(0); PG8_BAR; PG8_MMA(1, 0, At, B0); PG8_MMA(1, 1, At, B1); PG8_BAR; PG8_SCHED;
            } else {
            PG8_LDB(B0, 0, 0); PG8_SCHED; PG8_LDA(At, 0, 0); PG8_STAGE(PG8_SA(1, 1), a1 + hstep, voffA);
            PG8_WAIT_L(8); PG8_BAR; PG8_WAIT_L(0); PG8_MMA(0, 0, At, B0); PG8_BAR; PG8_SCHED;
            PG8_LDB(B1, 0, 1); PG8_STAGE(PG8_SB(0, 0), b2, voffB);
            PG8_BAR; PG8_WAIT_L(0); PG8_MMA(0, 1, At, B1); PG8_BAR;
            PG8_LDA(At, 0, 1); PG8_STAGE(PG8_SA(0, 0), a2, voffA);
            PG8_BAR; PG8_WAIT_L(0); PG8_MMA(1, 0, At, B0); PG8_BAR; PG8_SCHED;
            PG8_STAGE(PG8_SB(0, 1), b2 + hstep, voffB);
            PG8_WAIT_V(6); PG8_BAR; PG8_MMA(1, 1, At, B1); PG8_BAR;
            PG8_LDB(B0, 1, 0); PG8_SCHED; PG8_LDA(At, 1, 0); PG8_STAGE(PG8_SA(0, 1), a2 + hstep, voffA);
            PG8_WAIT_L(8); PG8_BAR; PG8_WAIT_L(0); PG8_MMA(0, 0, At, B0); PG8_BAR; PG8_SCHED;
            PG8_LDB(B1, 1, 1); PG8_STAGE(PG8_SB(1, 0), b3, voffB);
            PG8_BAR; PG8_WAIT_L(0); PG8_MMA(0, 1, At, B1); PG8_BAR;
            PG8_LDA(At, 1, 1); PG8_STAGE(PG8_SA(1, 0), a3, voffA);
            PG8_BAR; PG8_WAIT_L(0); PG8_MMA(1, 0, At, B0); PG8_BAR; PG8_SCHED;
            PG8_STAGE(PG8_SB(1, 1), b3 + hstep, voffB);
            PG8_WAIT_V(6); PG8_BAR; PG8_MMA(1, 1, At, B1); PG8_BAR;
            }
        }
        if constexpr (ALIGN_EPI) { if (wr == 0) PG8_BAR; }
        if constexpr (!Epi::AFTER_DRAIN) { E(acc, cur, wr, wc, fr, fq); S.done(cur); }
        if (!has_next) break;
#pragma unroll
        for (int a = 0; a < 2; ++a)
#pragma unroll
            for (int b = 0; b < 2; ++b)
#pragma unroll
                for (int m = 0; m < 4; ++m)
#pragma unroll
                    for (int n = 0; n < 2; ++n) acc[a][b][m][n] = (f32x4){0.f, 0.f, 0.f, 0.f};
        cur = nxt; cA = nA; cB = nB; ++ui;
        if constexpr (ALIGN_EPI) { if (wr == 1) PG8_BAR; }
    }
    PG8_WAIT_V(0);
    if constexpr (!ALIGN_EPI) { if (wr == 0) PG8_BAR; }
    PG8_BAR;
    if constexpr (Epi::AFTER_DRAIN) { E.fused(acc, cur, wr, wc, fr, fq, lds, wid, lane); S.done(cur); }
#undef PG8_SA
#undef PG8_SB
#undef PG8_STAGE
#undef PG8_LDA
#undef PG8_LDB
#undef PG8_MMA
#undef PG8_WAIT_V
#undef PG8_WAIT_L
#undef PG8_BAR
#undef PG8_SCHED
}
}

#ifndef PG8_SP2
#define PG8_SP2 true
#endif
#ifndef PG8_ALIGN
#define PG8_ALIGN true
#endif

namespace pg8 {
__host__ __device__ __forceinline__ int swz8(int q) { return (4 - q) & 3; }
__host__ __device__ __forceinline__ void stage_rc8(int b, int& R, int& Cb) { const int blk = b >> 10, d = (b & 1023) >> 4; R = (blk >> 1) * 16 + (d >> 2); Cb = 64 * (blk & 1) + 16 * ((d & 3) ^ swz8(d >> 4)); }
typedef int v8i32 __attribute__((ext_vector_type(8)));
typedef int v4i32 __attribute__((ext_vector_type(4)));
struct Gemm8 { const unsigned char* A; const unsigned char* Bt; int M, N, K; int scale_b; const PG8_LAS unsigned short* idx; };
template <class Epi, class Sched, bool ALIGN_EPI = false, bool SP2 = false, bool GATHER = false>
__device__ __forceinline__ void gemm_phase8(PG8_LAS unsigned char* lds, const Gemm8 g, const Sched& S, const Epi& E, const int tid) {
    const int wid = __builtin_amdgcn_readfirstlane(tid >> 6), lane = tid & 63, wr = wid >> 2, wc = wid & 3, fr = lane & 15, fq = lane >> 4;
    const int K = g.K, nt = K / 128;
    unsigned voffA[2], voffB[2]; int RA[2], CA[2];
#pragma unroll
    for (int i = 0; i < 2; ++i) { int R, C; stage_rc8(tid * 16 + i * 8192, R, C); const int Rb = Epi::PERM ? ((R & ~31) + perm32(R & 31)) : R;
        voffA[i] = (unsigned)(R * K + C); voffB[i] = (unsigned)(Rb * K + C); RA[i] = R; CA[i] = C; }
    const size_t kstep = (size_t)(BK * 2);
    const size_t hstep = (size_t)HALF * K;
    const size_t tstep = 2 * hstep;
#define PG8_AOFF(dst, u) do { _Pragma("unroll") for (int h_ = 0; h_ < 2; ++h_) _Pragma("unroll") for (int i_ = 0; i_ < 2; ++i_) { \
        if constexpr (GATHER) { const int e_ = (u).pm / 9, mt_ = (u).pm - e_ * 9; const unsigned r_ = g.idx[(e_ >> 3) * 2304 + mt_ * 256 + h_ * 128 + RA[i_]]; dst[h_][i_] = r_ * (unsigned)K + (unsigned)CA[i_]; } \
        else dst[h_][i_] = voffA[i_] + (unsigned)(h_ * hstep); } } while (0)
    const unsigned ldsw = (unsigned)wid * 1024u;
    const int roff = (4 * fr + (fq ^ swz8(fr >> 2))) * 16;
    const int aoff0 = (wr * 8) * 1024 + roff, aoff1 = aoff0 + 1024, boff0 = (wc * 4) * 1024 + roff, boff1 = boff0 + 1024;
#define PG8_SA(b, h) (((b) * 2 + (h)) * HTB)
#define PG8_SB(b, h) ((4 + (b) * 2 + (h)) * HTB)
#define PG8_STAGE(bufoff, gbase, voff) do { _Pragma("unroll") for (int _i = 0; _i < 2; ++_i) \
        __builtin_amdgcn_global_load_lds((const unsigned*)((const char*)(gbase) + (voff)[_i]), (PG8_LAS unsigned*)(lds + (bufoff) + ldsw + _i * 8192), 16, 0, 0); } while (0)
#define PG8_LDA(dst, b, h) do { _Pragma("unroll") for (int m = 0; m < 4; ++m) { const v4i32 lo_ = __builtin_bit_cast(v4i32, *(const PG8_LAS bf16x8*)(lds + PG8_SA(b, h) + aoff0 + m * 2048)), hi_ = __builtin_bit_cast(v4i32, *(const PG8_LAS bf16x8*)(lds + PG8_SA(b, h) + aoff1 + m * 2048)); dst[m] = __builtin_shufflevector(lo_, hi_, 0, 1, 2, 3, 4, 5, 6, 7); } } while (0)
#define PG8_LDB(dst, b, h) do { _Pragma("unroll") for (int n = 0; n < 2; ++n) { const v4i32 lo_ = __builtin_bit_cast(v4i32, *(const PG8_LAS bf16x8*)(lds + PG8_SB(b, h) + boff0 + n * 2048)), hi_ = __builtin_bit_cast(v4i32, *(const PG8_LAS bf16x8*)(lds + PG8_SB(b, h) + boff1 + n * 2048)); dst[n] = __builtin_shufflevector(lo_, hi_, 0, 1, 2, 3, 4, 5, 6, 7); } } while (0)
#define PG8_MMA(ai, bj, At, Bt) do { __builtin_amdgcn_s_setprio(1); _Pragma("unroll") for (int m = 0; m < 4; ++m) _Pragma("unroll") for (int n = 0; n < 2; ++n) \
        asm volatile("v_mfma_scale_f32_16x16x128_f8f6f4 %0, %1, %2, %0, %3, %4 op_sel_hi:[0,0,0]" : "+v"(acc[ai][bj][m][n]) : "v"(Bt[n]), "v"(At[m]), "v"(sc_b), "v"(sc_a)); __builtin_amdgcn_s_setprio(0); } while (0)
#define PG8_ACCFENCE() do { _Pragma("unroll") for (int a_ = 0; a_ < 2; ++a_) _Pragma("unroll") for (int b_ = 0; b_ < 2; ++b_) \
        asm volatile("s_nop 15\n\ts_nop 15" : "+v"(acc[a_][b_][0][0]), "+v"(acc[a_][b_][0][1]), "+v"(acc[a_][b_][1][0]), "+v"(acc[a_][b_][1][1]), "+v"(acc[a_][b_][2][0]), "+v"(acc[a_][b_][2][1]), "+v"(acc[a_][b_][3][0]), "+v"(acc[a_][b_][3][1])); } while (0)
#define PG8_WAIT_V(n) asm volatile("s_waitcnt vmcnt(" #n ")" ::: "memory")
#define PG8_WAIT_L(n) asm volatile("s_waitcnt lgkmcnt(" #n ")" ::: "memory")
#define PG8_BAR __builtin_amdgcn_s_barrier()
#define PG8_SCHED __builtin_amdgcn_sched_barrier(0)
    const int sc_b = g.scale_b, sc_a = 0x7f7f7f7f;
    Unit cur, nxt; int ui = 0;
    if (!S.next(0, cur)) return;
    f32x4 acc[2][2][4][2];
#pragma unroll
    for (int a = 0; a < 2; ++a)
#pragma unroll
        for (int b = 0; b < 2; ++b)
#pragma unroll
            for (int m = 0; m < 4; ++m)
#pragma unroll
                for (int n = 0; n < 2; ++n) acc[a][b][m][n] = (f32x4){0.f, 0.f, 0.f, 0.f};
    v8i32 At[4], B0[2], B1[2];
    const char* cA = (const char*)g.A + (GATHER ? (size_t)0 : (size_t)cur.pm * tstep); const char* cB = (const char*)g.Bt + (size_t)cur.pn * tstep;
    unsigned offA[2][2], noffA[2][2]; PG8_AOFF(offA, cur);
    S.a_ready(cur);
    if constexpr (SP2) {
        PG8_STAGE(PG8_SB(0, 0), cB, voffB); PG8_STAGE(PG8_SB(0, 1), cB + hstep, voffB); PG8_STAGE(PG8_SA(0, 0), cA, offA[0]); PG8_STAGE(PG8_SA(0, 1), cA, offA[1]);
        if (wr == 1) PG8_BAR;
        PG8_WAIT_V(2); PG8_BAR;
        PG8_STAGE(PG8_SB(1, 0), cB + kstep, voffB); PG8_STAGE(PG8_SA(1, 0), cA + kstep, offA[0]); PG8_STAGE(PG8_SB(1, 1), cB + hstep + kstep, voffB);
        PG8_WAIT_V(6); PG8_BAR;
    } else {
        PG8_STAGE(PG8_SB(0, 0), cB, voffB); PG8_STAGE(PG8_SA(0, 0), cA, offA[0]); PG8_STAGE(PG8_SB(0, 1), cB + hstep, voffB); PG8_STAGE(PG8_SA(0, 1), cA, offA[1]);
        if (wr == 1) PG8_BAR;
        PG8_WAIT_V(4); PG8_BAR;
        PG8_STAGE(PG8_SB(1, 0), cB + kstep, voffB); PG8_STAGE(PG8_SA(1, 0), cA + kstep, offA[0]); PG8_STAGE(PG8_SB(1, 1), cB + hstep + kstep, voffB);
        PG8_WAIT_V(6); PG8_BAR;
    }
    for (;;) {
        const bool has_next = S.next(ui + 1, nxt);
        const char* nA = (has_next && !GATHER) ? (const char*)g.A + (size_t)nxt.pm * tstep : cA; const char* nB = has_next ? (const char*)g.Bt + (size_t)nxt.pn * tstep : cB;
        if (has_next) { PG8_AOFF(noffA, nxt); } else { _Pragma("unroll") for (int h_ = 0; h_ < 2; ++h_) _Pragma("unroll") for (int i_ = 0; i_ < 2; ++i_) noffA[h_][i_] = offA[h_][i_]; }
        for (int t = 0; t < nt; t += 2) {
            const bool last = (t == nt - 2);
            const char* a1 = cA + (size_t)(t + 1) * kstep;
            const char* a2 = last ? nA : cA + (size_t)(t + 2) * kstep; const char* b2 = last ? nB : cB + (size_t)(t + 2) * kstep;
            const char* a3 = a2 + kstep; const char* b3 = b2 + kstep;
            unsigned o2[2][2]; _Pragma("unroll") for (int h_ = 0; h_ < 2; ++h_) _Pragma("unroll") for (int i_ = 0; i_ < 2; ++i_) o2[h_][i_] = last ? noffA[h_][i_] : offA[h_][i_];
            if (last && has_next) S.a_ready(nxt);
            if constexpr (SP2) {
            PG8_LDB(B0, 0, 0); PG8_LDB(B1, 0, 1); PG8_SCHED; PG8_LDA(At, 0, 0); PG8_STAGE(PG8_SA(1, 1), a1, offA[1]);
            PG8_WAIT_V(8); PG8_WAIT_L(0); PG8_BAR; PG8_MMA(0, 0, At, B0); PG8_MMA(0, 1, At, B1); PG8_BAR; PG8_SCHED;
            PG8_LDA(At, 0, 1); PG8_STAGE(PG8_SB(0, 0), b2, voffB); PG8_STAGE(PG8_SB(0, 1), b2 + hstep, voffB); PG8_STAGE(PG8_SA(0, 0), a2, o2[0]);
            PG8_WAIT_V(8); PG8_WAIT_L(0); PG8_BAR; PG8_MMA(1, 0, At, B0); PG8_MMA(1, 1, At, B1); PG8_BAR; PG8_SCHED;
            PG8_LDB(B0, 1, 0); PG8_LDB(B1, 1, 1); PG8_SCHED; PG8_LDA(At, 1, 0); PG8_STAGE(PG8_SA(0, 1), a2, o2[1]);
            PG8_WAIT_V(8); PG8_WAIT_L(0); PG8_BAR; PG8_MMA(0, 0, At, B0); PG8_MMA(0, 1, At, B1); PG8_BAR; PG8_SCHED;
            PG8_LDA(At, 1, 1); PG8_STAGE(PG8_SB(1, 0), b3, voffB); PG8_STAGE(PG8_SB(1, 1), b3 + hstep, voffB); PG8_STAGE(PG8_SA(1, 0), a3, o2[0]);
            PG8_WAIT_V(8); PG8_WAIT_L(0); PG8_BAR; PG8_MMA(1, 0, At, B0); PG8_MMA(1, 1, At, B1); PG8_BAR; PG8_SCHED;
            } else {
            PG8_LDB(B0, 0, 0); PG8_SCHED; PG8_LDA(At, 0, 0); PG8_STAGE(PG8_SA(1, 1), a1, offA[1]);
            PG8_WAIT_L(8); PG8_BAR; PG8_WAIT_L(0); PG8_MMA(0, 0, At, B0); PG8_BAR; PG8_SCHED;
            PG8_LDB(B1, 0, 1); PG8_STAGE(PG8_SB(0, 0), b2, voffB);
            PG8_BAR; PG8_WAIT_L(0); PG8_MMA(0, 1, At, B1); PG8_BAR;
            PG8_LDA(At, 0, 1); PG8_STAGE(PG8_SA(0, 0), a2, o2[0]);
            PG8_BAR; PG8_WAIT_L(0); PG8_MMA(1, 0, At, B0); PG8_BAR; PG8_SCHED;
            PG8_STAGE(PG8_SB(0, 1), b2 + hstep, voffB);
            PG8_WAIT_V(6); PG8_BAR; PG8_MMA(1, 1, At, B1); PG8_BAR;
            PG8_LDB(B0, 1, 0); PG8_SCHED; PG8_LDA(At, 1, 0); PG8_STAGE(PG8_SA(0, 1), a2, o2[1]);
            PG8_WAIT_L(8); PG8_BAR; PG8_WAIT_L(0); PG8_MMA(0, 0, At, B0); PG8_BAR; PG8_SCHED;
            PG8_LDB(B1, 1, 1); PG8_STAGE(PG8_SB(1, 0), b3, voffB);
            PG8_BAR; PG8_WAIT_L(0); PG8_MMA(0, 1, At, B1); PG8_BAR;
            PG8_LDA(At, 1, 1); PG8_STAGE(PG8_SA(1, 0), a3, o2[0]);
            PG8_BAR; PG8_WAIT_L(0); PG8_MMA(1, 0, At, B0); PG8_BAR; PG8_SCHED;
            PG8_STAGE(PG8_SB(1, 1), b3 + hstep, voffB);
            PG8_WAIT_V(6); PG8_BAR; PG8_MMA(1, 1, At, B1); PG8_BAR;
            }
        }
        if constexpr (ALIGN_EPI) { if (wr == 0) PG8_BAR; }
        PG8_ACCFENCE();
        if constexpr (!Epi::AFTER_DRAIN) { E(acc, cur, wr, wc, fr, fq); S.done(cur); }
        if (!has_next) break;
#pragma unroll
        for (int a = 0; a < 2; ++a)
#pragma unroll
            for (int b = 0; b < 2; ++b)
#pragma unroll
                for (int m = 0; m < 4; ++m)
#pragma unroll
                    for (int n = 0; n < 2; ++n) acc[a][b][m][n] = (f32x4){0.f, 0.f, 0.f, 0.f};
        cur = nxt; cA = nA; cB = nB; ++ui;
        _Pragma("unroll") for (int h_ = 0; h_ < 2; ++h_) _Pragma("unroll") for (int i_ = 0; i_ < 2; ++i_) offA[h_][i_] = noffA[h_][i_];
        if constexpr (ALIGN_EPI) { if (wr == 1) PG8_BAR; }
    }
    PG8_WAIT_V(0);
    if constexpr (!ALIGN_EPI) { if (wr == 0) PG8_BAR; }
    PG8_BAR;
    if constexpr (Epi::AFTER_DRAIN) { E.fused(acc, cur, wr, wc, fr, fq, lds, wid, lane); S.done(cur); }
#undef PG8_SA
#undef PG8_SB
#undef PG8_STAGE
#undef PG8_LDA
#undef PG8_LDB
#undef PG8_MMA
#undef PG8_AOFF
#undef PG8_ACCFENCE
#undef PG8_WAIT_V
#undef PG8_WAIT_L
#undef PG8_BAR
#undef PG8_SCHED
}
}

#include <hip/hip_bf16.h>
#include <cmath>
namespace attn_body {
using bf16=__hip_bfloat16;
using bf16x8=__attribute__((ext_vector_type(8)))short;
using s16x4=__attribute__((ext_vector_type(4)))short;
using f32x16=__attribute__((ext_vector_type(16)))float;
using u32x4=__attribute__((ext_vector_type(4)))unsigned;
constexpr int BATCH=2,NHEAD=16,SEQ=8192,D=64,DM=NHEAD*D;
constexpr int NW=8,QBLK=32,QB=QBLK*NW,KVBLK=64,NQB=SEQ/QB;
constexpr int ATTN_PITCH=DM, ATTN_UNIT_ROWS=QB;
__device__ __forceinline__ int crow(int r,int hi){return (r&3)+8*(r>>2)+4*hi;}
#define SBAR() __builtin_amdgcn_sched_barrier(0)
__device__ __forceinline__ void cmask(f32x16&p0,f32x16&p1,int jb,int qrel,int hi){
  const float NEG=-INFINITY; int kb=64*jb+4*hi;
  #pragma unroll
  for(int r=0;r<16;++r){int kv=kb+(r&3)+8*(r>>2); if(kv>qrel)p0[r]=NEG; if(kv+32>qrel)p1[r]=NEG;}
}

constexpr int NSLOT=3, SLOTB=8192;
constexpr int LDS_K=0, LDS_V=NSLOT*SLOTB, LDS_WS=2*NSLOT*SLOTB, LDS_OST=LDS_WS+NW*64*4, LDS_BYTES=LDS_OST+NW*4096;
constexpr float C2=0.125f*1.4426950408889634f;
__device__ __forceinline__ void glds16(const void*gsrc,unsigned lds_dst){unsigned keep;
  asm volatile("s_mov_b32 %0, m0\n\ts_mov_b32 m0, %2\n\ts_nop 0\n\tglobal_load_lds_dwordx4 %1, off\n\ts_mov_b32 m0, %0":"=&s"(keep):"v"(gsrc),"s"(lds_dst):"memory");}
__device__ __forceinline__ float max3f(float a,float b,float c){float r;asm("v_max3_f32 %0, %1, %2, %3":"=v"(r):"v"(a),"v"(b),"v"(c));return r;}
__device__ __forceinline__ float max2f(float a,float b){float r;asm("v_max_f32_e32 %0, %1, %2":"=v"(r):"v"(a),"v"(b));return r;}
__device__ __forceinline__ float fadd_s(float a,float b){float r;asm("v_add_f32_e32 %0, %1, %2":"=v"(r):"v"(a),"v"(b));return r;}
__device__ __forceinline__ float fsub_s(float a,float b){float r;asm("v_sub_f32_e32 %0, %1, %2":"=v"(r):"v"(a),"v"(b));return r;}
typedef float f32x2_t __attribute__((ext_vector_type(2))); typedef __bf16 bf16x2_t __attribute__((ext_vector_type(2)));
__device__ __forceinline__ unsigned cvtpk_s(float lo,float hi){f32x2_t v={lo,hi};bf16x2_t b=__builtin_convertvector(v,bf16x2_t);return __builtin_bit_cast(unsigned,b);}
#define WAIT_BAR(N) asm volatile("s_waitcnt vmcnt(" #N ") lgkmcnt(0)\n\ts_barrier":::"memory")

__device__ __forceinline__ void qkt(f32x16&p0,f32x16&p1,const char*Kslot,const bf16x8*qr,const f32x16&negm,int r32,int hi){
  const char*kb=Kslot+hi*1024+r32*16;
  #pragma unroll
  for(int d0=0;d0<4;++d0){
    const bf16x8 b0=*reinterpret_cast<const bf16x8*>(kb+d0*2048);
    const bf16x8 b1=*reinterpret_cast<const bf16x8*>(kb+d0*2048+512);
    if(d0==0){p0=__builtin_amdgcn_mfma_f32_32x32x16_bf16(b0,qr[0],negm,0,0,0);p1=__builtin_amdgcn_mfma_f32_32x32x16_bf16(b1,qr[0],negm,0,0,0);}
    else{p0=__builtin_amdgcn_mfma_f32_32x32x16_bf16(b0,qr[d0],p0,0,0,0);p1=__builtin_amdgcn_mfma_f32_32x32x16_bf16(b1,qr[d0],p1,0,0,0);}}
}
typedef __attribute__((address_space(3))) const char* lds_cptr;
typedef short v4i16_t __attribute__((ext_vector_type(4)));
__device__ __forceinline__ void kload8(bf16x8*kf,lds_cptr kp){
  kf[0]=*(const __attribute__((address_space(3))) bf16x8*)(kp);      kf[1]=*(const __attribute__((address_space(3))) bf16x8*)(kp+512);
  kf[2]=*(const __attribute__((address_space(3))) bf16x8*)(kp+2048); kf[3]=*(const __attribute__((address_space(3))) bf16x8*)(kp+2560);
  kf[4]=*(const __attribute__((address_space(3))) bf16x8*)(kp+4096); kf[5]=*(const __attribute__((address_space(3))) bf16x8*)(kp+4608);
  kf[6]=*(const __attribute__((address_space(3))) bf16x8*)(kp+6144); kf[7]=*(const __attribute__((address_space(3))) bf16x8*)(kp+6656);
}
__device__ __forceinline__ void kload2(bf16x8*kf,lds_cptr kp,int j){ kf[2*j]=*(const __attribute__((address_space(3))) bf16x8*)(kp+j*2048); kf[2*j+1]=*(const __attribute__((address_space(3))) bf16x8*)(kp+j*2048+512); }
__device__ __forceinline__ s16x4 vtr(lds_cptr p){ return __builtin_bit_cast(s16x4,__builtin_amdgcn_ds_read_tr16_b64_v4i16((__attribute__((address_space(3))) v4i16_t*)p)); }
__device__ __forceinline__ float rowmax(const f32x16&p0,const f32x16&p1){
  float a=max3f(p0[0],p0[1],p1[0]),b=max3f(p0[2],p0[3],p1[1]);a=max3f(a,p1[2],p1[3]);
  #pragma unroll
  for(int r=4;r<16;r+=4){a=max3f(a,p0[r],p0[r+1]);b=max3f(b,p0[r+2],p0[r+3]);a=max3f(a,p1[r],p1[r+1]);b=max3f(b,p1[r+2],p1[r+3]);}
  const float m=max2f(a,b);
  auto rr=__builtin_amdgcn_permlane32_swap(__float_as_uint(m),__float_as_uint(m),false,false);
  return max2f(__uint_as_float(rr[0]),__uint_as_float(rr[1]));
}
__device__ __forceinline__ void pv(f32x16*o,int vb,bf16x8 pa0,bf16x8 pa1,bf16x8 pa2,bf16x8 pa3){
  #pragma unroll
  for(int d0=0;d0<2;++d0){s16x4 lo[4],hi[4];
    #pragma unroll
    for(int ks=0;ks<4;++ks){
      asm volatile("ds_read_b64_tr_b16 %0,%1 offset:%c2":"=&v"(lo[ks]):"v"(vb),"i"(d0*4096+ks*1024):"memory");
      asm volatile("ds_read_b64_tr_b16 %0,%1 offset:%c2":"=&v"(hi[ks]):"v"(vb),"i"(d0*4096+ks*1024+512):"memory");}
    asm volatile("s_waitcnt lgkmcnt(0)":::"memory");SBAR();
    #define PK(k) (bf16x8){lo[k][0],lo[k][1],lo[k][2],lo[k][3],hi[k][0],hi[k][1],hi[k][2],hi[k][3]}
    o[d0]=__builtin_amdgcn_mfma_f32_32x32x16_bf16(pa0,PK(0),o[d0],0,0,0);
    o[d0]=__builtin_amdgcn_mfma_f32_32x32x16_bf16(pa1,PK(1),o[d0],0,0,0);
    o[d0]=__builtin_amdgcn_mfma_f32_32x32x16_bf16(pa2,PK(2),o[d0],0,0,0);
    o[d0]=__builtin_amdgcn_mfma_f32_32x32x16_bf16(pa3,PK(3),o[d0],0,0,0);
    #undef PK
  }
}

#ifndef ATTN_STORE16
#define ATTN_STORE16(p,v) (*(u32x4*)(p)=(v))
#endif
template<int THRL> __device__ __forceinline__ void attn_unit(const bf16*Qbase,const int QP,const bf16*__restrict__ Kh,const bf16*__restrict__ Vh,const int KP,const int VP,const int NT,bf16*Obase,const int OP,char*shm,const int tid){
  const int lane=tid&63,r32=lane&31,hi=lane>>5; const int wid=__builtin_amdgcn_readfirstlane(tid>>6);
  const bf16*Qw=Qbase+(long)(wid*QBLK)*QP;
  const unsigned lds0=(unsigned)(uintptr_t)shm;
  float*wsf=(float*)(shm+LDS_WS)+wid*64;
  const bf16*ksrc=Kh+(long)lane*KP+wid*8;
  const bf16*vsrc=Vh+(long)(16*(wid&3)+(lane>>2))*VP+(wid>>2)*32+(lane&3)*8;
  const unsigned kdst=lds0+LDS_K+wid*1024, vdst=lds0+LDS_V+wid*1024;
  #define DMA_K(t,slot) glds16(ksrc+(long)(t)*KVBLK*KP,(unsigned)__builtin_amdgcn_readfirstlane(kdst+(slot)))
  #define DMA_V(t,slot) glds16(vsrc+(long)(t)*KVBLK*VP,(unsigned)__builtin_amdgcn_readfirstlane(vdst+(slot)))
  const int vb0=(int)(lds0+LDS_V)+((lane>>4)&1)*32+(lane&3)*8+(4*hi+((lane&15)>>2))*64;
  const char*Kbase=shm+LDS_K; bf16x8 kf[8];
  const lds_cptr shm3=(lds_cptr)shm; const lds_cptr kp0=shm3+LDS_K+hi*1024+r32*16; const lds_cptr vp0=shm3+LDS_V+((lane>>4)&1)*32+(lane&3)*8+(4*hi+((lane&15)>>2))*64;
  DMA_K(0,0);DMA_V(0,0);DMA_K(1,SLOTB);
  bf16x8 qr[4];
  #pragma unroll
  for(int d0=0;d0<4;++d0)qr[d0]=*reinterpret_cast<const bf16x8*>(&Qw[(long)r32*QP+d0*16+hi*8]);
  f32x16 o[2];o[0]=f32x16{};o[1]=f32x16{};f32x16 o2=f32x16{};const bf16x8 ones8={0x3F80,0x3F80,0x3F80,0x3F80,0x3F80,0x3F80,0x3F80,0x3F80};    float zl_=0.f;asm volatile("":"+v"(zl_));f32x16 negm;
  _Pragma("unroll") for(int r=0;r<16;++r)negm[r]=zl_;
  asm volatile("":"+v"(negm));
  #define CMASK(P0,P1,t) do{}while(0)
  #define START(P0,P1) do{ _Pragma("unroll") for(int r=0;r<16;++r)P0[r]=__builtin_amdgcn_exp2f(P0[r]); }while(0)
  #define RESC() do{}while(0)
  f32x16 pA0,pA1,pB0,pB1;
  int sl_prev=0,sl_cur=0,sl_next=SLOTB;
  #define ROT() do{sl_prev=sl_cur;sl_cur=sl_next;sl_next=(sl_next==(NSLOT-1)*SLOTB)?0:sl_next+SLOTB;}while(0)
  DMA_K(2,2*SLOTB);
  WAIT_BAR(3);
  qkt(pA0,pA1,Kbase,qr,negm,r32,hi);asm volatile("s_nop 15\n\ts_nop 7":"+v"(pA0),"+v"(pA1));CMASK(pA0,pA1,0);
  START(pA0,pA1);
  _Pragma("unroll") for(int r=0;r<16;++r)pA1[r]=__builtin_amdgcn_exp2f(pA1[r]);
  WAIT_BAR(0);
  DMA_K(3,0);DMA_V(1,SLOTB);
  ROT();
  kload8(kf,kp0+sl_cur);
  WAIT_BAR(2);
  s16x4 vlo[8],vhi[8]; u32x4 pw0,pw1,pw2,pw3;
  #define PKW(P,B) cvtpk_s(P[B],P[B+1])
  #define PAF(k) __builtin_bit_cast(bf16x8,pw##k)
  #define VFR(i) (bf16x8){vlo[i][0],vlo[i][1],vlo[i][2],vlo[i][3],vhi[i][0],vhi[i][1],vhi[i][2],vhi[i][3]}
  #define PIN(x) asm volatile("":"+v"(x))
  #define MX3(a,b,c) __builtin_fmaxf(__builtin_fmaxf((a),(b)),(c))
  #define GAPA(MF,A0,A1,A2,A3,W0,W1,PW) do{ MF; W0; W1; PIN(PW); SBAR(); }while(0)
  #define EX(v) __builtin_amdgcn_exp2f(v)
  #define GAPB(MF,X,B) do{ MF; X[B]=EX(X[B]); X[B+1]=EX(X[B+1]); X[B+2]=EX(X[B+2]); X[B+3]=EX(X[B+3]); PIN(X); SBAR(); }while(0)
  #define VRD(i) do{ vlo[i]=vtr(vp_+(((i)>>2)*4096+((i)&3)*1024)); vhi[i]=vtr(vp_+(((i)>>2)*4096+((i)&3)*1024+512)); }while(0)
  #define KRD(G,j) do{ if(G){ kload2(kf,kp0+sl_next,j); SBAR(); } }while(0)
  #define STEP(C0,C1,P0,P1,t,GK,GV,GL) do{ SBAR(); \
    const lds_cptr vp_=vp0+sl_prev; \
    VRD(0); SBAR(); \
    GAPA(C0=__builtin_amdgcn_mfma_f32_32x32x16_bf16(kf[0],qr[0],negm,0,0,0), P0[2],P0[3],P0[4],P0[5],     pw0[0]=PKW(P0,0), pw0[1]=PKW(P0,2), pw0); \
    VRD(4); SBAR(); GAPA(C1=__builtin_amdgcn_mfma_f32_32x32x16_bf16(kf[1],qr[0],negm,0,0,0), P0[6],P0[7],P0[8],P0[9],     pw0[2]=PKW(P0,4), pw0[3]=PKW(P0,6), pw0); \
    VRD(1); SBAR(); GAPA(C0=__builtin_amdgcn_mfma_f32_32x32x16_bf16(kf[2],qr[1],C0,0,0,0),   P0[10],P0[11],P0[12],P0[13], pw1[0]=PKW(P0,8), pw1[1]=PKW(P0,10), pw1); \
    VRD(5); SBAR(); GAPA(C1=__builtin_amdgcn_mfma_f32_32x32x16_bf16(kf[3],qr[1],C1,0,0,0),   P0[14],P0[15],P1[0],P1[1],   pw1[2]=PKW(P0,12),pw1[3]=PKW(P0,14), pw1); \
    VRD(2); SBAR(); GAPA(C0=__builtin_amdgcn_mfma_f32_32x32x16_bf16(kf[4],qr[2],C0,0,0,0),   P1[2],P1[3],P1[4],P1[5],     pw2[0]=PKW(P1,0), pw2[1]=PKW(P1,2), pw2); \
    VRD(6); SBAR(); GAPA(C1=__builtin_amdgcn_mfma_f32_32x32x16_bf16(kf[5],qr[2],C1,0,0,0),   P1[6],P1[7],P1[8],P1[9],     pw2[2]=PKW(P1,4), pw2[3]=PKW(P1,6), pw2); \
    VRD(3); SBAR(); GAPA(C0=__builtin_amdgcn_mfma_f32_32x32x16_bf16(kf[6],qr[3],C0,0,0,0),   P1[10],P1[11],P1[12],P1[13], pw3[0]=PKW(P1,8), pw3[1]=PKW(P1,10), pw3); \
    VRD(7); SBAR(); GAPA(C1=__builtin_amdgcn_mfma_f32_32x32x16_bf16(kf[7],qr[3],C1,0,0,0),   P1[14],P1[15],0.f,0.f,       pw3[2]=PKW(P1,12),pw3[3]=PKW(P1,14), pw3); \
    if(GK){DMA_K((t)+3,sl_cur);} if(GV){DMA_V((t)+1,sl_next);} \
    CMASK(C0,C1,t); \
    SBAR(); \
    GAPB(o[0]=__builtin_amdgcn_mfma_f32_32x32x16_bf16(PAF(0),VFR(0),o[0],0,0,0), C0,0); \
    GAPB(o[1]=__builtin_amdgcn_mfma_f32_32x32x16_bf16(PAF(0),VFR(4),o[1],0,0,0), C0,4); \
    o2=__builtin_amdgcn_mfma_f32_32x32x16_bf16(PAF(0),ones8,o2,0,0,0); SBAR(); \
    KRD(GL,0); GAPB(o[0]=__builtin_amdgcn_mfma_f32_32x32x16_bf16(PAF(1),VFR(1),o[0],0,0,0), C0,8); \
    KRD(GL,1); GAPB(o[1]=__builtin_amdgcn_mfma_f32_32x32x16_bf16(PAF(1),VFR(5),o[1],0,0,0), C0,12); \
    o2=__builtin_amdgcn_mfma_f32_32x32x16_bf16(PAF(1),ones8,o2,0,0,0); SBAR(); \
    KRD(GL,2); GAPB(o[0]=__builtin_amdgcn_mfma_f32_32x32x16_bf16(PAF(2),VFR(2),o[0],0,0,0), C1,0); \
    KRD(GL,3); GAPB(o[1]=__builtin_amdgcn_mfma_f32_32x32x16_bf16(PAF(2),VFR(6),o[1],0,0,0), C1,4); \
    o2=__builtin_amdgcn_mfma_f32_32x32x16_bf16(PAF(2),ones8,o2,0,0,0); SBAR(); \
    GAPB(o[0]=__builtin_amdgcn_mfma_f32_32x32x16_bf16(PAF(3),VFR(3),o[0],0,0,0), C1,8); \
    GAPB(o[1]=__builtin_amdgcn_mfma_f32_32x32x16_bf16(PAF(3),VFR(7),o[1],0,0,0), C1,12); \
    o2=__builtin_amdgcn_mfma_f32_32x32x16_bf16(PAF(3),ones8,o2,0,0,0); SBAR(); \
    }while(0)
  int t=1;
  #undef CMASK
  #define CMASK(P0,P1,t) do{}while(0)
  for(;t+5<NT;t+=2){
    STEP(pB0,pB1,pA0,pA1,t,true,true,true);     WAIT_BAR(2); RESC(); ROT();
    STEP(pA0,pA1,pB0,pB1,t+1,true,true,true);   WAIT_BAR(2); RESC(); ROT();
  }
  #undef CMASK
  #define CMASK(P0,P1,t) do{}while(0)
  #define ENDW(tt) do{ if((tt)+3<NT){WAIT_BAR(2);} else if((tt)+2<NT){WAIT_BAR(1);} else {WAIT_BAR(0);} }while(0)
  for(;t+1<NT;t+=2){
    STEP(pB0,pB1,pA0,pA1,t,(t+3<NT),(t+1<NT),(t+1<NT));       ENDW(t);   RESC(); ROT();
    STEP(pA0,pA1,pB0,pB1,t+1,(t+4<NT),(t+2<NT),(t+2<NT));     ENDW(t+1); RESC(); ROT();
  }
  STEP(pB0,pB1,pA0,pA1,NT-1,false,false,false); RESC();
  {
    pw0=(u32x4){PKW(pB0,0),PKW(pB0,2),PKW(pB0,4),PKW(pB0,6)};pw1=(u32x4){PKW(pB0,8),PKW(pB0,10),PKW(pB0,12),PKW(pB0,14)};pw2=(u32x4){PKW(pB1,0),PKW(pB1,2),PKW(pB1,4),PKW(pB1,6)};pw3=(u32x4){PKW(pB1,8),PKW(pB1,10),PKW(pB1,12),PKW(pB1,14)};
    SBAR(); pv(o,vb0+sl_cur,PAF(0),PAF(1),PAF(2),PAF(3));
    o2=__builtin_amdgcn_mfma_f32_32x32x16_bf16(PAF(0),ones8,o2,0,0,0);o2=__builtin_amdgcn_mfma_f32_32x32x16_bf16(PAF(1),ones8,o2,0,0,0);o2=__builtin_amdgcn_mfma_f32_32x32x16_bf16(PAF(2),ones8,o2,0,0,0);o2=__builtin_amdgcn_mfma_f32_32x32x16_bf16(PAF(3),ones8,o2,0,0,0); }
  #undef PKW
  #undef PAF
  #undef VFR
  #undef PIN
  #undef MX3
  #undef GAPA
  #undef GAPB
  #undef EX
  #undef VRD
  #undef KRD
  #undef STEP
  #undef ENDW
  float rli[16];
  #pragma unroll
  for(int r=0;r<16;++r)rli[r]=__builtin_amdgcn_rcpf(o2[r]);
  bf16*Ow=Obase+(long)(wid*QBLK)*OP;
  { bf16*stg=(bf16*)(shm+LDS_OST)+wid*2048;
    #pragma unroll
    for(int r=0;r<16;++r){const int orow=crow(r,hi);
      #pragma unroll
      for(int d0=0;d0<2;++d0)stg[orow*64+d0*32+r32]=__float2bfloat16(o[d0][r]*rli[r]);}
    asm volatile("s_waitcnt lgkmcnt(0)":::"memory");
    #pragma unroll
    for(int i=0;i<4;++i){const int row=i*8+(lane>>3),ch=lane&7; const u32x4 v=*(const u32x4*)(stg+row*64+ch*8); ATTN_STORE16(Ow+(long)row*OP+ch*8,v);} }
  asm volatile("s_waitcnt lgkmcnt(0)\n\ts_barrier":::"memory");
  #undef DMA_K
  #undef DMA_V
  #undef CMASK
  #undef START
  #undef RESC
  #undef ROT
}
constexpr int ATTN_LDS_BYTES=LDS_BYTES;
#undef SBAR
#undef WAIT_BAR
}

constexpr int DM = 1024, NB = 2, SEQ = 8192, CTXL = 256, SB = SEQ + CTXL, MT = NB * SB, DEPTH = 2;
constexpr int NIN = 2576, NWIN = 2816, NP1 = 1792, NQK = 640;
constexpr int C_MQ = 0, C_MK = 256, C_MV = 512, C_MO = 768, C_AQ = 1024, C_AK = 1536, C_AV = 1664;
constexpr int NE = 16, FF = 2816, ROWS_E = 2304, NT1 = 22;
constexpr int NFFT = 16384;
constexpr float LN_EPS = 1e-5f, RMS_EPS = 1e-6f, ALPHA = 1.41421356237309515f;
constexpr float W1_MUL = 64.f, W2_MUL = 256.f; constexpr int W1_SCALE = 0x79797979, W2_SCALE = 0x77777777;
constexpr int SST = 4224;
constexpr int NPOS = 66;

constexpr size_t MiB = 1u << 20;
constexpr size_t WS_CTL = 0, CTL_ZERO_BYTES = 64 * 1024;
constexpr size_t WS_MODP = 1 * MiB, WS_MOD = 4 * MiB, WS_TW = 6 * MiB, WS_HID = 7 * MiB, WS_TAPC = 12 * MiB;
constexpr size_t WS_ROPE = 14 * MiB;
constexpr size_t WS_WINT = 16 * MiB, WS_WOUTT = 28 * MiB, WS_HF = 32 * MiB, WS_W1T = 160 * MiB, WS_W2T = 512 * MiB, WS_HN = 688 * MiB;
constexpr size_t WS_R = 722 * MiB;
constexpr size_t WS_P1 = WS_R, WS_HY = WS_R + 58 * MiB, WS_SLOC = WS_R + 108 * MiB, WS_SCAR = WS_R + 126 * MiB, WS_Y = WS_R + 144 * MiB, WS_MIX = WS_R + 178 * MiB;
constexpr size_t WS_TAPS = WS_R;
constexpr size_t WS_Z1 = WS_R + 250 * MiB;
constexpr size_t WS_ACT = WS_R + 72 * MiB, WS_YE = WS_R + 270 * MiB;
constexpr size_t WS_XS = WS_R + 414 * MiB, WS_XS2 = WS_XS + 66 * MiB, WS_QKP = WS_XS2 + 66 * MiB, WS_AFF = WS_QKP + 22 * MiB, WS_GT = WS_AFF + 2 * MiB, WS_INV = WS_GT + 2 * MiB, WS_IDX = WS_INV + 2 * MiB, WS_VAL = WS_IDX + 1 * MiB, WS_END = WS_VAL + 1 * MiB;
static_assert(WS_END <= 1408 * MiB, "workspace");
static_assert((size_t)MT * NP1 * 2 <= 58 * MiB && (size_t)NB * 768 * SB * 4 <= 50 * MiB && (size_t)16 * NPOS * SST * 4 <= 18 * MiB && (size_t)MT * DM * 2 <= 34 * MiB && (size_t)MT * DM * 4 <= 66 * MiB, "mix region");
static_assert((size_t)NE * ROWS_E * FF <= 198 * MiB && (size_t)NE * ROWS_E * DM * 2 <= 144 * MiB, "moe region");
static_assert(WS_MIX + 66 * MiB <= WS_XS, "mix region end");

constexpr int RING_OFF = 0;
constexpr int IDXL_OFF = 131072;
constexpr int LDSX_OFF = 139264;
constexpr int LDSCTL_OFF = 143360, MISC_OFF = LDSCTL_OFF + 320;
constexpr int LDS_BYTES = 147456;
constexpr int NWAVES = 8, NTHR = 512;

#define GAS __attribute__((address_space(1)))
#define LAS __attribute__((address_space(3)))
typedef unsigned short bf16;
typedef unsigned v4u __attribute__((ext_vector_type(4)));
typedef float f32x4 __attribute__((ext_vector_type(4)));
typedef short bf16x8 __attribute__((ext_vector_type(8)));
typedef GAS unsigned gu32;
typedef GAS unsigned long long gu64;
#define RLX_AGENT __ATOMIC_RELAXED, __HIP_MEMORY_SCOPE_AGENT
#define LDS_WAIT() asm volatile("s_waitcnt lgkmcnt(0)" ::: "memory")
#define VM_WAIT() asm volatile("s_waitcnt vmcnt(0)" ::: "memory")
__device__ __forceinline__ unsigned long long rt() { return __builtin_amdgcn_s_memrealtime(); }
__device__ __forceinline__ unsigned f2bf(float f) { unsigned u = __builtin_bit_cast(unsigned, f); return (u + 0x7fffu + ((u >> 16) & 1u)) >> 16; }
__device__ __forceinline__ unsigned pk2(float lo, float hi) { return f2bf(lo) | (f2bf(hi) << 16); }

#define XB_TMO      128
#define XB_XCNT(j)  (256  + 64 * (j))
#define XB_XSUB(j)  (1280 + 64 * (j))
#define XB_XGEN(j)  (2304 + 64 * (j))
#define XB_TOP      3328
#define XB_TOPGEN   3392
#define XCD_BAR_WORDS 3456
#define XB_SPIN_CAP (1u << 18)

__device__ __forceinline__ unsigned xb_ld(unsigned* p)              { return __hip_atomic_load(p, __ATOMIC_RELAXED, __HIP_MEMORY_SCOPE_AGENT); }
__device__ __forceinline__ unsigned xb_add(unsigned* p, unsigned v) { return __hip_atomic_fetch_add(p, v, __ATOMIC_RELAXED, __HIP_MEMORY_SCOPE_AGENT); }
__device__ __forceinline__ unsigned xb_xcc_id() { return (unsigned)__builtin_amdgcn_s_getreg((3 << 11) | 20) & 0xFu; }
#define XB_SPIN(cond, bar) do { unsigned _sp = 0; while (cond) { __builtin_amdgcn_s_sleep(1); \
    if ((++_sp & 255u) == 0u) { if (xb_ld(&(bar)[XB_TMO])) break; if (_sp > XB_SPIN_CAP) { atomicAdd(&(bar)[XB_TMO], 1u); break; } } } } while (0)

struct XcdBarrier {
    unsigned* bar; unsigned x;
    volatile LAS unsigned* st;
};

__device__ __forceinline__ XcdBarrier xcd_barrier_post(unsigned* bar, volatile LAS unsigned* st) {
    XcdBarrier b; b.bar = bar; b.x = xb_xcc_id(); b.st = st;
    if (threadIdx.x == 0) (void)xb_add(&bar[XB_XCNT(b.x)], 1u);
    return b;
}
__device__ __forceinline__ void xcd_barrier_complete(unsigned* bar, unsigned x, unsigned& nloc, unsigned& nx) {
    const unsigned G = gridDim.x * gridDim.y * gridDim.z;
    unsigned sum, cnt, mine, sp = 0u;
    for (;;) {
        sum = 0u; cnt = 0u; mine = 0u;
#pragma unroll
        for (unsigned j = 0; j < 16; ++j) { const unsigned c = xb_ld(&bar[XB_XCNT(j)]); sum += c; cnt += (c > 0u) ? 1u : 0u; mine = (j == x) ? c : mine; }
        if (sum == G) break;
        __builtin_amdgcn_s_sleep(1);
        if ((++sp & 255u) == 0u) { if (xb_ld(&bar[XB_TMO])) break; if (sp > XB_SPIN_CAP) { atomicAdd(&bar[XB_TMO], 1u); break; } }
    }
    nloc = mine > 0u ? mine : 1u; nx = cnt > 0u ? cnt : 1u;
}

__device__ __forceinline__ void xcd_barrier(const XcdBarrier& b) {
    asm volatile("s_waitcnt vmcnt(0)" ::: "memory");
    __syncthreads();
    if (threadIdx.x == 0) {
        unsigned* bar = b.bar;
        __builtin_amdgcn_s_waitcnt(0);
        unsigned nloc = b.st[0], nx = b.st[1];
        if (nloc == 0u) { xcd_barrier_complete(bar, b.x, nloc, nx); b.st[0] = nloc; b.st[1] = nx; }
        const unsigned old = xb_add(&bar[XB_XSUB(b.x)], 1u);
        const unsigned gen = old / nloc;
        if (old + 1u == (gen + 1u) * nloc) {
            __builtin_amdgcn_fence(__ATOMIC_RELEASE, "agent");
            asm volatile("s_waitcnt vmcnt(0)" ::: "memory");
            const unsigned og = xb_add(&bar[XB_TOP], 1u);
            const unsigned tg = og / nx;
            if (og + 1u == (tg + 1u) * nx) xb_add(&bar[XB_TOPGEN], 1u);
            else XB_SPIN(xb_ld(&bar[XB_TOPGEN]) == tg, bar);
            __builtin_amdgcn_fence(__ATOMIC_ACQUIRE, "agent");
            xb_add(&bar[XB_XGEN(b.x)], 1u);
            asm volatile("s_waitcnt vmcnt(0)" ::: "memory");
        } else {
            XB_SPIN(xb_ld(&bar[XB_XGEN(b.x)]) == gen, bar);
            __builtin_amdgcn_fence(__ATOMIC_ACQUIRE, "agent");
            asm volatile("s_waitcnt vmcnt(0)" ::: "memory");
        }
    }
    __syncthreads();
}


typedef float f32x16 __attribute__((ext_vector_type(16)));
typedef float f32x2 __attribute__((ext_vector_type(2)));
#ifndef MK_WT
#define MK_WT 0
#endif
__device__ __forceinline__ void st16(void* p, v4u v) {
#if MK_WT
    asm volatile("global_store_dwordx4 %0, %1, off sc1\n\ts_nop 1" ::"v"(p), "v"(v) : "memory");
#else
    *(v4u*)p = v;
#endif
}
__device__ __forceinline__ void st8(void* p, unsigned long long v) {
#if MK_WT
    asm volatile("global_store_dwordx2 %0, %1, off sc1\n\ts_nop 1" ::"v"(p), "v"(v) : "memory");
#else
    *(unsigned long long*)p = v;
#endif
}
__device__ __forceinline__ void st4(void* p, unsigned v) {
#if MK_WT
    asm volatile("global_store_dword %0, %1, off sc1\n\ts_nop 1" ::"v"(p), "v"(v) : "memory");
#else
    *(unsigned*)p = v;
#endif
}

struct Args { const float* in[32]; float* out; unsigned char* ws; int ph_lo, ph_hi; };

struct Fr { LAS unsigned char* lds; int tid, lane, wave, G, bid; };
__device__ __forceinline__ Fr fr_fresh(const Fr& F) { Fr P = F; int t = F.tid; asm volatile("" : "+v"(t)); P.tid = t; P.lane = t & 63; P.wave = __builtin_amdgcn_readfirstlane(t >> 6); return P; }

template <int CTRL> __device__ __forceinline__ float dppf(float v) { return __builtin_bit_cast(float, __builtin_amdgcn_update_dpp(0, __builtin_bit_cast(int, v), CTRL, 0xf, 0xf, true)); }
template <int CTRL> __device__ __forceinline__ int dppi(int v) { return __builtin_amdgcn_update_dpp(0, v, CTRL, 0xf, 0xf, true); }
__device__ __forceinline__ float rlanef(float v, int l) { return __builtin_bit_cast(float, __builtin_amdgcn_readlane(__builtin_bit_cast(int, v), l)); }
__device__ __forceinline__ float wave_sum(float v) {
    v += dppf<0xB1>(v); v += dppf<0x4E>(v); v += dppf<0x141>(v); v += dppf<0x140>(v);
    return (rlanef(v, 0) + rlanef(v, 16)) + (rlanef(v, 32) + rlanef(v, 48));
}
__device__ __forceinline__ float wave_max(float v) {
    v = fmaxf(v, dppf<0xB1>(v)); v = fmaxf(v, dppf<0x4E>(v)); v = fmaxf(v, dppf<0x141>(v)); v = fmaxf(v, dppf<0x140>(v));
    return fmaxf(fmaxf(rlanef(v, 0), rlanef(v, 16)), fmaxf(rlanef(v, 32), rlanef(v, 48)));
}
__device__ __forceinline__ int wave_sum_i(int v) {
    v += dppi<0xB1>(v); v += dppi<0x4E>(v); v += dppi<0x141>(v); v += dppi<0x140>(v);
    return (__builtin_amdgcn_readlane(v, 0) + __builtin_amdgcn_readlane(v, 16)) + (__builtin_amdgcn_readlane(v, 32) + __builtin_amdgcn_readlane(v, 48));
}
__device__ __forceinline__ float bf2f(unsigned short b) { return __uint_as_float(((unsigned)b) << 16); }
__device__ __forceinline__ float bflo(unsigned w) { return __uint_as_float(w << 16); }
__device__ __forceinline__ float bfhi(unsigned w) { return __uint_as_float(w & 0xffff0000u); }
__device__ __forceinline__ float sigmoidf_(float x) { return __builtin_amdgcn_rcpf(1.f + __builtin_amdgcn_exp2f(x * -1.44269504088896341f)); }
__device__ __forceinline__ float siluf_(float x) { return x * sigmoidf_(x); }
__device__ __forceinline__ float fexp(float x) { return __builtin_amdgcn_exp2f(x * 1.44269504088896341f); }
#define BSYNC() __syncthreads()

template <int MODE> __device__ __forceinline__ int tr_row(int n) {
    if (MODE == 0) return n;
    if (MODE == 1) return n < 1024 ? n : (n < 1040 ? 2560 + (n - 1024) : (n < NIN ? n - 16 : -1));
    if (MODE == 2) return (n >> 7) * 256 + (n & 127);
    return (n >> 7) * 256 + 128 + (n & 127);
}
template <int MODE> __device__ __forceinline__ void tr_item(const float* __restrict__ W, int K, int N, bf16* WT, LAS unsigned* scr, int item, int lane) {
    const int nblk = (N + 63) / 64, kb = item / nblk, nb = item % nblk, k0 = 64 * kb, n0 = 64 * nb;
    const int n4 = lane & 15, kq = lane >> 4; const int ncol = n0 + 4 * n4; const bool ok = ncol < N;
    f32x4 va[8], vb[8];
    const float* src = W + (size_t)(k0 + 2 * kq) * N + ncol;
#pragma unroll
    for (int i = 0; i < 8; ++i) { va[i] = ok ? __builtin_nontemporal_load((const f32x4*)(src + (size_t)(8 * i) * N)) : (f32x4){0.f, 0.f, 0.f, 0.f};
                                  vb[i] = ok ? __builtin_nontemporal_load((const f32x4*)(src + (size_t)(8 * i + 1) * N)) : (f32x4){0.f, 0.f, 0.f, 0.f}; }
#pragma unroll
    for (int i = 0; i < 8; ++i) { const int kd = 4 * i + kq;
        scr[(4 * n4 + 0) * 36 + kd] = pk2(va[i].x, vb[i].x); scr[(4 * n4 + 1) * 36 + kd] = pk2(va[i].y, vb[i].y); scr[(4 * n4 + 2) * 36 + kd] = pk2(va[i].z, vb[i].z); scr[(4 * n4 + 3) * 36 + kd] = pk2(va[i].w, vb[i].w); }
    LDS_WAIT(); asm volatile("" ::: "memory");
#pragma unroll
    for (int j = 0; j < 8; ++j) { const int n = 8 * j + (lane >> 3), c = lane & 7; const v4u o = *(const LAS v4u*)(scr + n * 36 + 4 * c);
        const int row = (n0 + n < N) ? tr_row<MODE>(n0 + n) : -1;
        if (row >= 0) *(GAS v4u*)(WT + (size_t)row * K + k0 + 8 * c) = o; }
    LDS_WAIT(); asm volatile("" ::: "memory");
}

__device__ __forceinline__ unsigned pk4_fp8(float a, float b, float c, float d) { int w = 0; w = __builtin_amdgcn_cvt_pk_fp8_f32(a, b, w, false); w = __builtin_amdgcn_cvt_pk_fp8_f32(c, d, w, true); return (unsigned)w; }
struct F8Job { const float* W; unsigned char* WT; int K, N, item, mode; float mul; };
__device__ __forceinline__ F8Job f8_job(const Args& A, int l, int q  ) {
    constexpr int I_M = 352, S_M = NE * I_M;
    F8Job j; const int kind = q / S_M, r = q - kind * S_M, e = r / I_M, le = l * NE + e; j.item = r - e * I_M;
    if (kind == 0) { j.W = A.in[27] + (size_t)le * DM * FF; j.WT = (unsigned char*)(A.ws + WS_W1T) + (size_t)le * (2 * FF) * DM; j.K = DM; j.N = FF; j.mode = 2; j.mul = W1_MUL; }
    else if (kind == 1) { j.W = A.in[28] + (size_t)le * DM * FF; j.WT = (unsigned char*)(A.ws + WS_W1T) + (size_t)le * (2 * FF) * DM; j.K = DM; j.N = FF; j.mode = 3; j.mul = W1_MUL; }
    else { j.W = A.in[29] + (size_t)le * FF * DM; j.WT = (unsigned char*)(A.ws + WS_W2T) + (size_t)le * DM * FF; j.K = FF; j.N = DM; j.mode = 0; j.mul = W2_MUL; }
    return j;
}
__device__ __forceinline__ void f8_load(const F8Job& j, int h, f32x4 (&v)[4][4], int lane) {
    const int nblk = j.N / 64, kb = j.item / nblk, nb = j.item % nblk, k0 = 128 * kb + 64 * h, n0 = 64 * nb;
    const int n4 = lane & 15, kq = lane >> 4;
    const float* src = j.W + (size_t)(k0 + 4 * kq) * j.N + n0 + 4 * n4;
#pragma unroll
    for (int i = 0; i < 4; ++i)
#pragma unroll
        for (int q = 0; q < 4; ++q) v[i][q] = __builtin_nontemporal_load((const f32x4*)(src + (size_t)(16 * i + q) * j.N));
}
__device__ __forceinline__ void f8_pack(const f32x4 (&v)[4][4], int h, float mul, LAS unsigned* scr, int lane) {
    const int n4 = lane & 15, kq = lane >> 4; const int sw = (n4 >> 1) & 7;
#pragma unroll
    for (int i = 0; i < 4; ++i) { const int kd = 4 * ((4 * h + i) ^ sw) + kq;
        scr[(4 * n4 + 0) * 36 + kd] = pk4_fp8(v[i][0].x * mul, v[i][1].x * mul, v[i][2].x * mul, v[i][3].x * mul);
        scr[(4 * n4 + 1) * 36 + kd] = pk4_fp8(v[i][0].y * mul, v[i][1].y * mul, v[i][2].y * mul, v[i][3].y * mul);
        scr[(4 * n4 + 2) * 36 + kd] = pk4_fp8(v[i][0].z * mul, v[i][1].z * mul, v[i][2].z * mul, v[i][3].z * mul);
        scr[(4 * n4 + 3) * 36 + kd] = pk4_fp8(v[i][0].w * mul, v[i][1].w * mul, v[i][2].w * mul, v[i][3].w * mul); }
}
__device__ __forceinline__ void f8_store(const F8Job& j, LAS unsigned* scr, int lane) {
    const int nblk = j.N / 64, kb = j.item / nblk, nb = j.item % nblk, k0 = 128 * kb, n0 = 64 * nb;
    LDS_WAIT(); asm volatile("" ::: "memory");
#pragma unroll
    for (int jj = 0; jj < 8; ++jj) { const int n = 8 * jj + (lane >> 3), c = lane & 7; const v4u o = *(const LAS v4u*)(scr + n * 36 + 4 * (c ^ ((n >> 3) & 7)));
        const int nn = n0 + n; const int row = j.mode == 0 ? nn : (nn >> 7) * 256 + (j.mode == 3 ? 128 : 0) + (nn & 127);
        *(GAS v4u*)(j.WT + (size_t)row * j.K + k0 + 16 * c) = o; }
    LDS_WAIT(); asm volatile("" ::: "memory");
}

__device__ __forceinline__ void ph_convert_experts(const Fr& F, const Args& A, int l) {
    LAS unsigned* scr = (LAS unsigned*)(F.lds + RING_OFF + F.wave * 16384);
    const int gw = F.bid * NWAVES + F.wave, NGW = F.G * NWAVES;
    __syncthreads();
#pragma unroll 1
    for (int it = (gw + NGW - 640) % NGW; it < 3 * NE * 352; it += NGW) {
        const F8Job j = f8_job(A, l, it);
        f32x4 va[4][4], vb[4][4];
        f8_load(j, 0, va, F.lane); f8_load(j, 1, vb, F.lane);
        f8_pack(va, 0, j.mul, scr, F.lane); f8_pack(vb, 1, j.mul, scr, F.lane);
        f8_store(j, scr, F.lane);
    }
    __syncthreads();
}
__device__ __forceinline__ void ph_convert(const Fr& F, const Args& A) {
    unsigned char* ws = A.ws;
    LAS unsigned* scr = (LAS unsigned*)(F.lds + RING_OFF + F.wave * 16384);
    const int gw = F.bid * NWAVES + F.wave, NGW = F.G * NWAVES;
    const int gid = F.bid * NTHR + F.tid, NG = F.G * NTHR;
    constexpr int I_WIN = 16 * 41, I_WOUT = 16 * 16, I_GU = 16 * 44, I_DN = 44 * 16;
    constexpr int S_A = DEPTH * I_WIN, S_B = S_A + DEPTH * I_WOUT;
    for (int it = gw; it < S_B; it += NGW) {
        if (it < S_A) { const int l = it / I_WIN, r = it % I_WIN; tr_item<1>(A.in[6] + (size_t)l * DM * NIN, DM, NIN, (bf16*)(ws + WS_WINT) + (size_t)l * NWIN * DM, scr, r, F.lane); }
        else { const int q = it - S_A, l = q / I_WOUT, r = q % I_WOUT; tr_item<0>(A.in[22] + (size_t)l * DM * DM, DM, DM, (bf16*)(ws + WS_WOUTT) + (size_t)l * DM * DM, scr, r, F.lane); }
    }
    f32x2* TW = (f32x2*)(ws + WS_TW);
    for (int i = gid; i < NFFT / 2; i += NG) { float s, c; sincospif((float)i * (1.f / 8192.f), &s, &c); TW[i] = (f32x2){c, -s}; }
    { f32x2* ROPE = (f32x2*)(ws + WS_ROPE);
      for (int i = gid; i < 128 * 16; i += NG) { const float ang = (float)(i >> 4) * exp2f(-(float)(i & 15) * (13.287712379549449f / 16.f)); ROPE[i] = (f32x2){cosf(ang), sinf(ang)}; } }
    float* MODP = (float*)(ws + WS_MODP);
    for (int it = gw; it < DEPTH * 16 * 24; it += NGW) {
        const int l = it / (16 * 24), kc = (it / 24) % 16, nb = it % 24;
        const int k = kc * 64 + F.lane;
        const float s0 = siluf_(A.in[1][k]), s1 = siluf_(A.in[1][DM + k]), s2 = siluf_(A.in[3][k]);
        f32x4 a0 = {0.f, 0.f, 0.f, 0.f}, a1 = a0, a2 = a0;
        const float* wp = A.in[4] + ((size_t)l * DM + kc * 64) * 6144 + nb * 256 + 4 * F.lane;
#pragma unroll 4
        for (int kk = 0; kk < 64; ++kk) { const f32x4 w = *(const f32x4*)(wp + (size_t)kk * 6144);
            const float t0 = __shfl(s0, kk), t1 = __shfl(s1, kk), t2 = __shfl(s2, kk); a0 += w * t0; a1 += w * t1; a2 += w * t2; }
        float* o = MODP + ((size_t)(l * 3) * 16 + kc) * 6144 + nb * 256 + 4 * F.lane;
        *(f32x4*)(o) = a0; *(f32x4*)(o + (size_t)16 * 6144) = a1; *(f32x4*)(o + (size_t)32 * 6144) = a2;
    }
    float* HID = (float*)(ws + WS_HID);
    for (int it = gw; it < DEPTH * SB; it += NGW) {
        const int l = it / SB, pos = it % SB; const int n = pos < SEQ ? SEQ : CTXL, i = pos < SEQ ? pos : pos - SEQ;
        const int k = F.lane; float feat = 0.f;
        if (k == 0) feat = (float)i / (float)n;
        else if (k <= 16) feat = cospif((float)(2 * i * k) / (float)n);
        else if (k <= 32) feat = sinpif((float)(2 * i * (k - 16)) / (float)n);
        const float* w1 = A.in[15] + (size_t)l * 33 * 64; const float* w2 = A.in[18] + (size_t)l * 64 * 64;
        float acc = A.in[16][l * 64 + k];
#pragma unroll
        for (int q = 0; q < 33; ++q) acc += __shfl(feat, q) * w1[q * 64 + k];
        const float h1 = sinf(A.in[17][l * 128 + k] * acc);
        float acc2 = A.in[19][l * 64 + k];
#pragma unroll 8
        for (int q = 0; q < 64; ++q) acc2 += __shfl(h1, q) * w2[q * 64 + k];
        HID[((size_t)l * SB + pos) * 64 + k] = sinf(A.in[17][l * 128 + 64 + k] * acc2);
    }
}

__device__ __forceinline__ int fphys(int i) { return i + ((i >> 6) << 2); }
__device__ __forceinline__ f32x2 cmul(f32x2 a, f32x2 b) { return (f32x2){a.x * b.x - a.y * b.y, a.x * b.y + a.y * b.x}; }
__device__ __forceinline__ f32x2 cmulc(f32x2 a, f32x2 b) { return (f32x2){a.x * b.x + a.y * b.y, a.y * b.x - a.x * b.y}; }
template <int NUM, int DEN> struct RotC {
    static constexpr int K16 = NUM * (16 / DEN);
    static constexpr float C = K16 == 0 ? 1.f : K16 == 1 ? 0.92387953251128674f : K16 == 2 ? 0.70710678118654752f : K16 == 3 ? 0.38268343236508977f : K16 == 4 ? 0.f : K16 == 5 ? -0.38268343236508977f : K16 == 6 ? -0.70710678118654752f : -0.92387953251128674f;
    static constexpr float S = K16 == 0 ? 0.f : K16 == 1 ? 0.38268343236508977f : K16 == 2 ? 0.70710678118654752f : K16 == 3 ? 0.92387953251128674f : K16 == 4 ? 1.f : K16 == 5 ? 0.92387953251128674f : K16 == 6 ? 0.70710678118654752f : 0.38268343236508977f;
};
template <int NUM, int DEN> __device__ __forceinline__ f32x2 crot(f32x2 a) {
    constexpr int K16 = RotC<NUM, DEN>::K16; constexpr float C = RotC<NUM, DEN>::C, S = RotC<NUM, DEN>::S;
    if (K16 == 0) return a;
    if (K16 == 4) return (f32x2){a.y, -a.x};
    if (K16 == 2) return (f32x2){(a.x + a.y) * C, (a.y - a.x) * C};
    if (K16 == 6) return (f32x2){(a.y - a.x) * S, -(a.x + a.y) * S};
    return (f32x2){a.x * C + a.y * S, a.y * C - a.x * S};
}
template <int NUM, int DEN> __device__ __forceinline__ f32x2 crotc(f32x2 a) {
    constexpr int K16 = RotC<NUM, DEN>::K16; constexpr float C = RotC<NUM, DEN>::C, S = RotC<NUM, DEN>::S;
    if (K16 == 0) return a;
    if (K16 == 4) return (f32x2){-a.y, a.x};
    if (K16 == 2) return (f32x2){(a.x - a.y) * C, (a.x + a.y) * C};
    if (K16 == 6) return (f32x2){-(a.x + a.y) * S, (a.x - a.y) * S};
    return (f32x2){a.x * C - a.y * S, a.y * C + a.x * S};
}
template <int R, int RS, int J, bool INV, bool UNITY> __device__ __forceinline__ void fft_bfly(f32x2 (&x)[1 << R], const f32x2 wb) {
    constexpr int E = 1 << R, hj = E >> (RS + 1);
    if constexpr (J < E) {
        if constexpr ((J & hj) == 0) {
            constexpr int jp = J & (hj - 1);
            const f32x2 a = x[J], b = x[J + hj];
            if (!INV) { x[J] = a + b; x[J + hj] = crot<jp, 2 * hj>(UNITY ? a - b : cmul(a - b, wb)); }
            else { const f32x2 v = crotc<jp, 2 * hj>(UNITY ? b : cmulc(b, wb)); x[J] = a + v; x[J + hj] = a - v; }
        }
        fft_bfly<R, RS, J + 1, INV, UNITY>(x, wb);
    }
}
template <int R, bool INV, int S> __device__ __forceinline__ void fft_pass(LAS f32x2* d, const f32x2* __restrict__ TW, const int tid) {
    constexpr int E = 1 << R, lq = 14 - S - R, q = 1 << lq, qs = q >= 64 ? q + ((q >> 6) << 2) : q, NIT = (NFFT >> R) / NTHR;
    constexpr bool UNITY = (lq == 0);
    static_assert(q >= 64 || E * q <= 64, "fft_pass: an item must not straddle a 64-element block");
    f32x2 tw[UNITY ? 1 : NIT][R];
    if constexpr (!UNITY) {
#pragma unroll
        for (int it = 0; it < NIT; ++it) { const int pos = (tid + it * NTHR) & (q - 1);
#pragma unroll
            for (int rs = 0; rs < R; ++rs) tw[it][rs] = TW[(pos << (S + rs)) & (NFFT / 2 - 1)]; }
    }
#pragma unroll (R == 4 ? 2 : 1)
    for (int it = 0; it < NIT; ++it) {
        const int w = tid + it * NTHR, grp = w >> lq, pos = w & (q - 1);
        LAS f32x2* p = d + fphys((grp << (lq + R)) + pos);
        f32x2 x[E];
#pragma unroll
        for (int j = 0; j < E; ++j) x[j] = p[j * qs];
        f32x2 wv[R];
#pragma unroll
        for (int rs = 0; rs < R; ++rs) wv[rs] = UNITY ? (f32x2){1.f, 0.f} : (NIT == 2 ? (it == 0 ? tw[0][rs] : tw[NIT - 1][rs]) : tw[0][rs]);
        if constexpr (R == 4) {
            if (!INV) { fft_bfly<4, 0, 0, false, UNITY>(x, wv[0]); fft_bfly<4, 1, 0, false, UNITY>(x, wv[1]); fft_bfly<4, 2, 0, false, UNITY>(x, wv[2]); fft_bfly<4, 3, 0, false, UNITY>(x, wv[3]); }
            else { fft_bfly<4, 3, 0, true, UNITY>(x, wv[3]); fft_bfly<4, 2, 0, true, UNITY>(x, wv[2]); fft_bfly<4, 1, 0, true, UNITY>(x, wv[1]); fft_bfly<4, 0, 0, true, UNITY>(x, wv[0]); }
        } else {
            static_assert(R == 2, "fft_pass: R is 4 or 2");
            if (!INV) { fft_bfly<2, 0, 0, false, UNITY>(x, wv[0]); fft_bfly<2, 1, 0, false, UNITY>(x, wv[1]); }
            else { fft_bfly<2, 1, 0, true, UNITY>(x, wv[1]); fft_bfly<2, 0, 0, true, UNITY>(x, wv[0]); }
        }
#pragma unroll
        for (int j = 0; j < E; ++j) p[j * qs] = x[j];
    }
}
__device__ __forceinline__ void fft_fwd(LAS f32x2* d, const f32x2* TW, int tid) {
    fft_pass<4, false, 0>(d, TW, tid); BSYNC(); fft_pass<4, false, 4>(d, TW, tid); BSYNC(); fft_pass<4, false, 8>(d, TW, tid); BSYNC(); fft_pass<2, false, 12>(d, TW, tid); BSYNC();
}
__device__ __forceinline__ void fft_inv(LAS f32x2* d, const f32x2* TW, int tid) {
    fft_pass<2, true, 12>(d, TW, tid); BSYNC(); fft_pass<4, true, 8>(d, TW, tid); BSYNC(); fft_pass<4, true, 4>(d, TW, tid); BSYNC(); fft_pass<4, true, 0>(d, TW, tid); BSYNC();
}

__device__ __forceinline__ float block_sum(float v, LAS float* red, int wave, int lane) {
    v = wave_sum(v);
    BSYNC();
    if (lane == 0) red[wave] = v;
    BSYNC();
    float s = 0.f;
#pragma unroll
    for (int i = 0; i < NWAVES; ++i) s += red[i];
    return s;
}

__device__ __forceinline__ void ph_taps(const Fr& F, const Args& A) {
    unsigned char* ws = A.ws;
    const int gid = F.bid * NTHR + F.tid, NG = F.G * NTHR;
    { float* MOD = (float*)(ws + WS_MOD); const float* MODP = (const float*)(ws + WS_MODP);
      for (int i = gid; i < DEPTH * 3 * 6144; i += NG) { const int l = i / (3 * 6144), n = i % 6144; float a = A.in[5][l * 6144 + n]; const float* p = MODP + (size_t)(i / 6144) * 16 * 6144 + n;
#pragma unroll
          for (int kc = 0; kc < 16; ++kc) a += p[(size_t)kc * 6144];
          MOD[i] = a; } }
    const float* HID = (const float*)(ws + WS_HID); float* TAPS = (float*)(ws + WS_TAPS);
    LAS float* hs = (LAS float*)(F.lds + RING_OFF);
    const float log_target = 4.605170185988091f; const float dlo = log_target / 1.5f, dhi = log_target / 0.3f;
    const int r = F.lane & 31, hh = F.lane >> 5;
    for (int u = F.bid; u < DEPTH * (SB / 64); u += F.G) {
        const int l = u / (SB / 64), pos0 = (u % (SB / 64)) * 64;
        BSYNC();
#pragma unroll
        for (int k = 0; k < 2; ++k) { const int idx = F.tid + NTHR * k, p = idx >> 4, c4 = idx & 15; const f32x4 v = *(const f32x4*)(HID + ((size_t)l * SB + pos0 + p) * 64 + 4 * c4);
            hs[p * 65 + 4 * c4] = v.x; hs[p * 65 + 4 * c4 + 1] = v.y; hs[p * 65 + 4 * c4 + 2] = v.z; hs[p * 65 + 4 * c4 + 3] = v.w; }
        BSYNC();
        const float* w3 = A.in[20] + (size_t)l * 64 * 1024;
#pragma unroll 1
        for (int task = F.wave; task < 16; task += NWAVES) {
            const int ph = task >> 3, col0 = (task & 7) * 128;
            f32x16 acc[4];
#pragma unroll
            for (int n = 0; n < 4; ++n) acc[n] = (f32x16){};
            const LAS float* ap = hs + (ph * 32 + r) * 65 + hh; const float* bp = w3 + (size_t)hh * 1024 + col0 + r;
#pragma unroll 4
            for (int kk = 0; kk < 32; ++kk) { const float a = ap[2 * kk];
#pragma unroll
                for (int n = 0; n < 4; ++n) acc[n] = __builtin_amdgcn_mfma_f32_32x32x2f32(a, bp[(size_t)(2 * kk) * 1024 + 32 * n], acc[n], 0, 0, 0); }
#pragma unroll
            for (int n = 0; n < 4; ++n) { const int col = col0 + 32 * n + r; const float de = dlo + (dhi - dlo) * (float)(col & 255) / 255.f;
                float* op = TAPS + ((size_t)l * 1024 + col) * SB + pos0 + ph * 32 + 4 * hh;
#pragma unroll
                for (int q = 0; q < 4; ++q) { f32x4 o;
#pragma unroll
                    for (int i = 0; i < 4; ++i) { const int pos = pos0 + ph * 32 + 8 * q + 4 * hh + i; const float t = pos < SEQ ? (float)pos / 8192.f : (float)(pos - SEQ) / 256.f; o[i] = acc[n][4 * q + i] * (expf(-t * de) + 0.05f); }
                    *(f32x4*)(op + 8 * q) = o; } }
        }
    }
}
__device__ __forceinline__ void ph_filters(const Fr& F, const Args& A) {
    unsigned char* ws = A.ws;
    const int gw = F.bid * NWAVES + F.wave, NGW = F.G * NWAVES;
    const float* TAPS = (const float*)(ws + WS_TAPS);
    { float* TAPC = (float*)(ws + WS_TAPC);
      for (int it = gw; it < DEPTH * 2 * 256; it += NGW) {
          const int l = it / 512, o = (it / 256) & 1, c = it & 255;
          const float* fw = TAPS + ((size_t)l * 1024 + o * 256 + c) * SB + SEQ; const float* bw = TAPS + ((size_t)l * 1024 + 512 + o * 256 + c) * SB + SEQ;
          float fv[4], gv[4]; float l1 = 0.f;
#pragma unroll
          for (int i = 0; i < 4; ++i) { const int s = F.lane + 64 * i; fv[i] = fw[s]; gv[i] = s ? bw[s] : 0.f; l1 += fabsf(fv[i]) + fabsf(gv[i]); }
          l1 = wave_sum(l1); const float inv = 1.f / l1; float* T = TAPC + (size_t)it * 512;
#pragma unroll
          for (int i = 0; i < 4; ++i) { const int s = F.lane + 64 * i; T[256 + s] = fv[i] * inv; if (s >= 1) T[256 - s] = gv[i] * inv; }
          if (F.lane == 0) T[0] = 0.f;
      } }
    LAS f32x2* d = (LAS f32x2*)(F.lds + RING_OFF); LAS float* xs = (LAS float*)(F.lds + LDSX_OFF);
    const f32x2* TW = (const f32x2*)(ws + WS_TW); f32x2* HF = (f32x2*)(ws + WS_HF);
    for (int u = F.bid; u < DEPTH * 256; u += F.G) {
        const int l = u / 256, c = u & 255;
        const float* fw0 = TAPS + ((size_t)l * 1024 + c) * SB; const float* bw0 = TAPS + ((size_t)l * 1024 + 512 + c) * SB;
        const float* fw1 = fw0 + (size_t)256 * SB; const float* bw1 = bw0 + (size_t)256 * SB;
        BSYNC();
        float l1a = 0.f, l1b = 0.f;
#pragma unroll 4
        for (int s = F.tid; s < SEQ; s += NTHR) { const float f0 = fw0[s], g0 = bw0[s], f1 = fw1[s], g1 = bw1[s];
            d[fphys(s)] = (f32x2){f0, f1};
            if (s >= 1) { d[fphys(NFFT - s)] = (f32x2){g0, g1}; l1a += fabsf(g0); l1b += fabsf(g1); } else d[fphys(SEQ)] = (f32x2){0.f, 0.f};
            l1a += fabsf(f0); l1b += fabsf(f1); }
        l1a = block_sum(l1a, xs + 128, F.wave, F.lane);
        l1b = block_sum(l1b, xs + 144, F.wave, F.lane);
        const float sca = 0.5f / (l1a * (float)NFFT), scb = 0.5f / (l1b * (float)NFFT);
        fft_fwd(d, TW, F.tid);
        f32x2* outa = HF + ((size_t)(l * 2 + 0) * 256 + c) * NFFT; f32x2* outb = HF + ((size_t)(l * 2 + 1) * 256 + c) * NFFT;
#pragma unroll 4
        for (int i = F.tid; i < NFFT; i += NTHR) { const int k = (int)(__brev((unsigned)i) >> 18), kp = (NFFT - k) & (NFFT - 1), ip = (int)(__brev((unsigned)kp) >> 18);
            const f32x2 v = d[fphys(i)], w = d[fphys(ip)];
            outa[i] = (f32x2){(v.x + w.x) * sca, (v.y - w.y) * sca};
            outb[i] = (f32x2){(v.y + w.y) * scb, (w.x - v.x) * scb}; }
    }
}

struct Row { f32x4 v[4]; };
__device__ __forceinline__ Row row_load(const float* p, int lane) { Row r; const f32x4* q = (const f32x4*)p + lane;
#pragma unroll
    for (int j = 0; j < 4; ++j) r.v[j] = q[64 * j];
    return r; }
__device__ __forceinline__ Row row_load_bf16(const bf16* p, int lane) { Row r; const unsigned long long* q = (const unsigned long long*)p + lane;
#pragma unroll
    for (int j = 0; j < 4; ++j) { const unsigned long long w = q[64 * j]; const unsigned lo = (unsigned)w, hi = (unsigned)(w >> 32); r.v[j] = (f32x4){bflo(lo), bfhi(lo), bflo(hi), bfhi(hi)}; }
    return r; }
__device__ __forceinline__ void row_store_fp8(unsigned char* p, const Row& r, int lane) { unsigned* q = (unsigned*)p + lane;
#pragma unroll
    for (int j = 0; j < 4; ++j) st4(q + 64 * j, pk4_fp8(r.v[j].x, r.v[j].y, r.v[j].z, r.v[j].w)); }
__device__ __forceinline__ void row_store(float* p, const Row& r, int lane) { f32x4* q = (f32x4*)p + lane;
#pragma unroll
    for (int j = 0; j < 4; ++j) st16(q + 64 * j, __builtin_bit_cast(v4u, r.v[j])); }
__device__ __forceinline__ void row_store_bf16(bf16* p, const Row& r, int lane) { unsigned long long* q = (unsigned long long*)p + lane;
#pragma unroll
    for (int j = 0; j < 4; ++j) st8(q + 64 * j, (unsigned long long)pk2(r.v[j].x, r.v[j].y) | ((unsigned long long)pk2(r.v[j].z, r.v[j].w) << 32)); }
__device__ __forceinline__ Row row_load_lds(const LAS float* p, int lane) { Row r; const LAS f32x4* q = (const LAS f32x4*)p + lane;
#pragma unroll
    for (int j = 0; j < 4; ++j) r.v[j] = q[64 * j];
    return r; }
constexpr int LNPV_OFF = 65536;
__device__ __forceinline__ const LAS float* ln_pv(const Fr& F, int row, int k) { const int b = row / SB, s = row % SB; return (const LAS float*)(F.lds + RING_OFF + LNPV_OFF) + ((s < SEQ ? b : 2) * 5 + k) * DM; }
__device__ __forceinline__ void ln_pv_fill(const Fr& F, int k, const float* v0, const float* v1, const float* v2) {
    LAS float* pv = (LAS float*)(F.lds + RING_OFF + LNPV_OFF);
    for (int i = F.tid; i < DM; i += NTHR) { pv[(0 * 5 + k) * DM + i] = v0[i]; pv[(1 * 5 + k) * DM + i] = v1[i]; pv[(2 * 5 + k) * DM + i] = v2[i]; }
}
__device__ __forceinline__ void row_norm(Row& r) {
    float s = 0.f;
#pragma unroll
    for (int j = 0; j < 4; ++j) s += (r.v[j].x + r.v[j].y) + (r.v[j].z + r.v[j].w);
    const float mean = wave_sum(s) * (1.f / DM); float s2 = 0.f;
#pragma unroll
    for (int j = 0; j < 4; ++j) { r.v[j] = r.v[j] - mean; s2 += (r.v[j].x * r.v[j].x + r.v[j].y * r.v[j].y) + (r.v[j].z * r.v[j].z + r.v[j].w * r.v[j].w); }
    const float rstd = 1.f / sqrtf(wave_sum(s2) * (1.f / DM) + LN_EPS);
#pragma unroll
    for (int j = 0; j < 4; ++j) r.v[j] = r.v[j] * rstd;
}
__device__ __forceinline__ void row_mod_lds(Row& r, const LAS float* shift, const LAS float* scale, int lane) {
    const Row sh = row_load_lds(shift, lane), sc = row_load_lds(scale, lane);
#pragma unroll
    for (int j = 0; j < 4; ++j) r.v[j] = r.v[j] * (sc.v[j] + 1.f) + sh.v[j];
}
__device__ __forceinline__ void row_affine_lds(Row& r, const LAS float* w, const LAS float* b, int lane) {
    const Row ww = row_load_lds(w, lane), bb = row_load_lds(b, lane);
#pragma unroll
    for (int j = 0; j < 4; ++j) r.v[j] = r.v[j] * ww.v[j] + bb.v[j];
}
__device__ __forceinline__ void row_dot16x2(const Row& ra, const Row& rb, const LAS float* W16, int lane, float& da, float& db) {
    f32x2 p[16];
#pragma unroll
    for (int e = 0; e < 16; ++e) { const LAS f32x4* w = (const LAS f32x4*)(W16 + e * DM) + lane; f32x2 a = {0.f, 0.f};
#pragma unroll
        for (int j = 0; j < 4; ++j) { const f32x4 x = w[64 * j];
            a += (f32x2){ra.v[j].x, rb.v[j].x} * x.x; a += (f32x2){ra.v[j].y, rb.v[j].y} * x.y; a += (f32x2){ra.v[j].z, rb.v[j].z} * x.z; a += (f32x2){ra.v[j].w, rb.v[j].w} * x.w; }
        p[e] = a; }
    const bool b0 = (lane & 1) != 0, b1 = (lane & 2) != 0;
    float res[2];
#pragma unroll
    for (int c = 0; c < 2; ++c) {
        float q[8];
#pragma unroll
        for (int i = 0; i < 8; ++i) { const float keep = b0 ? p[2 * i + 1][c] : p[2 * i][c], send = b0 ? p[2 * i][c] : p[2 * i + 1][c]; q[i] = keep + dppf<0xB1>(send); }
        float t[4];
#pragma unroll
        for (int i = 0; i < 4; ++i) { const float keep = b1 ? q[2 * i + 1] : q[2 * i], send = b1 ? q[2 * i] : q[2 * i + 1]; t[i] = keep + dppf<0x4E>(send); }
#pragma unroll
        for (int i = 0; i < 4; ++i) { t[i] += dppf<0x124>(t[i]); t[i] += dppf<0x128>(t[i]); t[i] += __shfl_xor(t[i], 16); t[i] += __shfl_xor(t[i], 32); }
        const int sel = (lane >> 2) & 3;
        res[c] = sel == 0 ? t[0] : (sel == 1 ? t[1] : (sel == 2 ? t[2] : t[3]));
    }
    da = res[0]; db = res[1];
}
__device__ __forceinline__ const float* row_input(const Args& A, int l, int row) {
    if (l > 0) return (const float*)(A.ws + WS_XS2) + (size_t)row * DM;
    const int b = row / SB, s = row % SB;
    return s < SEQ ? A.in[0] + ((size_t)b * SEQ + s) * DM : A.in[2] + ((size_t)b * CTXL + (s - SEQ)) * DM;
}
__device__ __forceinline__ Row ln_a_head(const Fr& F, const Args& A, int row, Row r, int lane) {
    row_norm(r); row_mod_lds(r, ln_pv(F, row, 3), ln_pv(F, row, 4), lane);
    row_store_bf16((bf16*)(A.ws + WS_HN) + (size_t)row * DM, r, lane);
    return r;
}
__device__ __forceinline__ void ph_ln_a0(const Fr& F, const Args& A) {
    BSYNC();
    { const float* M = (const float*)(A.ws + WS_MOD); ln_pv_fill(F, 3, M, M + 6144, M + 2 * 6144); ln_pv_fill(F, 4, M + DM, M + 6144 + DM, M + 2 * 6144 + DM); BSYNC(); }
    const int gw = F.bid * NWAVES + F.wave, NGW = F.G * NWAVES;
    for (int row = gw; row < MT; row += 2 * NGW) { asm volatile("" ::: "memory");
        const int row2 = row + NGW < MT ? row + NGW : row;
        (void)ln_a_head(F, A, row, row_load(row_input(A, 0, row), F.lane), F.lane); if (row2 != row) (void)ln_a_head(F, A, row2, row_load(row_input(A, 0, row2), F.lane), F.lane); }
}
__device__ __forceinline__ void ph_ln_b(const Fr& F, const Args& A, int l) {
    LAS float* RW = (LAS float*)(F.lds + RING_OFF);
    BSYNC();
    for (int i = F.tid; i < 16 * DM; i += NTHR) { const int e = i >> 10, k = i & 1023; RW[i] = A.in[25][((size_t)l * DM + k) * 16 + e]; }
    { const float* M = (const float*)(A.ws + WS_MOD) + (size_t)l * 3 * 6144; const float* w = A.in[23] + l * DM; const float* bb = A.in[24] + l * DM;
      ln_pv_fill(F, 0, M + 2 * DM, M + 6144 + 2 * DM, M + 2 * 6144 + 2 * DM); ln_pv_fill(F, 1, w, w, w); ln_pv_fill(F, 2, bb, bb, bb);
      ln_pv_fill(F, 3, M + 3 * DM, M + 6144 + 3 * DM, M + 2 * 6144 + 3 * DM); ln_pv_fill(F, 4, M + 4 * DM, M + 6144 + 4 * DM, M + 2 * 6144 + 4 * DM); }
    BSYNC();
    const int gw = F.bid * NWAVES + F.wave, NGW = F.G * NWAVES; const bool last = (l == DEPTH - 1);
    const int NR = last ? NB * SEQ : MT;
#define LNROW(i_) (last ? (i_) + ((i_) >= SEQ ? CTXL : 0) : (i_))
    for (int idx = gw; idx < NR; idx += 2 * NGW) {
        asm volatile("" ::: "memory");
        const int rows[2] = {LNROW(idx), idx + NGW < NR ? LNROW(idx + NGW) : LNROW(idx)};
        Row h[2];
#pragma unroll
        for (int c = 0; c < 2; ++c) { const int row = rows[c];
            Row r = row_load(row_input(A, l, row), F.lane); const Row mx = row_load_bf16((const bf16*)(A.ws + WS_MIX) + (size_t)row * DM, F.lane), g1 = row_load_lds(ln_pv(F, row, 0), F.lane);
#pragma unroll
            for (int j = 0; j < 4; ++j) r.v[j] = r.v[j] * ALPHA + g1.v[j] * mx.v[j];
            row_norm(r); row_affine_lds(r, ln_pv(F, row, 1), ln_pv(F, row, 2), F.lane);
            row_store((float*)(A.ws + WS_XS) + (size_t)row * DM, r, F.lane);
            row_norm(r); row_mod_lds(r, ln_pv(F, row, 3), ln_pv(F, row, 4), F.lane);
            row_store_fp8((unsigned char*)(A.ws + WS_HN) + (size_t)row * DM, r, F.lane);
            h[c] = r; }
        float lgs[2]; row_dot16x2(h[0], h[1], RW, F.lane, lgs[0], lgs[1]);
#pragma unroll
        for (int c = 0; c < 2; ++c) { const int row = rows[c]; const int b = row / SB, s = row % SB;
            const float lg = lgs[c] + A.in[26][l * 16 + (F.lane & 15)];
            float mxv = lg;
#pragma unroll
            for (int o = 1; o < 16; o <<= 1) mxv = fmaxf(mxv, __shfl_xor(mxv, o));
            const float ex = expf(lg - mxv); float sm = ex;
#pragma unroll
            for (int o = 1; o < 16; o <<= 1) sm += __shfl_xor(sm, o);
            if (F.lane < 16) ((float*)(A.ws + WS_AFF))[((size_t)b * 16 + F.lane) * SB + s] = ex / sm; }
    }
#undef LNROW
}
__device__ __forceinline__ void ph_ln_c(const Fr& F, const Args& A, int l) {
    const bool last = (l == DEPTH - 1);
    { const float* M = (const float*)(A.ws + WS_MOD) + (size_t)l * 3 * 6144; const float* w = A.in[30] + l * DM; const float* bb = A.in[31] + l * DM; BSYNC();
      ln_pv_fill(F, 0, M + 5 * DM, M + 6144 + 5 * DM, M + 2 * 6144 + 5 * DM); ln_pv_fill(F, 1, w, w, w); ln_pv_fill(F, 2, bb, bb, bb);
      if (!last) { const float* M1 = M + 3 * 6144; ln_pv_fill(F, 3, M1, M1 + 6144, M1 + 2 * 6144); ln_pv_fill(F, 4, M1 + DM, M1 + 6144 + DM, M1 + 2 * 6144 + DM); }
      BSYNC(); }
    const int gw = F.bid * NWAVES + F.wave, NGW = F.G * NWAVES;
    const int* INV = (const int*)(A.ws + WS_INV); const float* VAL = (const float*)(A.ws + WS_VAL); const bf16* YE = (const bf16*)(A.ws + WS_YE);
    const int NR = last ? NB * SEQ : MT;
#define LNROW(i_) (last ? (i_) + ((i_) >= SEQ ? CTXL : 0) : (i_))
    for (int idx = gw; idx < NR; idx += 2 * NGW) {
        asm volatile("" ::: "memory");
        const int rows[2] = {LNROW(idx), idx + NGW < NR ? LNROW(idx + NGW) : LNROW(idx)};
        Row h[2];
#pragma unroll
        for (int c = 0; c < 2; ++c) { const int row = rows[c]; const int b = row / SB, s = row % SB;
            const int myinv = (F.lane < 16) ? INV[(size_t)row * 16 + F.lane] : 0;
            Row f;
#pragma unroll
            for (int j = 0; j < 4; ++j) f.v[j] = (f32x4){0.f, 0.f, 0.f, 0.f};
            for (int e = 0; e < 16; ++e) { const int r1 = __builtin_amdgcn_readlane(myinv, e);
                if (r1 != 0) { const size_t rr = (size_t)e * ROWS_E + (r1 - 1); const float val = VAL[rr]; const Row y = row_load_bf16(YE + rr * DM, F.lane);
#pragma unroll
                    for (int j = 0; j < 4; ++j) f.v[j] += y.v[j] * val; } }
            Row r = row_load((const float*)(A.ws + WS_XS) + (size_t)row * DM, F.lane); const Row g2 = row_load_lds(ln_pv(F, row, 0), F.lane);
#pragma unroll
            for (int j = 0; j < 4; ++j) r.v[j] = r.v[j] * ALPHA + g2.v[j] * f.v[j];
            row_norm(r); row_affine_lds(r, ln_pv(F, row, 1), ln_pv(F, row, 2), F.lane);
            if (last) row_store(A.out + ((size_t)b * SEQ + s) * DM, r, F.lane);
            else { row_store((float*)(A.ws + WS_XS2) + (size_t)row * DM, r, F.lane); (void)ln_a_head(F, A, row, r, F.lane); } }
    }
#undef LNROW
}

struct EpiWin {
    static constexpr bool PERM = true, AFTER_DRAIN = false;
    bf16* P1; float* HY; float* GT;
    __device__ __forceinline__ void operator()(const pg8::f32x4 (&acc)[2][2][4][2], const pg8::Unit& u, int wr, int wc, int fr, int fq) const {
        const int row0 = u.pm * 256 + wr * 64 + fr;
        if (u.pn == 10) {
            if (wc == 0 && fq < 2) {
#pragma unroll
                for (int ai = 0; ai < 2; ++ai)
#pragma unroll
                    for (int m = 0; m < 4; ++m) { float* gp = GT + (size_t)(row0 + ai * 128 + m * 16) * 16 + 8 * fq; *(pg8::f32x4*)gp = acc[ai][0][m][0]; *(pg8::f32x4*)(gp + 4) = acc[ai][0][m][1]; } }
        } else if (u.pn < 7) {
            const int col0 = u.pn * 256 + wc * 32 + 8 * fq;
#pragma unroll
            for (int ai = 0; ai < 2; ++ai)
#pragma unroll
                for (int m = 0; m < 4; ++m) { bf16* rowp = P1 + (size_t)(row0 + ai * 128 + m * 16) * NP1 + col0;
#pragma unroll
                    for (int bj = 0; bj < 2; ++bj) { const pg8::f32x4 v0 = acc[ai][bj][m][0], v1 = acc[ai][bj][m][1]; pg8::u32x4 w;
                        w.x = pg8::cvt_pk_bf16(v0[0], v0[1]); w.y = pg8::cvt_pk_bf16(v0[2], v0[3]); w.z = pg8::cvt_pk_bf16(v1[0], v1[1]); w.w = pg8::cvt_pk_bf16(v1[2], v1[3]);
                        st16(rowp + bj * 128, __builtin_bit_cast(v4u, w)); } }
        } else {
            const int b = u.pm / 33, s0 = (u.pm % 33) * 256 + wr * 64 + fr; const int ch0 = (u.pn - 7) * 256 + wc * 32 + 8 * fq;
            float* base = HY + (size_t)b * 768 * SB;
#pragma unroll
            for (int ai = 0; ai < 2; ++ai)
#pragma unroll
                for (int m = 0; m < 4; ++m) { const int s = s0 + ai * 128 + m * 16;
#pragma unroll
                    for (int bj = 0; bj < 2; ++bj)
#pragma unroll
                        for (int n = 0; n < 2; ++n)
#pragma unroll
                            for (int i = 0; i < 4; ++i) st4(base + (size_t)(ch0 + bj * 128 + 4 * n + i) * SB + s, __float_as_uint(acc[ai][bj][m][n][i])); }
        }
    }
};
struct EpiF32g {
    static constexpr bool PERM = false, AFTER_DRAIN = false;
    float* C; int ldc; int ntn;
    __device__ __forceinline__ void operator()(const pg8::f32x4 (&acc)[2][2][4][2], const pg8::Unit& u, int wr, int wc, int fr, int fq) const {
        const int row0 = u.pm * 256 + wr * 64 + fr, col0 = (u.pn % ntn) * 256 + wc * 32 + 4 * fq;
#pragma unroll
        for (int ai = 0; ai < 2; ++ai)
#pragma unroll
            for (int m = 0; m < 4; ++m) { float* rowp = C + (size_t)(row0 + ai * 128 + m * 16) * ldc + col0;
#pragma unroll
                for (int bj = 0; bj < 2; ++bj)
#pragma unroll
                    for (int n = 0; n < 2; ++n) *(pg8::f32x4*)(rowp + bj * 128 + n * 16) = acc[ai][bj][m][n]; }
    }
};
struct EpiBf16g {
    static constexpr bool PERM = true, AFTER_DRAIN = false;
    bf16* O; int ldc; int ntn;
    __device__ __forceinline__ void operator()(const pg8::f32x4 (&acc)[2][2][4][2], const pg8::Unit& u, int wr, int wc, int fr, int fq) const {
        const int row0 = u.pm * 256 + wr * 64 + fr, col0 = (u.pn % ntn) * 256 + wc * 32 + 8 * fq;
#pragma unroll
        for (int ai = 0; ai < 2; ++ai)
#pragma unroll
            for (int m = 0; m < 4; ++m) { bf16* rowp = O + (size_t)(row0 + ai * 128 + m * 16) * ldc + col0;
#pragma unroll
                for (int bj = 0; bj < 2; ++bj) { const pg8::f32x4 v0 = acc[ai][bj][m][0], v1 = acc[ai][bj][m][1]; pg8::u32x4 w;
                    w.x = pg8::cvt_pk_bf16(v0[0], v0[1]); w.y = pg8::cvt_pk_bf16(v0[2], v0[3]); w.z = pg8::cvt_pk_bf16(v1[0], v1[1]); w.w = pg8::cvt_pk_bf16(v1[2], v1[3]);
                    st16(rowp + bj * 128, __builtin_bit_cast(v4u, w)); } }
    }
};
struct EpiSwiglu {
    static constexpr bool PERM = true, AFTER_DRAIN = false;
    unsigned char* ACT;
    __device__ __forceinline__ void operator()(const pg8::f32x4 (&acc)[2][2][4][2], const pg8::Unit& u, int wr, int wc, int fr, int fq) const {
        const int row0 = u.pm * 256 + wr * 64 + fr, col0 = (u.pn % NT1) * 128 + wc * 32 + 8 * fq;
#pragma unroll
        for (int ai = 0; ai < 2; ++ai)
#pragma unroll
            for (int m = 0; m < 4; ++m) { float o[8];
#pragma unroll
                for (int n = 0; n < 2; ++n)
#pragma unroll
                    for (int i = 0; i < 4; ++i) { const float g = acc[ai][0][m][n][i], uu = acc[ai][1][m][n][i]; o[4 * n + i] = g * __builtin_amdgcn_rcpf(1.f + __builtin_amdgcn_exp2f(g * -1.44269504088896341f)) * uu; }
                st8(ACT + (size_t)(row0 + ai * 128 + m * 16) * FF + col0, (unsigned long long)pk4_fp8(o[0], o[1], o[2], o[3]) | ((unsigned long long)pk4_fp8(o[4], o[5], o[6], o[7]) << 32)); }
    }
};
struct OrderBase { __device__ __forceinline__ void a_ready(const pg8::Unit&) const {} __device__ __forceinline__ void done(const pg8::Unit&) const {} };
struct GroupOrder : OrderBase { int nMe, nN, G, c;
    __device__ __forceinline__ bool next(int i, pg8::Unit& u) const {
        if ((G & 7) == 0) { const int xcd = c & 7, j = (c >> 3) + (G >> 3) * i; const int tl = j / nMe, mt = j - tl * nMe; if (tl >= 2 * nN) return false; const int e = xcd + 8 * (tl / nN), nt = tl % nN;
            u.pm = e * 9 + mt; u.pn = e * nN + nt; return true; }
        const int L = i * G + c, per = nMe * nN; if (L >= NE * per) return false; const int e = L / per, r = L % per; u.pm = e * 9 + r % nMe; u.pn = e * nN + r / nMe; return true; } };
struct WoutOrder : OrderBase { int ntile, skipctx, G, c;
    __device__ __forceinline__ bool next(int i, pg8::Unit& u) const { const int L = i * G + c; if (L >= ntile * 4) return false; int t = L >> 2; if (skipctx) t += (t >= 32); u.pm = t; u.pn = L & 3; return true; } };

__device__ __forceinline__ void prep8(const bf16* p, bf16* dst, const float* wv  , bool rope, const f32x2* rp  , bool hi_half) {
    const v4u x = *(const v4u*)p; float v[8] = {bflo(x.x), bfhi(x.x), bflo(x.y), bfhi(x.y), bflo(x.z), bfhi(x.z), bflo(x.w), bfhi(x.w)};
    float ss = 0.f;
#pragma unroll
    for (int i = 0; i < 8; ++i) ss += v[i] * v[i];
    ss += dppf<0xB1>(ss); ss += dppf<0x4E>(ss); ss += dppf<0x141>(ss);
    const float rs = 1.f / sqrtf(ss * (1.f / 64.f) + RMS_EPS);
#pragma unroll
    for (int i = 0; i < 8; ++i) v[i] = v[i] * rs * wv[i];
    if (rope) {
#pragma unroll
        for (int i = 0; i < 8; ++i) { const float partner = dppf<0x4E>(v[i]); const f32x2 cs = rp[i]; v[i] = v[i] * cs.x + (hi_half ? partner : -partner) * cs.y; }
    }
    *(v4u*)dst = (v4u){pk2(v[0], v[1]), pk2(v[2], v[3]), pk2(v[4], v[5]), pk2(v[6], v[7])};
}
__device__ __forceinline__ void ph_attn_prep(const Fr& F, const Args& A, int l) {
    const bf16* P1 = (const bf16*)(A.ws + WS_P1); bf16* QKP = (bf16*)(A.ws + WS_QKP); const f32x2* ROPE = (const f32x2*)(A.ws + WS_ROPE);
    const int gw = F.bid * NWAVES + F.wave, NGW = F.G * NWAVES;
    const int d0 = (F.lane & 7) * 8;
    float qw[8], kw[8];
#pragma unroll
    for (int i = 0; i < 8; ++i) { qw[i] = A.in[11][l * 64 + d0 + i] * attn_body::C2; kw[i] = A.in[12][l * 64 + d0 + i]; }
    const bool hi_half = ((d0 >> 4) & 1) != 0; const bool lastl = (l == DEPTH - 1);
    for (int row = gw; row < MT; row += NGW) {
        const int s = row % SB; const bool lat = s < SEQ;
        const int pos = (d0 < 32) ? (s >> 6) : (s & 63);
        const f32x2* rp = ROPE + (lat ? pos : 0) * 16 + (F.lane & 1) * 8;
        const bf16* rowp = P1 + (size_t)row * NP1; bf16* dstp = QKP + (size_t)row * NQK;
        if (lat || !lastl) prep8(rowp + C_AQ + F.lane * 8, dstp + F.lane * 8, qw, lat, rp, hi_half);
        if (F.lane < 16) prep8(rowp + C_AK + (F.lane & 15) * 8, dstp + 512 + (F.lane & 15) * 8, kw, lat, rp, hi_half);
    }
}

typedef short s16x8 __attribute__((ext_vector_type(8)));
template <int CTRL> __device__ __forceinline__ float dpp_keep(float ident, float v) { return __builtin_bit_cast(float, __builtin_amdgcn_update_dpp(__builtin_bit_cast(int, ident), __builtin_bit_cast(int, v), CTRL, 0xf, 0xf, false)); }
__device__ __forceinline__ float wave_scan_add(float v, int lane) {
    v += dpp_keep<0x111>(0.f, v); v += dpp_keep<0x112>(0.f, v); v += dpp_keep<0x114>(0.f, v); v += dpp_keep<0x118>(0.f, v);
    const float r0 = rlanef(v, 15), r1 = rlanef(v, 31), r2 = rlanef(v, 47); const int row = lane >> 4;
    return v + (row == 0 ? 0.f : (row == 1 ? r0 : (row == 2 ? r0 + r1 : (r0 + r1) + r2)));
}
__device__ __forceinline__ float wave_scan_max(float v, int lane) {
    const float NI = -INFINITY;
    v = fmaxf(v, dpp_keep<0x111>(NI, v)); v = fmaxf(v, dpp_keep<0x112>(NI, v)); v = fmaxf(v, dpp_keep<0x114>(NI, v)); v = fmaxf(v, dpp_keep<0x118>(NI, v));
    const float r0 = rlanef(v, 15), r1 = rlanef(v, 31), r2 = rlanef(v, 47); const int row = lane >> 4;
    return fmaxf(v, row == 0 ? NI : (row == 1 ? r0 : (row == 2 ? fmaxf(r0, r1) : fmaxf(fmaxf(r0, r1), r2))));
}
__device__ __forceinline__ float logsigmoidf_(float x) { return fminf(x, 0.f) - log1pf(expf(-fabsf(x))); }
__device__ __forceinline__ int mpos(int dir, int blk) { return dir == 0 ? (blk >= 64 ? blk - 64 : blk + 2) : (blk >= 64 ? 65 - blk : 65 - blk); }
__device__ __forceinline__ void gate_scan(const Args& A, int l, int row0, int dir, int h, LAS float* BC, LAS float* GG, LAS float* PM, int lane) {
    const float* GT = (const float*)(A.ws + WS_GT); const float bi = A.in[9][((l * 2 + dir) * 2 + 0) * 4 + h], bfg = A.in[9][((l * 2 + dir) * 2 + 1) * 4 + h];
    const int o0 = 2 * lane, o1 = 2 * lane + 1; const int t0 = dir ? 127 - o0 : o0, t1 = dir ? 127 - o1 : o1;
    const float li0 = GT[(size_t)(row0 + t0) * 16 + dir * 8 + h] + bi, li1 = GT[(size_t)(row0 + t1) * 16 + dir * 8 + h] + bi;
    const float lf0 = logsigmoidf_(GT[(size_t)(row0 + t0) * 16 + dir * 8 + 4 + h] + bfg), lf1 = logsigmoidf_(GT[(size_t)(row0 + t1) * 16 + dir * 8 + 4 + h] + bfg);
    const float S = wave_scan_add(lf0 + lf1, lane); const float b0 = S - lf1, b1 = S;
    const float g0 = li0 - b0, g1 = li1 - b1;
    const float M = wave_scan_max(fmaxf(g0, g1), lane); float Mprev = __shfl_up(M, 1); if (lane == 0) Mprev = -INFINITY;
    BC[t0] = b0; BC[t1] = b1; GG[t0] = g0; GG[t1] = g1; PM[t0] = fmaxf(Mprev, g0); PM[t1] = M;
}
__device__ __forceinline__ void qk_conv8(const bf16* P1, const float* cw  , const float* cb, int row, int seq_lo, int seq_hi, int ch, float scale, float (&o)[8]) {
    const v4u z = {0u, 0u, 0u, 0u};
    const v4u xm = (row - 1 >= seq_lo) ? *(const v4u*)(P1 + (size_t)(row - 1) * NP1 + ch) : z;
    const v4u x0 = *(const v4u*)(P1 + (size_t)row * NP1 + ch);
    const v4u xp = (row + 1 < seq_hi) ? *(const v4u*)(P1 + (size_t)(row + 1) * NP1 + ch) : z;
    const f32x4 w0a = *(const f32x4*)(cw + ch), w0b = *(const f32x4*)(cw + ch + 4), w1a = *(const f32x4*)(cw + 512 + ch), w1b = *(const f32x4*)(cw + 512 + ch + 4), w2a = *(const f32x4*)(cw + 1024 + ch), w2b = *(const f32x4*)(cw + 1024 + ch + 4);
    const f32x4 ba = *(const f32x4*)(cb + ch), bb = *(const f32x4*)(cb + ch + 4);
    const unsigned am[4] = {xm.x, xm.y, xm.z, xm.w}, a0[4] = {x0.x, x0.y, x0.z, x0.w}, ap[4] = {xp.x, xp.y, xp.z, xp.w};
#pragma unroll
    for (int i = 0; i < 4; ++i) {
        const float wl0 = i < 2 ? w0a[2 * i] : w0b[2 * i - 4], wh0 = i < 2 ? w0a[2 * i + 1] : w0b[2 * i - 3];
        const float wl1 = i < 2 ? w1a[2 * i] : w1b[2 * i - 4], wh1 = i < 2 ? w1a[2 * i + 1] : w1b[2 * i - 3];
        const float wl2 = i < 2 ? w2a[2 * i] : w2b[2 * i - 4], wh2 = i < 2 ? w2a[2 * i + 1] : w2b[2 * i - 3];
        const float bl = i < 2 ? ba[2 * i] : bb[2 * i - 4], bh = i < 2 ? ba[2 * i + 1] : bb[2 * i - 3];
        const float ul = bl + wl0 * bflo(am[i]) + wl1 * bflo(a0[i]) + wl2 * bflo(ap[i]);
        const float uh = bh + wh0 * bfhi(am[i]) + wh1 * bfhi(a0[i]) + wh2 * bfhi(ap[i]);
        o[2 * i] = siluf_(ul) * scale; o[2 * i + 1] = siluf_(uh) * scale;
    }
}
constexpr int ML_QT = 0, ML_KN = 18432, ML_AP = 36864, ML_BTP = 88064, ML_VEC = 113664;
constexpr int ML_VT = 36864, ML_KT = 36864 + 26112;
__device__ __forceinline__ void ph_mlstm_local(const Fr& F, const Args& A, int l) {
    const bf16* P1 = (const bf16*)(A.ws + WS_P1); float* SLOC = (float*)(A.ws + WS_SLOC);
    LAS unsigned char* L = F.lds + RING_OFF;
    LAS unsigned short* VT = (LAS unsigned short*)(L + ML_VT); LAS unsigned short* KT = (LAS unsigned short*)(L + ML_KT);
    LAS float* BC = (LAS float*)(L + ML_VEC); LAS float* GG = BC + 256; LAS float* PM = GG + 256; LAS float* WW = PM + 256;
    const float* cw = A.in[7] + (size_t)l * 3 * 512; const float* cb = A.in[8] + l * 512;
    for (int u = F.bid; u < NB * 4 * NPOS; u += F.G) {
        const int b = u / (4 * NPOS), h = (u / NPOS) & 3, blk = u % NPOS;
        const int row0 = b * SB + blk * 128; const int seq_lo = blk < 64 ? b * SB : b * SB + SEQ, seq_hi = blk < 64 ? b * SB + SEQ : (b + 1) * SB;
        BSYNC();
        if (F.wave < 2) gate_scan(A, l, row0, F.wave, h, BC + F.wave * 128, GG + F.wave * 128, PM + F.wave * 128, F.lane);
#pragma unroll
        for (int it = 0; it < 2; ++it) { const int idx = F.tid + it * NTHR, t = idx >> 3, c8 = idx & 7; float o[8];
            qk_conv8(P1, cw, cb, row0 + t, seq_lo, seq_hi, C_MK + h * 64 + c8 * 8, 1.f, o);
#pragma unroll
            for (int i = 0; i < 8; ++i) KT[(c8 * 8 + i) * 136 + t] = (unsigned short)f2bf(o[i]); }
        BSYNC();
        for (int dir = 0; dir < 2; ++dir) {
            const float pmall = dir ? PM[128 + 0] : PM[127];
            const float atot = dir ? BC[128 + 0] : BC[127];
            if (F.tid < 128) { const float wv = fexp(GG[dir * 128 + F.tid] - pmall); WW[dir * 128 + F.tid] = wv; VT[64 * 136 + F.tid] = (unsigned short)f2bf(wv); }
            BSYNC();
#pragma unroll
            for (int it = 0; it < 2; ++it) { const int idx = F.tid + it * NTHR, t = idx >> 3, c8 = idx & 7; const float w = WW[dir * 128 + t];
                const v4u x = *(const v4u*)(P1 + (size_t)(row0 + t) * NP1 + C_MV + h * 64 + c8 * 8); const unsigned xa[4] = {x.x, x.y, x.z, x.w};
#pragma unroll
                for (int i = 0; i < 4; ++i) { VT[(c8 * 8 + 2 * i) * 136 + t] = (unsigned short)f2bf(w * bflo(xa[i])); VT[(c8 * 8 + 2 * i + 1) * 136 + t] = (unsigned short)f2bf(w * bfhi(xa[i])); } }
            BSYNC();
            const int stream = (dir * 2 + b) * 4 + h, p = mpos(dir, blk);
            float* rec = SLOC + ((size_t)stream * NPOS + p) * SST;
            if (F.wave < 6) {
                const int be = F.wave >> 1, bd = F.wave & 1, r = F.lane & 31, hh = F.lane >> 5; f32x16 acc = {};
#pragma unroll
                for (int kk = 0; kk < 8; ++kk) { const s16x8 a = *(const LAS s16x8*)(VT + (be * 32 + r) * 136 + kk * 16 + hh * 8), bb = *(const LAS s16x8*)(KT + (bd * 32 + r) * 136 + kk * 16 + hh * 8);
                    acc = __builtin_amdgcn_mfma_f32_32x32x16_bf16(a, bb, acc, 0, 0, 0); }
                if (be < 2) {
#pragma unroll
                    for (int g = 0; g < 16; ++g) { const int e = be * 32 + (g & 3) + 8 * (g >> 2) + 4 * hh; rec[e * 64 + bd * 32 + r] = acc[g]; }
                } else if (hh == 0) rec[4096 + bd * 32 + r] = acc[0];
            } else if (F.wave == 6 && F.lane == 0) { rec[4160] = atot; rec[4161] = atot + pmall; }
            BSYNC();
        }
    }
}
__device__ __forceinline__ void ph_mlstm_carry(const Fr& F, const Args& A) {
    const float* __restrict__ SLOC = (const float*)(A.ws + WS_SLOC); float* __restrict__ SCAR = (float*)(A.ws + WS_SCAR);
    const int vb = F.G - 1 - F.bid; const int gid = vb * NTHR + F.tid, NG = F.G * NTHR;
    for (int i = gid; i < 16 * 4160; i += NG) {
        const int stream = i / 4160, el = i % 4160; float m = 0.f, val = 0.f;
        const float* __restrict__ sl = SLOC + (size_t)stream * NPOS * SST; float* __restrict__ sc = SCAR + (size_t)stream * NPOS * SST;
#pragma unroll 1
        for (int p0 = 0; p0 < NPOS; p0 += 6) {
            float a[6], ml[6], dl[6];
#pragma unroll
            for (int q = 0; q < 6; ++q) { const size_t o = (size_t)(p0 + q) * SST; a[q] = sl[o + 4160]; ml[q] = sl[o + 4161]; dl[q] = sl[o + el]; }
#pragma unroll
            for (int q = 0; q < 6; ++q) { const size_t o = (size_t)(p0 + q) * SST;
                sc[o + el] = val; if (el == 0) sc[o + 4160] = m;
                const float mn = fmaxf(a[q] + m, ml[q]);
                val = fexp(a[q] + m - mn) * val + fexp(ml[q] - mn) * dl[q]; m = mn; }
        }
    }
}
constexpr int M3_QT = 0, M3_KN = 18432, M3_AP = 36864, M3_VT = 88064, M3_C0 = 105472, M3_VEC = 123904;
__device__ __forceinline__ void ph_mlstm_out(const Fr& F, const Args& A, int l, int u_lo, int u_hi, int boff) {
    const bf16* P1 = (const bf16*)(A.ws + WS_P1); const float* SCAR = (const float*)(A.ws + WS_SCAR); const float* SLOC = (const float*)(A.ws + WS_SLOC); bf16* Y = (bf16*)(A.ws + WS_Y);
    LAS unsigned char* L = F.lds + RING_OFF;
    LAS unsigned short* QT = (LAS unsigned short*)(L + M3_QT); LAS unsigned short* KN = (LAS unsigned short*)(L + M3_KN);
    LAS unsigned short* AP = (LAS unsigned short*)(L + M3_AP); LAS unsigned short* VT = (LAS unsigned short*)(L + M3_VT); LAS unsigned short* C0B = (LAS unsigned short*)(L + M3_C0);
    LAS float* BC = (LAS float*)(L + M3_VEC); LAS float* GG = BC + 256; LAS float* PM = GG + 256;
    LAS float* MM = PM + 256; LAS float* WI = MM + 256; LAS float* DEN = WI + 256; LAS float* N0 = DEN + 256; LAS float* SS = N0 + 128; LAS float* M0 = SS + 512;
    const float* cw = A.in[7] + (size_t)l * 3 * 512; const float* cb = A.in[8] + l * 512;
    const int r = F.lane & 31, hh = F.lane >> 5;
    for (int u = u_lo + ((F.bid + F.G - boff) % F.G); u < u_hi; u += F.G) {
        int b, h, blk;
        if (u < 512) { b = u >> 8; h = (u >> 6) & 3; blk = u & 63; } else { const int v = u - 512; b = v >> 3; h = (v >> 1) & 3; blk = 64 + (v & 1); }
        const int row0 = b * SB + blk * 128; const int seq_lo = blk < 64 ? b * SB : b * SB + SEQ, seq_hi = blk < 64 ? b * SB + SEQ : (b + 1) * SB;
        BSYNC();
        if (F.wave < 2) gate_scan(A, l, row0, F.wave, h, BC + F.wave * 128, GG + F.wave * 128, PM + F.wave * 128, F.lane);
#pragma unroll
        for (int dir = 0; dir < 2; ++dir) {
            const int stream = (dir * 2 + b) * 4 + h, p = mpos(dir, blk);
            const float* rec = p >= 2 ? SCAR + ((size_t)stream * NPOS + p) * SST : SLOC + ((size_t)stream * NPOS) * SST;
            float m0, sc;
            if (p >= 2) { m0 = rec[4160]; sc = 1.f; } else if (p == 1) { const float a0 = rec[4160], ml = rec[4161]; m0 = fmaxf(a0, ml); sc = expf(ml - m0); } else { m0 = 0.f; sc = 0.f; }
            { const int e = F.tid >> 3, d0 = (F.tid & 7) * 8; const f32x4 c0 = *(const f32x4*)(rec + e * 64 + d0), c1 = *(const f32x4*)(rec + e * 64 + d0 + 4);
              *(LAS v4u*)(C0B + (dir * 64 + e) * 72 + d0) = (v4u){pk2(c0.x * sc, c0.y * sc), pk2(c0.z * sc, c0.w * sc), pk2(c1.x * sc, c1.y * sc), pk2(c1.z * sc, c1.w * sc)}; }
            if (F.tid < 64) N0[dir * 64 + F.tid] = rec[4096 + F.tid] * sc;
            if (F.tid == 64) M0[dir] = m0;
        }
#pragma unroll
        for (int it = 0; it < 2; ++it) { const int idx = F.tid + it * NTHR, t = idx >> 3, c8 = idx & 7; float o[8];
            qk_conv8(P1, cw, cb, row0 + t, seq_lo, seq_hi, C_MQ + h * 64 + c8 * 8, 0.125f, o);
            *(LAS v4u*)(QT + t * 72 + c8 * 8) = (v4u){pk2(o[0], o[1]), pk2(o[2], o[3]), pk2(o[4], o[5]), pk2(o[6], o[7])};
            qk_conv8(P1, cw, cb, row0 + t, seq_lo, seq_hi, C_MK + h * 64 + c8 * 8, 1.f, o);
            *(LAS v4u*)(KN + t * 72 + c8 * 8) = (v4u){pk2(o[0], o[1]), pk2(o[2], o[3]), pk2(o[4], o[5]), pk2(o[6], o[7])};
            const v4u x = *(const v4u*)(P1 + (size_t)(row0 + t) * NP1 + C_MV + h * 64 + c8 * 8); const unsigned xa[4] = {x.x, x.y, x.z, x.w};
#pragma unroll
            for (int i = 0; i < 4; ++i) { VT[(c8 * 8 + 2 * i) * 136 + t] = (unsigned short)(xa[i] & 0xffffu); VT[(c8 * 8 + 2 * i + 1) * 136 + t] = (unsigned short)(xa[i] >> 16); } }
        BSYNC();
        if (F.tid < 256) { const int dir = F.tid >> 7, j = F.tid & 127; const float m0 = M0[dir]; const float mm = fmaxf(m0, PM[dir * 128 + j]); MM[F.tid] = mm; WI[F.tid] = fexp(m0 - mm); }
        BSYNC();
        f32x16 osum = {};
        const int bj = F.wave >> 1, be = F.wave & 1;
#pragma unroll 1
        for (int dir = 0; dir < 2; ++dir) {
#pragma unroll
            for (int it = 0; it < 2; ++it) { const int idx = F.tid + it * NTHR, t = idx >> 3, c8 = idx & 7; const float w = WI[dir * 128 + t];
                const v4u x = *(const LAS v4u*)(QT + t * 72 + c8 * 8);
                *(LAS v4u*)(AP + t * 200 + 128 + c8 * 8) = (v4u){pk2(bflo(x.x) * w, bfhi(x.x) * w), pk2(bflo(x.y) * w, bfhi(x.y) * w), pk2(bflo(x.z) * w, bfhi(x.z) * w), pk2(bflo(x.w) * w, bfhi(x.w) * w)}; }
#pragma unroll
            for (int q2 = 0; q2 < 2; ++q2) { const int blkid = F.wave * 2 + q2, bi = blkid >> 2, bs = blkid & 3; f32x16 acc = {};
                const bool need = dir ? (bs >= bi) : (bs <= bi);
                if (need) {
#pragma unroll
                    for (int kk = 0; kk < 4; ++kk) { const s16x8 a = *(const LAS s16x8*)(KN + (bs * 32 + r) * 72 + kk * 16 + hh * 8), bb = *(const LAS s16x8*)(QT + (bi * 32 + r) * 72 + kk * 16 + hh * 8);
                        acc = __builtin_amdgcn_mfma_f32_32x32x16_bf16(a, bb, acc, 0, 0, 0); } }
                const int j = bi * 32 + r; const float mmj = MM[dir * 128 + j];
#pragma unroll
                for (int q = 0; q < 4; ++q) { const int s0 = bs * 32 + 8 * q + 4 * hh; const f32x4 gs = *(const LAS f32x4*)(GG + dir * 128 + s0); float v[4];
#pragma unroll
                    for (int i = 0; i < 4; ++i) { const int sidx = s0 + i; const bool valid = dir ? (sidx >= j) : (sidx <= j); v[i] = valid ? acc[4 * q + i] * fexp(gs[i] - mmj) : 0.f; }
                    *(LAS unsigned long long*)(AP + j * 200 + s0) = (unsigned long long)pk2(v[0], v[1]) | ((unsigned long long)pk2(v[2], v[3]) << 32); } }
            BSYNC();
            { const int j = F.tid >> 2, part = F.tid & 3; float a = 0.f;
#pragma unroll
              for (int i = 0; i < 6; ++i) { const int k0 = part * 48 + 8 * i; const v4u x = *(const LAS v4u*)(AP + j * 200 + k0); const float f[8] = {bflo(x.x), bfhi(x.x), bflo(x.y), bfhi(x.y), bflo(x.z), bfhi(x.z), bflo(x.w), bfhi(x.w)};
                  if (k0 < 128) { a += ((f[0] + f[1]) + (f[2] + f[3])) + ((f[4] + f[5]) + (f[6] + f[7])); }
                  else { const LAS float* nn = N0 + dir * 64 + (k0 - 128);
#pragma unroll
                      for (int q = 0; q < 8; ++q) a += f[q] * nn[q]; } }
              a += dppf<0xB1>(a); a += dppf<0x4E>(a); if (part == 0) DEN[dir * 128 + j] = a; }
            f32x16 acc = {};
#pragma unroll
            for (int kk = 0; kk < 12; ++kk) { const s16x8 a = *(const LAS s16x8*)(AP + (bj * 32 + r) * 200 + kk * 16 + hh * 8);
                const s16x8 bb = kk < 8 ? *(const LAS s16x8*)(VT + (be * 32 + r) * 136 + kk * 16 + hh * 8) : *(const LAS s16x8*)(C0B + (dir * 64 + be * 32 + r) * 72 + (kk - 8) * 16 + hh * 8);
                acc = __builtin_amdgcn_mfma_f32_32x32x16_bf16(a, bb, acc, 0, 0, 0); }
            BSYNC();
#pragma unroll
            for (int g = 0; g < 16; ++g) { const int j = bj * 32 + (g & 3) + 8 * (g >> 2) + 4 * hh; const float den = fmaxf(fabsf(DEN[dir * 128 + j]), fexp(-(BC[dir * 128 + j] + MM[dir * 128 + j]))); osum[g] += acc[g] * __builtin_amdgcn_rcpf(den); }
        }
        float ssq[16];
#pragma unroll
        for (int g = 0; g < 16; ++g) { float q = osum[g] * osum[g]; q += dppf<0xB1>(q); q += dppf<0x4E>(q); q += dppf<0x141>(q); q += dppf<0x140>(q); ssq[g] = q; }
        if ((F.lane & 15) == 0) {
#pragma unroll
            for (int g = 0; g < 16; ++g) SS[(be * 2 + ((F.lane >> 4) & 1)) * 128 + bj * 32 + (g & 3) + 8 * (g >> 2) + 4 * hh] = ssq[g]; }
        BSYNC();
        const int e = be * 32 + r; const float nw = A.in[10][l * 256 + h * 64 + e];
#pragma unroll
        for (int g = 0; g < 16; ++g) { const int j = bj * 32 + (g & 3) + 8 * (g >> 2) + 4 * hh; const float tot = (SS[j] + SS[128 + j]) + (SS[256 + j] + SS[384 + j]);
            const float og = bf2f(P1[(size_t)(row0 + j) * NP1 + C_MO + h * 64 + e]);
            const float y = osum[g] * (1.f / sqrtf(tot * (1.f / 64.f) + RMS_EPS)) * nw * sigmoidf_(og);
            Y[(size_t)(row0 + j) * DM + h * 64 + e] = (bf16)f2bf(y); }
    }
}

__device__ __forceinline__ float hy_conv(const float* p, int t, int n, float w0, float w1, float w2, float bb) {
    const float xm = t > 0 ? p[t - 1] : 0.f, x0 = p[t], xp = t + 1 < n ? p[t + 1] : 0.f; return bb + w0 * xm + w1 * x0 + w2 * xp; }
__device__ __forceinline__ void hy_row16(const float* p, int t0, float w0, float w1, float w2, float bb, float (&out)[16]) {
    const f32x4 a = *(const f32x4*)(p + t0), b = *(const f32x4*)(p + t0 + 4), c = *(const f32x4*)(p + t0 + 8), d = *(const f32x4*)(p + t0 + 12);
    const float lo = t0 > 0 ? p[t0 - 1] : 0.f, hi = t0 + 16 < SEQ ? p[t0 + 16] : 0.f;
    const float x[18] = {lo, a.x, a.y, a.z, a.w, b.x, b.y, b.z, b.w, c.x, c.y, c.z, c.w, d.x, d.y, d.z, d.w, hi};
#pragma unroll
    for (int i = 0; i < 16; ++i) out[i] = bb + w0 * x[i] + w1 * x[i + 1] + w2 * x[i + 2];
}
__device__ __forceinline__ void hy_spectrum_mul(LAS f32x2* d, const f32x2* __restrict__ hf, int tid) {
#pragma unroll 1
    for (int i0 = 0; i0 < NFFT; i0 += 16 * NTHR) { f32x2 h[16];
#pragma unroll
        for (int k = 0; k < 16; ++k) h[k] = hf[i0 + k * NTHR + tid];
#pragma unroll
        for (int k = 0; k < 16; ++k) { const int i = i0 + k * NTHR + tid; d[fphys(i)] = cmul(d[fphys(i)], h[k]); } }
}
__device__ __forceinline__ void ph_hyena(const Fr& F, const Args& A, int l) {
    const float* HY = (const float*)(A.ws + WS_HY); bf16* Y = (bf16*)(A.ws + WS_Y); float* ZT = (float*)(A.ws + WS_Z1);
    const f32x2* TW = (const f32x2*)(A.ws + WS_TW); const f32x2* HF = (const f32x2*)(A.ws + WS_HF);
    LAS f32x2* d = (LAS f32x2*)(F.lds + RING_OFF);
    const bool lastl = (l == DEPTH - 1);
    for (int c = F.bid; c < 256; c += F.G) {
        const float* cwp = A.in[13] + (size_t)l * 3 * 768; const float* cbp = A.in[14] + l * 768;
        float cw[3][3], cbv[3];
#pragma unroll
        for (int w = 0; w < 3; ++w) { cbv[w] = cbp[w * 256 + c];
#pragma unroll
            for (int j = 0; j < 3; ++j) cw[w][j] = cwp[j * 768 + w * 256 + c]; }
        const float sk0 = A.in[21][(l * 2 + 0) * 256 + c], sk1 = A.in[21][(l * 2 + 1) * 256 + c];
        const float* hb0 = HY + ((size_t)(0 * 768 + c)) * SB; const float* hb1 = HY + ((size_t)(1 * 768 + c)) * SB;
        const int t0 = 16 * F.tid; const int pb = fphys(t0);
        float z0[16], z1[16];
        BSYNC();
        hy_row16(hb0, t0, cw[0][0], cw[0][1], cw[0][2], cbv[0], z0); hy_row16(hb1, t0, cw[0][0], cw[0][1], cw[0][2], cbv[0], z1);
#pragma unroll
        for (int i = 0; i < 16; ++i) { d[pb + i] = (f32x2){z0[i], z1[i]}; d[fphys(SEQ + t0) + i] = (f32x2){0.f, 0.f}; }
        BSYNC();
#pragma unroll 1
        for (int o = 0; o < 2; ++o) {
            fft_fwd(d, TW, F.tid);
            hy_spectrum_mul(d, HF + ((size_t)(l * 2 + o) * 256 + c) * NFFT, F.tid);
            BSYNC();
            fft_inv(d, TW, F.tid);
            float x0[16], x1[16]; const int w = 1 + o; const float sk = o ? sk1 : sk0;
            hy_row16(hb0 + (size_t)(w * 256) * SB, t0, cw[w][0], cw[w][1], cw[w][2], cbv[w], x0); hy_row16(hb1 + (size_t)(w * 256) * SB, t0, cw[w][0], cw[w][1], cw[w][2], cbv[w], x1);
#pragma unroll
            for (int i = 0; i < 16; ++i) { const f32x2 cv = d[pb + i]; z0[i] = x0[i] * (cv.x + sk * z0[i]); z1[i] = x1[i] * (cv.y + sk * z1[i]); }
            if (o == 0) {
#pragma unroll
                for (int i = 0; i < 16; ++i) { d[pb + i] = (f32x2){z0[i], z1[i]}; d[fphys(SEQ + t0) + i] = (f32x2){0.f, 0.f}; }
            }
            BSYNC();
        }
        { float* o0 = ZT + ((size_t)(0 * 256 + c)) * SEQ + t0; float* o1 = ZT + ((size_t)(1 * 256 + c)) * SEQ + t0;
#pragma unroll
          for (int i4 = 0; i4 < 4; ++i4) { st16(o0 + 4 * i4, __builtin_bit_cast(v4u, (f32x4){z0[4 * i4], z0[4 * i4 + 1], z0[4 * i4 + 2], z0[4 * i4 + 3]})); st16(o1 + 4 * i4, __builtin_bit_cast(v4u, (f32x4){z1[4 * i4], z1[4 * i4 + 1], z1[4 * i4 + 2], z1[4 * i4 + 3]})); } }
        if (!lastl) {
            LAS float* zc = (LAS float*)(F.lds + RING_OFF); LAS float* tp = zc + 512;
            const float* TAPC = (const float*)(A.ws + WS_TAPC) + ((size_t)(l * 2) * 256 + c) * 512;
            const int b = F.tid >> 8, t = F.tid & 255;
            const float* base = HY + ((size_t)(b * 768 + c)) * SB + SEQ;
            const float vc = hy_conv(base, t, CTXL, cw[0][0], cw[0][1], cw[0][2], cbv[0]);
            const float x1c = hy_conv(base + (size_t)256 * SB, t, CTXL, cw[1][0], cw[1][1], cw[1][2], cbv[1]);
            const float x2c = hy_conv(base + (size_t)512 * SB, t, CTXL, cw[2][0], cw[2][1], cw[2][2], cbv[2]);
            BSYNC();
            zc[F.tid] = vc; tp[F.tid] = TAPC[F.tid]; tp[512 + F.tid] = TAPC[(size_t)256 * 512 + F.tid];
            BSYNC();
            float y = 0.f; for (int q = 0; q < 256; ++q) y += tp[256 + t - q] * zc[b * 256 + q];
            const float zz1 = x1c * (y + sk0 * vc);
            BSYNC(); zc[F.tid] = zz1; BSYNC();
            float y2 = 0.f; for (int q = 0; q < 256; ++q) y2 += tp[512 + 256 + t - q] * zc[b * 256 + q];
            const float zz2 = x2c * (y2 + sk1 * zz1);
            Y[((size_t)b * SB + SEQ + t) * DM + 768 + c] = (bf16)f2bf(zz2);
        }
    }
}

__device__ __forceinline__ void ph_hy_transpose(const Fr& F, const Args& A) {
    const float* ZT = (const float*)(A.ws + WS_Z1); bf16* Y = (bf16*)(A.ws + WS_Y);
    LAS float* tile = (LAS float*)(F.lds + RING_OFF);
    for (int u = F.bid; u < NB * (SEQ / 64); u += F.G) {
        const int b = u / (SEQ / 64), t0 = (u % (SEQ / 64)) * 64;
        BSYNC();
#pragma unroll
        for (int k = 0; k < 8; ++k) { const int idx = F.tid + NTHR * k, c = idx >> 4, f4 = idx & 15; const f32x4 v = *(const f32x4*)(ZT + ((size_t)(b * 256 + c)) * SEQ + t0 + 4 * f4);
            tile[(4 * f4 + 0) * 257 + c] = v.x; tile[(4 * f4 + 1) * 257 + c] = v.y; tile[(4 * f4 + 2) * 257 + c] = v.z; tile[(4 * f4 + 3) * 257 + c] = v.w; }
        BSYNC();
#pragma unroll
        for (int k = 0; k < 4; ++k) { const int idx = F.tid + NTHR * k, t = idx >> 5, c8 = idx & 31; const LAS float* sp = tile + t * 257 + c8 * 8;
            *(v4u*)(Y + ((size_t)b * SB + t0 + t) * DM + 768 + c8 * 8) = (v4u){pk2(sp[0], sp[1]), pk2(sp[2], sp[3]), pk2(sp[4], sp[5]), pk2(sp[6], sp[7])}; }
    }
}

__device__ __forceinline__ void ph_attention(const Fr& F, const Args& A, int l, unsigned char* lds_generic, int i_lo, int i_hi) {
    const attn_body::bf16* P1 = (const attn_body::bf16*)(A.ws + WS_P1); const attn_body::bf16* QKP = (const attn_body::bf16*)(A.ws + WS_QKP); attn_body::bf16* Y = (attn_body::bf16*)(A.ws + WS_Y);
    const int nun = (l == DEPTH - 1) ? 512 : 528;
    for (int i = i_lo; i < i_hi; ++i) { const int u = F.bid + i * F.G; if (u >= nun) break;
        int b, hq, q0, kv0, nt;
        if (u < 512) { b = u >> 8; hq = (u >> 5) & 7; q0 = (u & 31) * 256; kv0 = 0; nt = SB / 64; }
        else { const int v = u - 512; b = v >> 3; hq = v & 7; q0 = SEQ; kv0 = SEQ; nt = CTXL / 64; }
        const int kvh = hq >> 2;
        const attn_body::bf16* Qb = QKP + ((size_t)b * SB + q0) * NQK + hq * 64;
        const attn_body::bf16* Kb = QKP + ((size_t)b * SB + kv0) * NQK + 512 + kvh * 64;
        const attn_body::bf16* Vb = P1 + ((size_t)b * SB + kv0) * NP1 + C_AV + kvh * 64;
        attn_body::bf16* Ob = Y + ((size_t)b * SB + q0) * DM + 256 + hq * 64;
        attn_body::attn_unit<8>(Qb, NQK, Kb, Vb, NQK, NP1, nt, Ob, DM, (char*)lds_generic + RING_OFF, F.tid);
    }
}

__device__ __forceinline__ int block_count(int v, LAS int* slot  , int it, int wave, int lane) {
    v = wave_sum_i(v);
    if (lane == 0) slot[(it & 1) * 8 + wave] = v;
    BSYNC();
    int s = 0;
#pragma unroll
    for (int i = 0; i < NWAVES; ++i) s += slot[(it & 1) * 8 + i];
    return s;
}
__device__ __forceinline__ int block_excl_scan(int v, LAS int* wtot  , int wave, int lane, int& tot) {
    int inc = v;
#pragma unroll
    for (int o = 1; o < 64; o <<= 1) { const int t = __shfl_up(inc, o); if (lane >= o) inc += t; }
    BSYNC();
    if (lane == 63) wtot[wave] = inc;
    BSYNC();
    int pre = 0; tot = 0;
#pragma unroll
    for (int i = 0; i < NWAVES; ++i) { const int x = wtot[i]; if (i < wave) pre += x; tot += x; }
    return pre + inc - v;
}
__device__ __forceinline__ void ph_select(const Fr& F, const Args& A, int l) {
    const float* AFF = (const float*)(A.ws + WS_AFF); int* INV = (int*)(A.ws + WS_INV); int* IDX = (int*)(A.ws + WS_IDX); float* VAL = (float*)(A.ws + WS_VAL);
    LAS int* slot = (LAS int*)(F.lds + LDSX_OFF); LAS int* wtot = slot + 16;
    const int nun = (l == DEPTH - 1) ? 32 : 64;
    for (int u = F.bid; u < nun; u += F.G) {
        const int kind = u >> 5, b = (u >> 4) & 1, e = u & 15;
        const int n = kind ? CTXL : SEQ, cap = n / 8, sbase = kind ? SEQ : 0;
        const float* ap = AFF + ((size_t)b * 16 + e) * SB + sbase;
        unsigned key[16];
#pragma unroll
        for (int i4 = 0; i4 < 4; ++i4) { const int t = 16 * F.tid + 4 * i4; v4u x = {0u, 0u, 0u, 0u}; if (t < n) x = *(const v4u*)(ap + t); key[4 * i4] = x.x; key[4 * i4 + 1] = x.y; key[4 * i4 + 2] = x.z; key[4 * i4 + 3] = x.w; }
        const bool tv = (16 * F.tid < n);
        BSYNC();
        unsigned T = 0u; int itc = 0;
        for (int bit = 31; bit >= 0; --bit) { const unsigned cand = T | (1u << bit); int cnt = 0;
#pragma unroll
            for (int i = 0; i < 16; ++i) cnt += (tv && key[i] >= cand) ? 1 : 0;
            if (block_count(cnt, slot, itc++, F.wave, F.lane) >= cap) T = cand; }
        int cgt = 0, ceq = 0;
#pragma unroll
        for (int i = 0; i < 16; ++i) { cgt += (tv && key[i] > T) ? 1 : 0; ceq += (tv && key[i] == T) ? 1 : 0; }
        int tot_gt, tot_eq; (void)block_excl_scan(cgt, wtot, F.wave, F.lane, tot_gt);
        int eqrank = block_excl_scan(ceq, wtot, F.wave, F.lane, tot_eq);
        const int need = cap - tot_gt;
        unsigned selmask = 0u; int csel = 0;
#pragma unroll
        for (int i = 0; i < 16; ++i) { bool sel = false; if (tv) { if (key[i] > T) sel = true; else if (key[i] == T) { sel = eqrank < need; ++eqrank; } } if (sel) { selmask |= 1u << i; ++csel; } }
        int tot_sel; int sl = block_excl_scan(csel, wtot, F.wave, F.lane, tot_sel);
        if (tv) {
#pragma unroll
            for (int i = 0; i < 16; ++i) { const int t = 16 * F.tid + i; const int row = b * SB + sbase + t; int r1 = 0;
                if (selmask & (1u << i)) { const int rr = (kind ? 2048 + b * 32 : b * 1024) + sl; ++sl; IDX[e * ROWS_E + rr] = row; VAL[e * ROWS_E + rr] = __uint_as_float(key[i]); r1 = rr + 1; }
                INV[(size_t)row * 16 + e] = r1; }
        }
    }
}
constexpr int NPH_PRO = 3, NPH_LAYER = 10, NPH = NPH_PRO + DEPTH * NPH_LAYER;
template <unsigned KMASK> __global__ void __launch_bounds__(NTHR, 2) mk_fwd(Args args) {
    extern __shared__ __attribute__((aligned(16))) unsigned char lds[];
    Fr F; F.lds = (LAS unsigned char*)lds; F.tid = threadIdx.x; F.lane = F.tid & 63; F.wave = __builtin_amdgcn_readfirstlane(F.tid >> 6); F.G = gridDim.x; F.bid = blockIdx.x;
    unsigned char* ws = args.ws;
    for (int u = F.tid; u < (LDS_BYTES - LDSCTL_OFF) / 4; u += NTHR) ((LAS unsigned*)(F.lds + LDSCTL_OFF))[u] = 0u;
    __syncthreads();
#if MK_SINGLE
    XcdBarrier bar = xcd_barrier_post((unsigned*)(ws + WS_CTL) + 1024, (volatile LAS unsigned*)(F.lds + MISC_OFF) + 8);
#ifdef PROBE_DBLBAR
#define GRID_BAR() do { xcd_barrier(bar); xcd_barrier(bar); } while (0)
#else
#define GRID_BAR() xcd_barrier(bar)
#endif
#else
#define GRID_BAR() do {} while (0)
#endif
    const int lo = args.ph_lo, hi = args.ph_hi;
#define IN(k) (lo <= (k) && (k) < hi)
#define KIND(q) if constexpr ((KMASK >> (q)) & 1u)
#ifndef PROBE_KIND
#define PROBE_KIND -1
#endif
#ifndef PROBE_REPS
#define PROBE_REPS 0
#endif
#ifdef PROBE_REPBAR
#define REP(q) for (int rep_ = 0; rep_ < (((q) == PROBE_KIND || PROBE_KIND == 99) ? 1 + PROBE_REPS : 1); ++rep_, (rep_ < (((q) == PROBE_KIND || PROBE_KIND == 99) ? 1 + PROBE_REPS : 1) ? (void)(GRID_BAR()) : (void)0))
#else
#define REP(q) for (int rep_ = 0; rep_ < (((q) == PROBE_KIND || PROBE_KIND == 99) ? 1 + PROBE_REPS : 1); ++rep_)
#endif
#define SEAM(k) do { if (IN(k) && IN((k) + 1)) GRID_BAR(); } while (0)
    KIND(0) if (IN(0)) REP(0) { const Fr Fp = fr_fresh(F); ph_convert(Fp, args); } SEAM(0);
    KIND(1) if (IN(1)) REP(1) { const Fr Fp = fr_fresh(F); ph_taps(Fp, args); } SEAM(1);
    KIND(2) if (IN(2)) { REP(2) { const Fr Fp = fr_fresh(F); ph_ln_a0(Fp, args); } REP(17) { const Fr Fp = fr_fresh(F); ph_filters(Fp, args); } } SEAM(2);
    for (int l = 0; l < DEPTH; ++l) {
        const int pb = NPH_PRO + l * NPH_LAYER; const bool lastl = (l == DEPTH - 1);
        KIND(3) if (IN(pb + 0)) REP(3) {
            const Fr Fp = fr_fresh(F);
            pg8::Gemm g{(const pg8::bf16_t*)(ws + WS_HN), (const pg8::bf16_t*)(ws + WS_WINT) + (size_t)l * NWIN * DM, MT, NWIN, DM}; pg8::StaticOrder S; S.init(MT, NWIN, Fp.G, Fp.bid);
            EpiWin E{(bf16*)(ws + WS_P1), (float*)(ws + WS_HY), (float*)(ws + WS_GT)};
            pg8::gemm_phase<EpiWin, pg8::StaticOrder, PG8_ALIGN, PG8_SP2>(Fp.lds + RING_OFF, g, S, E, Fp.tid);
        } SEAM(pb + 0);
        KIND(4) if (IN(pb + 1)) {
            REP(4) { const Fr Fp = fr_fresh(F); ph_attn_prep(Fp, args, l); }
            REP(14) { const Fr Fp = fr_fresh(F); ph_mlstm_local(Fp, args, l); }
            REP(15) { const Fr Fp = fr_fresh(F); ph_hyena(Fp, args, l); }
        } SEAM(pb + 1);
        KIND(5) if (IN(pb + 2)) { REP(16) { const Fr Fp = fr_fresh(F); ph_mlstm_carry(Fp, args); } if (!lastl) REP(18) { const Fr Fp = fr_fresh(F); ph_mlstm_out(Fp, args, l, 512, 528, 64); } REP(19) { const Fr Fp = fr_fresh(F); ph_hy_transpose(Fp, args); } REP(5) { const Fr Fp = fr_fresh(F); const int grp = (Fp.bid >> 3) % 3;
#pragma unroll 1
                for (int i = 0; i < 3; ++i) { if (i == grp && rep_ == 0) { const Fr Fq = fr_fresh(F); ph_convert_experts(Fq, args, l); } const Fr Fa = fr_fresh(F); ph_attention(Fa, args, l, lds, i, i + 1); } } } SEAM(pb + 2);
        KIND(6) if (IN(pb + 3)) REP(6) { const Fr Fp = fr_fresh(F); ph_mlstm_out(Fp, args, l, 0, 512, 0); } SEAM(pb + 3);
        KIND(7) if (IN(pb + 4)) REP(7) {
            const Fr Fp = fr_fresh(F);
            pg8::Gemm g{(const pg8::bf16_t*)(ws + WS_Y), (const pg8::bf16_t*)(ws + WS_WOUTT) + (size_t)l * DM * DM, MT, DM, DM};
            WoutOrder S; S.ntile = lastl ? 64 : 66; S.skipctx = lastl ? 1 : 0; S.G = Fp.G; S.c = Fp.bid;
            EpiBf16g E{(bf16*)(ws + WS_MIX), DM, 4};
            pg8::gemm_phase<EpiBf16g, WoutOrder, PG8_ALIGN, PG8_SP2>(Fp.lds + RING_OFF, g, S, E, Fp.tid);
        } SEAM(pb + 4);
        KIND(8) if (IN(pb + 5)) REP(8) { const Fr Fp = fr_fresh(F); ph_ln_b(Fp, args, l); } SEAM(pb + 5);
        KIND(9) if (IN(pb + 6)) REP(9) { const Fr Fp = fr_fresh(F); ph_select(Fp, args, l); } SEAM(pb + 6);
        KIND(11) if (IN(pb + 7)) REP(11) {
            const Fr Fp = fr_fresh(F);
            LAS unsigned short* idxl = (LAS unsigned short*)(Fp.lds + IDXL_OFF);
            { const int* IDX = (const int*)(ws + WS_IDX); const int e0 = Fp.bid & 7;
              __syncthreads();
              for (int i = Fp.tid; i < 2 * ROWS_E; i += NTHR) { const int e = e0 + 8 * (i / ROWS_E); const unsigned v = (unsigned)IDX[e * ROWS_E + (i % ROWS_E)]; idxl[i] = (unsigned short)(v < (unsigned)MT ? v : 0u); }
              __syncthreads(); }
            pg8::Gemm8 g{(const unsigned char*)(ws + WS_HN), (const unsigned char*)(ws + WS_W1T) + (size_t)l * NE * (2 * FF) * DM, NE * ROWS_E, NE * 2 * FF, DM, W1_SCALE, idxl};
            GroupOrder S; S.nMe = lastl ? 8 : 9; S.nN = NT1; S.G = Fp.G; S.c = Fp.bid;
            EpiSwiglu E{(unsigned char*)(ws + WS_ACT)};
            pg8::gemm_phase8<EpiSwiglu, GroupOrder, PG8_ALIGN, false, true>(Fp.lds + RING_OFF, g, S, E, Fp.tid);
        } SEAM(pb + 7);
        KIND(12) if (IN(pb + 8)) REP(12) {
            const Fr Fp = fr_fresh(F);
            pg8::Gemm8 g{(const unsigned char*)(ws + WS_ACT), (const unsigned char*)(ws + WS_W2T) + (size_t)l * NE * DM * FF, NE * ROWS_E, NE * DM, FF, W2_SCALE, nullptr};
            GroupOrder S; S.nMe = lastl ? 8 : 9; S.nN = 4; S.G = Fp.G; S.c = Fp.bid;
            EpiBf16g E{(bf16*)(ws + WS_YE), DM, 4};
            pg8::gemm_phase8<EpiBf16g, GroupOrder, PG8_ALIGN, false>(Fp.lds + RING_OFF, g, S, E, Fp.tid);
        } SEAM(pb + 8);
        KIND(13) if (IN(pb + 9)) REP(13) { const Fr Fp = fr_fresh(F); ph_ln_c(Fp, args, l); } if (!lastl) SEAM(pb + 9);
    }
#undef IN
#undef SEAM
#undef KIND
#undef REP
}

constexpr int kind_of_phase(int k) { return k < NPH_PRO ? k : (3 + (k - NPH_PRO) % NPH_LAYER < 10 ? 3 + (k - NPH_PRO) % NPH_LAYER : 4 + (k - NPH_PRO) % NPH_LAYER); }
typedef void (*kern_t)(Args);
template <int Q> static kern_t kern_for_kind(int q) { if (q == Q) return mk_fwd<(1u << Q)>; if constexpr (Q + 1 < 14) return kern_for_kind<Q + 1>(q); else return nullptr; }
extern "C" void kernel_launch(void* const* d_in, const int* in_sizes, int n_in, void* d_out, int out_size, void* d_ws, size_t ws_size, hipStream_t stream) {
    static int grid = 0;
    if (grid == 0) {
        if (n_in != 32 || in_sizes[0] != NB * SEQ * DM || out_size != NB * SEQ * DM || ws_size < WS_END) { fprintf(stderr, "kernel_launch: unexpected shapes / workspace (n_in %d, ws %zu < %zu)\n", n_in, ws_size, (size_t)WS_END); grid = -1; return; }
        int dev = 0, cus = 0;
        if (hipGetDevice(&dev) != hipSuccess || hipDeviceGetAttribute(&cus, hipDeviceAttributeMultiprocessorCount, dev) != hipSuccess) { grid = -1; return; }
#if MK_SINGLE
        if (hipFuncSetAttribute((const void*)mk_fwd<0x3fffu>, hipFuncAttributeMaxDynamicSharedMemorySize, LDS_BYTES) != hipSuccess) { fprintf(stderr, "kernel_launch: hipFuncSetAttribute failed\n"); grid = -1; return; }
#else
        for (int q = 0; q < 14; ++q) if (hipFuncSetAttribute((const void*)kern_for_kind<0>(q), hipFuncAttributeMaxDynamicSharedMemorySize, LDS_BYTES) != hipSuccess) { fprintf(stderr, "kernel_launch: hipFuncSetAttribute failed\n"); grid = -1; return; }
#endif
        (void)hipGetLastError();
        grid = cus & ~7;
    }
    if (grid < 0) return;
    if (hipMemsetAsync((char*)d_ws + WS_CTL, 0, CTL_ZERO_BYTES, stream) != hipSuccess) return;
    Args a{};
    for (int i = 0; i < 32; ++i) a.in[i] = (const float*)d_in[i];
    a.out = (float*)d_out; a.ws = (unsigned char*)d_ws;
#if MK_SINGLE
    a.ph_lo = 0; a.ph_hi = NPH;
    hipLaunchKernelGGL(mk_fwd<0x3fffu>, dim3(grid), dim3(NTHR), LDS_BYTES, stream, a);
#else
    for (int k = 0; k < NPH; ++k) { a.ph_lo = k; a.ph_hi = k + 1; kern_t f = kern_for_kind<0>(kind_of_phase(k)); hipLaunchKernelGGL(f, dim3(grid), dim3(NTHR), LDS_BYTES, stream, a); }
#endif
}
```

```cpp
#include <hip/hip_runtime.h>
#include <hip/hip_bf16.h>
#include <cstdio>
#include <cstdint>
#include <cmath>

#ifndef MK_SINGLE
#define MK_SINGLE 1
#endif

namespace pg8 {
#define PG8_LAS __attribute__((address_space(3)))
typedef unsigned short bf16_t;
typedef short bf16x8 __attribute__((ext_vector_type(8)));
typedef float f32x4 __attribute__((ext_vector_type(4)));
typedef unsigned u32x4 __attribute__((ext_vector_type(4)));
constexpr int BM = 256, BK = 64, HALF = 128, HTB = HALF * BK * 2  , STAGE_BYTES = 8 * HTB, NXCD = 8, WGM = 8;

__host__ __device__ __forceinline__ int lds_byte(int r, int c) { const int st = (r >> 4) * 2 + (c >> 5), rr = r & 15, cc = c & 31, ob = rr * 64 + cc * 2; return st * 1024 + (ob ^ (((ob >> 9) & 1) << 5)); }
__host__ __device__ __forceinline__ void stage_rc(int b, int& R, int& C) { const int st = b / 1024, sb = b % 1024, swz = sb ^ (((sb >> 9) & 1) << 5); R = (st >> 1) * 16 + swz / 64; C = (st & 1) * 32 + (swz % 64) / 2; }
__host__ __device__ __forceinline__ int perm32(int rho) { const int n = rho >> 4, i = rho & 15; return 8 * (i >> 2) + 4 * n + (i & 3); }

struct Unit { int pm, pn; int kq = -1; };
struct Gemm { const bf16_t* A; const bf16_t* Bt; int M, N, K; };

struct StaticOrder {
    int nM, nN, nwg, G, c;
    __host__ __device__ void init(int M, int N, int G_, int c_) { nM = M / BM; nN = N / BM; nwg = nM * nN; G = G_; c = c_; }
    __host__ __device__ bool next(int i, Unit& u) const {
        const long L = (long)i * G + c; if (L >= nwg) return false;
        int wgid = (int)L; { const int q = nwg / NXCD, r = nwg % NXCD, xcd = wgid % NXCD, off = wgid / NXCD; wgid = (xcd < r ? xcd * (q + 1) : r * (q + 1) + (xcd - r) * q) + off; }
        const int nig = WGM * nN, gid = wgid / nig, fm = gid * WGM, gsz = (nM - fm) < WGM ? (nM - fm) : WGM;
        u.pm = fm + ((wgid % nig) % gsz); u.pn = (wgid % nig) / gsz;
        if (nN == 11) u.pn = (int)((0xA6954382107ULL >> (4 * u.pn)) & 15ULL);
        return true;
    }
    __device__ __forceinline__ void a_ready(const Unit&) const {}
    __device__ __forceinline__ void done(const Unit&) const {}
};

__device__ __forceinline__ unsigned cvt_pk_bf16(float lo, float hi) { unsigned r; asm volatile("v_cvt_pk_bf16_f32 %0, %1, %2" : "=v"(r) : "v"(lo), "v"(hi)); return r; }
typedef float f32x2 __attribute__((ext_vector_type(2)));
__device__ __forceinline__ f32x2 gelu_pk(f32x2 v) {
    const f32x2 av = __builtin_elementwise_abs(v), d = av * 0.2316418882f + 1.0f;
    f32x2 t; t.x = __builtin_amdgcn_rcpf(d.x); t.y = __builtin_amdgcn_rcpf(d.y);
    f32x2 q = t * 0.5307027145f + (-0.7265760135f); q = q * t + 0.7107068705f; q = q * t + (-0.142248368f); q = q * t + 0.127414796f; q = q * t;
    const f32x2 s = (v * v) * (-0.72134752044f);
    f32x2 e; e.x = __builtin_amdgcn_exp2f(s.x); e.y = __builtin_amdgcn_exp2f(s.y);
    const f32x2 m = v * (q * e), r = v - m;
    f32x2 o; o.x = v.x < 0.f ? m.x : r.x; o.y = v.y < 0.f ? m.y : r.y; return o;
}

template <int ACT  > struct EpiBf16 {
    static constexpr bool PERM = true, AFTER_DRAIN = false; static_assert(ACT == 0 || ACT == 1, "EpiBf16: ACT is 0 (none) or 1 (gelu_pk)");
    bf16_t* O; int ldc; const float* bias; int split_cols; size_t split_stride; float scale0;
    __device__ __forceinline__ void operator()(const f32x4 (&acc)[2][2][4][2], const Unit& u, int wr, int wc, int fr, int fq) const {
        const int row0 = u.pm * BM + wr * 64 + fr; int colt = u.pn * BM; bf16_t* base = O;
        float sc = 1.f; if (split_cols) { const int t = colt / split_cols; base += (size_t)t * split_stride; colt -= t * split_cols; if (t == 0) sc = scale0; }
        const int col0 = colt + wc * 32 + 8 * fq, bcol0 = u.pn * BM + wc * 32 + 8 * fq;
        f32x4 bv[2][2];
#pragma unroll
        for (int bj = 0; bj < 2; ++bj)
#pragma unroll
            for (int n = 0; n < 2; ++n) bv[bj][n] = bias ? *(const f32x4*)(bias + bcol0 + bj * HALF + 4 * n) : (f32x4){0.f, 0.f, 0.f, 0.f};
#pragma unroll
        for (int ai = 0; ai < 2; ++ai)
#pragma unroll
            for (int m = 0; m < 4; ++m) { bf16_t* rowp = base + (size_t)(row0 + ai * HALF + m * 16) * ldc + col0;
#pragma unroll
                for (int bj = 0; bj < 2; ++bj) { f32x4 v0 = acc[ai][bj][m][0] + bv[bj][0], v1 = acc[ai][bj][m][1] + bv[bj][1];
                    if (ACT == 1) { f32x2 a = gelu_pk((f32x2){v0[0], v0[1]}), b = gelu_pk((f32x2){v0[2], v0[3]}), c = gelu_pk((f32x2){v1[0], v1[1]}), d = gelu_pk((f32x2){v1[2], v1[3]});
                        v0 = (f32x4){a.x, a.y, b.x, b.y}; v1 = (f32x4){c.x, c.y, d.x, d.y}; }
                    v0 = v0 * sc; v1 = v1 * sc; u32x4 w; w.x = cvt_pk_bf16(v0[0], v0[1]); w.y = cvt_pk_bf16(v0[2], v0[3]); w.z = cvt_pk_bf16(v1[0], v1[1]); w.w = cvt_pk_bf16(v1[2], v1[3]);
                    *(u32x4*)(rowp + bj * HALF) = w; } }
    }
};


template <class Epi, class Sched, bool ALIGN_EPI = false, bool SP2 = false>
__device__ __forceinline__ void gemm_phase(PG8_LAS unsigned char* lds, const Gemm g, const Sched& S, const Epi& E, const int tid) {
    const int wid = __builtin_amdgcn_readfirstlane(tid >> 6), lane = tid & 63, wr = wid >> 2, wc = wid & 3, fr = lane & 15, fq = lane >> 4;
    const int K = g.K, nt = K / BK;
    unsigned voffA[2], voffB[2];
#pragma unroll
    for (int i = 0; i < 2; ++i) { int R, C; stage_rc(tid * 16 + i * 8192, R, C); const int Rb = Epi::PERM ? ((R & ~31) + perm32(R & 31)) : R;
        voffA[i] = (unsigned)(R * K + C) * 2u; voffB[i] = (unsigned)(Rb * K + C) * 2u; }
    const size_t kstep = (size_t)(BK * 2);
    const size_t hstep = (size_t)HALF * K * 2;
    const size_t tstep = 2 * hstep;
    const unsigned ldsw = (unsigned)wid * 1024u;
    const int aoff = lds_byte(wr * 64 + fr, fq * 8), boff = lds_byte(wc * 32 + fr, fq * 8);
#define PG8_SA(b, h) (((b) * 2 + (h)) * HTB)
#define PG8_SB(b, h) ((4 + (b) * 2 + (h)) * HTB)
#define PG8_STAGE(bufoff, gbase, voff) do { _Pragma("unroll") for (int _i = 0; _i < 2; ++_i) \
        __builtin_amdgcn_global_load_lds((const unsigned*)((const char*)(gbase) + (voff)[_i]), (PG8_LAS unsigned*)(lds + (bufoff) + ldsw + _i * 8192), 16, 0, 0); } while (0)
#define PG8_LDA(dst, b, h) do { _Pragma("unroll") for (int m = 0; m < 4; ++m) _Pragma("unroll") for (int k = 0; k < 2; ++k) dst[m][k] = *(const PG8_LAS bf16x8*)(lds + PG8_SA(b, h) + aoff + m * 2048 + k * 1024); } while (0)
#define PG8_LDB(dst, b, h) do { _Pragma("unroll") for (int n = 0; n < 2; ++n) _Pragma("unroll") for (int k = 0; k < 2; ++k) dst[n][k] = *(const PG8_LAS bf16x8*)(lds + PG8_SB(b, h) + boff + n * 2048 + k * 1024); } while (0)
#define PG8_MMA(ai, bj, At, Bt) do { __builtin_amdgcn_s_setprio(1); _Pragma("unroll") for (int m = 0; m < 4; ++m) _Pragma("unroll") for (int n = 0; n < 2; ++n) _Pragma("unroll") for (int k = 0; k < 2; ++k) \
        acc[ai][bj][m][n] = __builtin_amdgcn_mfma_f32_16x16x32_bf16(Bt[n][k], At[m][k], acc[ai][bj][m][n], 0, 0, 0); __builtin_amdgcn_s_setprio(0); } while (0)
#define PG8_WAIT_V(n) asm volatile("s_waitcnt vmcnt(" #n ")" ::: "memory")
#define PG8_WAIT_L(n) asm volatile("s_waitcnt lgkmcnt(" #n ")" ::: "memory")
#define PG8_BAR __builtin_amdgcn_s_barrier()
#define PG8_SCHED __builtin_amdgcn_sched_barrier(0)
    Unit cur, nxt; int ui = 0;
    if (!S.next(0, cur)) return;
    f32x4 acc[2][2][4][2];
#pragma unroll
    for (int a = 0; a < 2; ++a)
#pragma unroll
        for (int b = 0; b < 2; ++b)
#pragma unroll
            for (int m = 0; m < 4; ++m)
#pragma unroll
                for (int n = 0; n < 2; ++n) acc[a][b][m][n] = (f32x4){0.f, 0.f, 0.f, 0.f};
    bf16x8 At[4][2], B0[2][2], B1[2][2];
    const size_t kqb = (size_t)(K / 4) * 2;
    const char* cA = (const char*)g.A + (size_t)cur.pm * tstep + (cur.kq > 0 ? cur.kq * kqb : 0); const char* cB = (const char*)g.Bt + (size_t)cur.pn * tstep + (cur.kq > 0 ? cur.kq * kqb : 0);
    S.a_ready(cur);
    if constexpr (SP2) {
        PG8_STAGE(PG8_SB(0, 0), cB, voffB); PG8_STAGE(PG8_SB(0, 1), cB + hstep, voffB); PG8_STAGE(PG8_SA(0, 0), cA, voffA); PG8_STAGE(PG8_SA(0, 1), cA + hstep, voffA);
        if (wr == 1) PG8_BAR;
        PG8_WAIT_V(2); PG8_BAR;
        PG8_STAGE(PG8_SB(1, 0), cB + kstep, voffB); PG8_STAGE(PG8_SA(1, 0), cA + kstep, voffA); PG8_STAGE(PG8_SB(1, 1), cB + hstep + kstep, voffB);
        PG8_WAIT_V(6); PG8_BAR;
    } else {
        PG8_STAGE(PG8_SB(0, 0), cB, voffB); PG8_STAGE(PG8_SA(0, 0), cA, voffA); PG8_STAGE(PG8_SB(0, 1), cB + hstep, voffB); PG8_STAGE(PG8_SA(0, 1), cA + hstep, voffA);
        if (wr == 1) PG8_BAR;
        PG8_WAIT_V(4); PG8_BAR;
        PG8_STAGE(PG8_SB(1, 0), cB + kstep, voffB); PG8_STAGE(PG8_SA(1, 0), cA + kstep, voffA); PG8_STAGE(PG8_SB(1, 1), cB + hstep + kstep, voffB);
        PG8_WAIT_V(6); PG8_BAR;
    }
    for (;;) {
        const bool has_next = S.next(ui + 1, nxt);
        const size_t nko = (has_next && nxt.kq > 0) ? nxt.kq * kqb : 0;
        const char* nA = has_next ? (const char*)g.A + (size_t)nxt.pm * tstep + nko : cA; const char* nB = has_next ? (const char*)g.Bt + (size_t)nxt.pn * tstep + nko : cB;
        const int ntu = cur.kq >= 0 ? nt / 4 : nt;
        for (int t = 0; t < ntu; t += 2) {
            const bool last = (t == ntu - 2);
            const char* a1 = cA + (size_t)(t + 1) * kstep;
            const char* a2 = last ? nA : cA + (size_t)(t + 2) * kstep; const char* b2 = last ? nB : cB + (size_t)(t + 2) * kstep;
            const char* a3 = a2 + kstep; const char* b3 = b2 + kstep;
            if (last && has_next) S.a_ready(nxt);
            if constexpr (SP2) {
            PG8_LDB(B0, 0, 0); PG8_LDB(B1, 0, 1); PG8_SCHED; PG8_LDA(At, 0, 0); PG8_STAGE(PG8_SA(1, 1), a1 + hstep, voffA);
            PG8_WAIT_V(8); PG8_WAIT_L(0); PG8_BAR; PG8_MMA(0, 0, At, B0); PG8_MMA(0, 1, At, B1); PG8_BAR; PG8_SCHED;
            PG8_LDA(At, 0, 1); PG8_STAGE(PG8_SB(0, 0), b2, voffB); PG8_STAGE(PG8_SB(0, 1), b2 + hstep, voffB); PG8_STAGE(PG8_SA(0, 0), a2, voffA);
            PG8_WAIT_V(8); PG8_WAIT_L(0); PG8_BAR; PG8_MMA(1, 0, At, B0); PG8_MMA(1, 1, At, B1); PG8_BAR; PG8_SCHED;
            PG8_LDB(B0, 1, 0); PG8_LDB(B1, 1, 1); PG8_SCHED; PG8_LDA(At, 1, 0); PG8_STAGE(PG8_SA(0, 1), a2 + hstep, voffA);
            PG8_WAIT_V(8); PG8_WAIT_L(0); PG8_BAR; PG8_MMA(0, 0, At, B0); PG8_MMA(0, 1, At, B1); PG8_BAR; PG8_SCHED;
            PG8_LDA(At, 1, 1); PG8_STAGE(PG8_SB(1, 0), b3, voffB); PG8_STAGE(PG8_SB(1, 1), b3 + hstep, voffB); PG8_STAGE(PG8_SA(1, 0), a3, voffA);
            PG8_WAIT_V(8); PG8_WAIT_L(0); PG8_BAR; PG8_MMA(1, 0, At, B0); PG8_MMA(1, 1, At, B1); PG8_BAR; PG8_SCHED;
            } else {
            PG8_LDB(B0, 0, 0); PG8_SCHED; PG8_LDA(At, 0, 0); PG8_STAGE(PG8_SA(1, 1), a1 + hstep, voffA);
            PG8_WAIT_L(8); PG8_BAR; PG8_WAIT_L(0); PG8_MMA(0, 0, At, B0); PG8_BAR; PG8_SCHED;
            PG8_LDB(B1, 0, 1); PG8_STAGE(PG8_SB(0, 0), b2, voffB);
            PG8_BAR; PG8_WAIT_L(0); PG8_MMA(0, 1, At, B1); PG8_BAR;
            PG8_LDA(At, 0, 1); PG8_STAGE(PG8_SA(0, 0), a2, voffA);
            PG8_BAR; PG8_WAIT_L(0); PG8_MMA(1, 0, At, B0); PG8_BAR; PG8_SCHED;
            PG8_STAGE(PG8_SB(0, 1), b2 + hstep, voffB);
            PG8_WAIT_V(6); PG8_BAR; PG8_MMA(1, 1, At, B1); PG8_BAR;
            PG8_LDB(B0, 1, 0); PG8_SCHED; PG8_LDA(At, 1, 0); PG8_STAGE(PG8_SA(0, 1), a2 + hstep, voffA);
            PG8_WAIT_L(8); PG8_BAR; PG8_WAIT_L(0); PG8_MMA(0, 0, At, B0); PG8_BAR; PG8_SCHED;
            PG8_LDB(B1, 1, 1); PG8_STAGE(PG8_SB(1, 0), b3, voffB);
            PG8_BAR; PG8_WAIT_L(0); PG8_MMA(0, 1, At, B1); PG8_BAR;
            PG8_LDA(At, 1, 1); PG8_STAGE(PG8_SA(1, 0), a3, voffA);
            PG8_BAR; PG8_WAIT_L(0); PG8_MMA(1, 0, At, B0); PG8_BAR; PG8_SCHED;
            PG8_STAGE(PG8_SB(1, 1), b3 + hstep, voffB);
            PG8_WAIT_V(6); PG8_BAR; PG8_MMA(1, 1, At, B1); PG8_BAR;
            }
        }
        if constexpr (ALIGN_EPI) { if (wr == 0) PG8_BAR; }
        if constexpr (!Epi::AFTER_DRAIN) { E(acc, cur, wr, wc, fr, fq); S.done(cur); }
        if (!has_next) break;
#pragma unroll
        for (int a = 0; a < 2; ++a)
#pragma unroll
            for (int b = 0; b < 2; ++b)
#pragma unroll
                for (int m = 0; m < 4; ++m)
#pragma unroll
                    for (int n = 0; n < 2; ++n) acc[a][b][m][n] = (f32x4){0.f, 0.f, 0.f, 0.f};
        cur = nxt; cA = nA; cB = nB; ++ui;
        if constexpr (ALIGN_EPI) { if (wr == 1) PG8_BAR; }
    }
    PG8_WAIT_V(0);
    if constexpr (!ALIGN_EPI) { if (wr == 0) PG8_BAR; }
    PG8_BAR;
    if constexpr (Epi::AFTER_DRAIN) { E.fused(acc, cur, wr, wc, fr, fq, lds, wid, lane); S.done(cur); }
#undef PG8_SA
#undef PG8_SB
#undef PG8_STAGE
#undef PG8_LDA
#undef PG8_LDB
#undef PG8_MMA
#undef PG8_WAIT_V
#undef PG8_WAIT_L
#undef PG8_BAR
#undef PG8_SCHED
}
}

#ifndef PG8_SP2
#define PG8_SP2 true
#endif
#ifndef PG8_ALIGN
#define PG8_ALIGN true
#endif

namespace pg8 {
__host__ __device__ __forceinline__ int swz8(int q) { return (4 - q) & 3; }
__host__ __device__ __forceinline__ void stage_rc8(int b, int& R, int& Cb) { const int blk = b >> 10, d = (b & 1023) >> 4; R = (blk >> 1) * 16 + (d >> 2); Cb = 64 * (blk & 1) + 16 * ((d & 3) ^ swz8(d >> 4)); }
typedef int v8i32 __attribute__((ext_vector_type(8)));
typedef int v4i32 __attribute__((ext_vector_type(4)));
struct Gemm8 { const unsigned char* A; const unsigned char* Bt; int M, N, K; int scale_b; const PG8_LAS unsigned short* idx; };
template <class Epi, class Sched, bool ALIGN_EPI = false, bool SP2 = false, bool GATHER = false>
__device__ __forceinline__ void gemm_phase8(PG8_LAS unsigned char* lds, const Gemm8 g, const Sched& S, const Epi& E, const int tid) {
    const int wid = __builtin_amdgcn_readfirstlane(tid >> 6), lane = tid & 63, wr = wid >> 2, wc = wid & 3, fr = lane & 15, fq = lane >> 4;
    const int K = g.K, nt = K / 128;
    unsigned voffA[2], voffB[2]; int RA[2], CA[2];
#pragma unroll
    for (int i = 0; i < 2; ++i) { int R, C; stage_rc8(tid * 16 + i * 8192, R, C); const int Rb = Epi::PERM ? ((R & ~31) + perm32(R & 31)) : R;
        voffA[i] = (unsigned)(R * K + C); voffB[i] = (unsigned)(Rb * K + C); RA[i] = R; CA[i] = C; }
    const size_t kstep = (size_t)(BK * 2);
    const size_t hstep = (size_t)HALF * K;
    const size_t tstep = 2 * hstep;
#define PG8_AOFF(dst, u) do { _Pragma("unroll") for (int h_ = 0; h_ < 2; ++h_) _Pragma("unroll") for (int i_ = 0; i_ < 2; ++i_) { \
        if constexpr (GATHER) { const int e_ = (u).pm / 9, mt_ = (u).pm - e_ * 9; const unsigned r_ = g.idx[(e_ >> 3) * 2304 + mt_ * 256 + h_ * 128 + RA[i_]]; dst[h_][i_] = r_ * (unsigned)K + (unsigned)CA[i_]; } \
        else dst[h_][i_] = voffA[i_] + (unsigned)(h_ * hstep); } } while (0)
    const unsigned ldsw = (unsigned)wid * 1024u;
    const int roff = (4 * fr + (fq ^ swz8(fr >> 2))) * 16;
    const int aoff0 = (wr * 8) * 1024 + roff, aoff1 = aoff0 + 1024, boff0 = (wc * 4) * 1024 + roff, boff1 = boff0 + 1024;
#define PG8_SA(b, h) (((b) * 2 + (h)) * HTB)
#define PG8_SB(b, h) ((4 + (b) * 2 + (h)) * HTB)
#define PG8_STAGE(bufoff, gbase, voff) do { _Pragma("unroll") for (int _i = 0; _i < 2; ++_i) \
        __builtin_amdgcn_global_load_lds((const unsigned*)((const char*)(gbase) + (voff)[_i]), (PG8_LAS unsigned*)(lds + (bufoff) + ldsw + _i * 8192), 16, 0, 0); } while (0)
#define PG8_LDA(dst, b, h) do { _Pragma("unroll") for (int m = 0; m < 4; ++m) { const v4i32 lo_ = __builtin_bit_cast(v4i32, *(const PG8_LAS bf16x8*)(lds + PG8_SA(b, h) + aoff0 + m * 2048)), hi_ = __builtin_bit_cast(v4i32, *(const PG8_LAS bf16x8*)(lds + PG8_SA(b, h) + aoff1 + m * 2048)); dst[m] = __builtin_shufflevector(lo_, hi_, 0, 1, 2, 3, 4, 5, 6, 7); } } while (0)
#define PG8_LDB(dst, b, h) do { _Pragma("unroll") for (int n = 0; n < 2; ++n) { const v4i32 lo_ = __builtin_bit_cast(v4i32, *(const PG8_LAS bf16x8*)(lds + PG8_SB(b, h) + boff0 + n * 2048)), hi_ = __builtin_bit_cast(v4i32, *(const PG8_LAS bf16x8*)(lds + PG8_SB(b, h) + boff1 + n * 2048)); dst[n] = __builtin_shufflevector(lo_, hi_, 0, 1, 2, 3, 4, 5, 6, 7); } } while (0)
#define PG8_MMA(ai, bj, At, Bt) do { __builtin_amdgcn_s_setprio(1); _Pragma("unroll") for (int m = 0; m < 4; ++m) _Pragma("unroll") for (int n = 0; n < 2; ++n) \
        asm volatile("v_mfma_scale_f32_16x16x128_f8f6f4 %0, %1, %2, %0, %3, %4 op_sel_hi:[0,0,0]" : "+v"(acc[ai][bj][m][n]) : "v"(Bt[n]), "v"(At[m]), "v"(sc_b), "v"(sc_a)); __builtin_amdgcn_s_setprio(0); } while (0)
#define PG8_ACCFENCE() do { _Pragma("unroll") for (int a_ = 0; a_ < 2; ++a_) _Pragma("unroll") for (int b_ = 0; b_ < 2; ++b_) \
        asm volatile("s_nop 15\n\ts_nop 15" : "+v"(acc[a_][b_][0][0]), "+v"(acc[a_][b_][0][1]), "+v"(acc[a_][b_][1][0]), "+v"(acc[a_][b_][1][1]), "+v"(acc[a_][b_][2][0]), "+v"(acc[a_][b_][2][1]), "+v"(acc[a_][b_][3][0]), "+v"(acc[a_][b_][3][1])); } while (0)
#define PG8_WAIT_V(n) asm volatile("s_waitcnt vmcnt(" #n ")" ::: "memory")
#define PG8_WAIT_L(n) asm volatile("s_waitcnt lgkmcnt(" #n ")" ::: "memory")
#define PG8_BAR __builtin_amdgcn_s_barrier()
#define PG8_SCHED __builtin_amdgcn_sched_barrier(0)
    const int sc_b = g.scale_b, sc_a = 0x7f7f7f7f;
    Unit cur, nxt; int ui = 0;
    if (!S.next(0, cur)) return;
    f32x4 acc[2][2][4][2];
#pragma unroll
    for (int a = 0; a < 2; ++a)
#pragma unroll
        for (int b = 0; b < 2; ++b)
#pragma unroll
            for (int m = 0; m < 4; ++m)
#pragma unroll
                for (int n = 0; n < 2; ++n) acc[a][b][m][n] = (f32x4){0.f, 0.f, 0.f, 0.f};
    v8i32 At[4], B0[2], B1[2];
    const int ktq = ((nt >> 2) + 1) & ~1;
    const char* cA = (const char*)g.A + (GATHER ? (size_t)0 : (size_t)cur.pm * tstep) + (cur.kq > 0 ? (size_t)cur.kq * ktq * 128 : 0); const char* cB = (const char*)g.Bt + (size_t)cur.pn * tstep + (cur.kq > 0 ? (size_t)cur.kq * ktq * 128 : 0);
    unsigned offA[2][2], noffA[2][2]; PG8_AOFF(offA, cur);
    S.a_ready(cur);
    if constexpr (SP2) {
        PG8_STAGE(PG8_SB(0, 0), cB, voffB); PG8_STAGE(PG8_SB(0, 1), cB + hstep, voffB); PG8_STAGE(PG8_SA(0, 0), cA, offA[0]); PG8_STAGE(PG8_SA(0, 1), cA, offA[1]);
        if (wr == 1) PG8_BAR;
        PG8_WAIT_V(2); PG8_BAR;
        PG8_STAGE(PG8_SB(1, 0), cB + kstep, voffB); PG8_STAGE(PG8_SA(1, 0), cA + kstep, offA[0]); PG8_STAGE(PG8_SB(1, 1), cB + hstep + kstep, voffB);
        PG8_WAIT_V(6); PG8_BAR;
    } else {
        PG8_STAGE(PG8_SB(0, 0), cB, voffB); PG8_STAGE(PG8_SA(0, 0), cA, offA[0]); PG8_STAGE(PG8_SB(0, 1), cB + hstep, voffB); PG8_STAGE(PG8_SA(0, 1), cA, offA[1]);
        if (wr == 1) PG8_BAR;
        PG8_WAIT_V(4); PG8_BAR;
        PG8_STAGE(PG8_SB(1, 0), cB + kstep, voffB); PG8_STAGE(PG8_SA(1, 0), cA + kstep, offA[0]); PG8_STAGE(PG8_SB(1, 1), cB + hstep + kstep, voffB);
        PG8_WAIT_V(6); PG8_BAR;
    }
    for (;;) {
        const bool has_next = S.next(ui + 1, nxt);
        const size_t nko = (has_next && nxt.kq > 0) ? (size_t)nxt.kq * ktq * 128 : 0;
        const char* nA = has_next ? (const char*)g.A + (GATHER ? (size_t)0 : (size_t)nxt.pm * tstep) + nko : cA; const char* nB = has_next ? (const char*)g.Bt + (size_t)nxt.pn * tstep + nko : cB;
        const int ntu = cur.kq < 0 ? nt : (cur.kq < 3 ? ktq : nt - 3 * ktq);
        if (has_next) { PG8_AOFF(noffA, nxt); } else { _Pragma("unroll") for (int h_ = 0; h_ < 2; ++h_) _Pragma("unroll") for (int i_ = 0; i_ < 2; ++i_) noffA[h_][i_] = offA[h_][i_]; }
        if (!S.is_small(cur)) {
        for (int t = 0; t < ntu; t += 2) {
            const bool last = (t == ntu - 2);
            const char* a1 = cA + (size_t)(t + 1) * kstep;
            const char* a2 = last ? nA : cA + (size_t)(t + 2) * kstep; const char* b2 = last ? nB : cB + (size_t)(t + 2) * kstep;
            const char* a3 = a2 + kstep; const char* b3 = b2 + kstep;
            unsigned o2[2][2]; _Pragma("unroll") for (int h_ = 0; h_ < 2; ++h_) _Pragma("unroll") for (int i_ = 0; i_ < 2; ++i_) o2[h_][i_] = last ? noffA[h_][i_] : offA[h_][i_];
            if (last && has_next) S.a_ready(nxt);
            if constexpr (SP2) {
            PG8_LDB(B0, 0, 0); PG8_LDB(B1, 0, 1); PG8_SCHED; PG8_LDA(At, 0, 0); PG8_STAGE(PG8_SA(1, 1), a1, offA[1]);
            PG8_WAIT_V(8); PG8_WAIT_L(0); PG8_BAR; PG8_MMA(0, 0, At, B0); PG8_MMA(0, 1, At, B1); PG8_BAR; PG8_SCHED;
            PG8_LDA(At, 0, 1); PG8_STAGE(PG8_SB(0, 0), b2, voffB); PG8_STAGE(PG8_SB(0, 1), b2 + hstep, voffB); PG8_STAGE(PG8_SA(0, 0), a2, o2[0]);
            PG8_WAIT_V(8); PG8_WAIT_L(0); PG8_BAR; PG8_MMA(1, 0, At, B0); PG8_MMA(1, 1, At, B1); PG8_BAR; PG8_SCHED;
            PG8_LDB(B0, 1, 0); PG8_LDB(B1, 1, 1); PG8_SCHED; PG8_LDA(At, 1, 0); PG8_STAGE(PG8_SA(0, 1), a2, o2[1]);
            PG8_WAIT_V(8); PG8_WAIT_L(0); PG8_BAR; PG8_MMA(0, 0, At, B0); PG8_MMA(0, 1, At, B1); PG8_BAR; PG8_SCHED;
            PG8_LDA(At, 1, 1); PG8_STAGE(PG8_SB(1, 0), b3, voffB); PG8_STAGE(PG8_SB(1, 1), b3 + hstep, voffB); PG8_STAGE(PG8_SA(1, 0), a3, o2[0]);
            PG8_WAIT_V(8); PG8_WAIT_L(0); PG8_BAR; PG8_MMA(1, 0, At, B0); PG8_MMA(1, 1, At, B1); PG8_BAR; PG8_SCHED;
            } else {
            PG8_LDB(B0, 0, 0); PG8_SCHED; PG8_LDA(At, 0, 0); PG8_STAGE(PG8_SA(1, 1), a1, offA[1]);
            PG8_WAIT_L(8); PG8_BAR; PG8_WAIT_L(0); PG8_MMA(0, 0, At, B0); PG8_BAR; PG8_SCHED;
            PG8_LDB(B1, 0, 1); PG8_STAGE(PG8_SB(0, 0), b2, voffB);
            PG8_BAR; PG8_WAIT_L(0); PG8_MMA(0, 1, At, B1); PG8_BAR;
            PG8_LDA(At, 0, 1); PG8_STAGE(PG8_SA(0, 0), a2, o2[0]);
            PG8_BAR; PG8_WAIT_L(0); PG8_MMA(1, 0, At, B0); PG8_BAR; PG8_SCHED;
            PG8_STAGE(PG8_SB(0, 1), b2 + hstep, voffB);
            PG8_WAIT_V(6); PG8_BAR; PG8_MMA(1, 1, At, B1); PG8_BAR;
            PG8_LDB(B0, 1, 0); PG8_SCHED; PG8_LDA(At, 1, 0); PG8_STAGE(PG8_SA(0, 1), a2, o2[1]);
            PG8_WAIT_L(8); PG8_BAR; PG8_WAIT_L(0); PG8_MMA(0, 0, At, B0); PG8_BAR; PG8_SCHED;
            PG8_LDB(B1, 1, 1); PG8_STAGE(PG8_SB(1, 0), b3, voffB);
            PG8_BAR; PG8_WAIT_L(0); PG8_MMA(0, 1, At, B1); PG8_BAR;
            PG8_LDA(At, 1, 1); PG8_STAGE(PG8_SA(1, 0), a3, o2[0]);
            PG8_BAR; PG8_WAIT_L(0); PG8_MMA(1, 0, At, B0); PG8_BAR; PG8_SCHED;
            PG8_STAGE(PG8_SB(1, 1), b3 + hstep, voffB);
            PG8_WAIT_V(6); PG8_BAR; PG8_MMA(1, 1, At, B1); PG8_BAR;
            }
        }
        } else {
        for (int t = 0; t < ntu; t += 2) {
            const bool last = (t == ntu - 2);
            const char* a1 = cA + (size_t)(t + 1) * kstep;
            const char* a2 = last ? nA : cA + (size_t)(t + 2) * kstep; const char* b2 = last ? nB : cB + (size_t)(t + 2) * kstep;
            const char* a3 = a2 + kstep; const char* b3 = b2 + kstep;
            unsigned o2[2][2]; _Pragma("unroll") for (int h_ = 0; h_ < 2; ++h_) _Pragma("unroll") for (int i_ = 0; i_ < 2; ++i_) o2[h_][i_] = last ? noffA[h_][i_] : offA[h_][i_];
            if (last && has_next) S.a_ready(nxt);
            if constexpr (SP2) {
            PG8_LDB(B0, 0, 0); PG8_LDB(B1, 0, 1); PG8_SCHED; PG8_LDA(At, 0, 0); PG8_STAGE(PG8_SA(1, 1), a1, offA[1]);
            PG8_WAIT_V(8); PG8_WAIT_L(0); PG8_BAR; if (wr == 0) PG8_MMA(0, 0, At, B0); if (wr == 0) PG8_MMA(0, 1, At, B1); PG8_BAR; PG8_SCHED;
            PG8_LDA(At, 0, 1); PG8_STAGE(PG8_SB(0, 0), b2, voffB); PG8_STAGE(PG8_SB(0, 1), b2 + hstep, voffB); PG8_STAGE(PG8_SA(0, 0), a2, o2[0]);
            PG8_WAIT_V(8); PG8_WAIT_L(0); PG8_BAR;   PG8_BAR; PG8_SCHED;
            PG8_LDB(B0, 1, 0); PG8_LDB(B1, 1, 1); PG8_SCHED; PG8_LDA(At, 1, 0); PG8_STAGE(PG8_SA(0, 1), a2, o2[1]);
            PG8_WAIT_V(8); PG8_WAIT_L(0); PG8_BAR; if (wr == 0) PG8_MMA(0, 0, At, B0); if (wr == 0) PG8_MMA(0, 1, At, B1); PG8_BAR; PG8_SCHED;
            PG8_LDA(At, 1, 1); PG8_STAGE(PG8_SB(1, 0), b3, voffB); PG8_STAGE(PG8_SB(1, 1), b3 + hstep, voffB); PG8_STAGE(PG8_SA(1, 0), a3, o2[0]);
            PG8_WAIT_V(8); PG8_WAIT_L(0); PG8_BAR;   PG8_BAR; PG8_SCHED;
            } else {
            PG8_LDB(B0, 0, 0); PG8_SCHED; PG8_LDA(At, 0, 0); PG8_STAGE(PG8_SA(1, 1), a1, offA[1]);
            PG8_WAIT_L(8); PG8_BAR; PG8_WAIT_L(0); if (wr == 0) PG8_MMA(0, 0, At, B0); PG8_BAR; PG8_SCHED;
            PG8_LDB(B1, 0, 1); PG8_STAGE(PG8_SB(0, 0), b2, voffB);
            PG8_BAR; PG8_WAIT_L(0); if (wr == 0) PG8_MMA(0, 1, At, B1); PG8_BAR;
            PG8_LDA(At, 0, 1); PG8_STAGE(PG8_SA(0, 0), a2, o2[0]);
            PG8_BAR; PG8_WAIT_L(0);  PG8_BAR; PG8_SCHED;
            PG8_STAGE(PG8_SB(0, 1), b2 + hstep, voffB);
            PG8_WAIT_V(6); PG8_BAR;  PG8_BAR;
            PG8_LDB(B0, 1, 0); PG8_SCHED; PG8_LDA(At, 1, 0); PG8_STAGE(PG8_SA(0, 1), a2, o2[1]);
            PG8_WAIT_L(8); PG8_BAR; PG8_WAIT_L(0); if (wr == 0) PG8_MMA(0, 0, At, B0); PG8_BAR; PG8_SCHED;
            PG8_LDB(B1, 1, 1); PG8_STAGE(PG8_SB(1, 0), b3, voffB);
            PG8_BAR; PG8_WAIT_L(0); if (wr == 0) PG8_MMA(0, 1, At, B1); PG8_BAR;
            PG8_LDA(At, 1, 1); PG8_STAGE(PG8_SA(1, 0), a3, o2[0]);
            PG8_BAR; PG8_WAIT_L(0);  PG8_BAR; PG8_SCHED;
            PG8_STAGE(PG8_SB(1, 1), b3 + hstep, voffB);
            PG8_WAIT_V(6); PG8_BAR;  PG8_BAR;
            }
        }
        }
        if constexpr (ALIGN_EPI) { if (wr == 0) PG8_BAR; }
        PG8_ACCFENCE();
        if constexpr (!Epi::AFTER_DRAIN) { E(acc, cur, wr, wc, fr, fq); S.done(cur); }
        if (!has_next) break;
#pragma unroll
        for (int a = 0; a < 2; ++a)
#pragma unroll
            for (int b = 0; b < 2; ++b)
#pragma unroll
                for (int m = 0; m < 4; ++m)
#pragma unroll
                    for (int n = 0; n < 2; ++n) acc[a][b][m][n] = (f32x4){0.f, 0.f, 0.f, 0.f};
        cur = nxt; cA = nA; cB = nB; ++ui;
        _Pragma("unroll") for (int h_ = 0; h_ < 2; ++h_) _Pragma("unroll") for (int i_ = 0; i_ < 2; ++i_) offA[h_][i_] = noffA[h_][i_];
        if constexpr (ALIGN_EPI) { if (wr == 1) PG8_BAR; }
    }
    PG8_WAIT_V(0);
    if constexpr (!ALIGN_EPI) { if (wr == 0) PG8_BAR; }
    PG8_BAR;
    if constexpr (Epi::AFTER_DRAIN) { E.fused(acc, cur, wr, wc, fr, fq, lds, wid, lane); S.done(cur); }
#undef PG8_SA
#undef PG8_SB
#undef PG8_STAGE
#undef PG8_LDA
#undef PG8_LDB
#undef PG8_MMA
#undef PG8_AOFF
#undef PG8_ACCFENCE
#undef PG8_WAIT_V
#undef PG8_WAIT_L
#undef PG8_BAR
#undef PG8_SCHED
}
}

#include <hip/hip_bf16.h>
#include <cmath>
namespace attn_body {
using bf16=__hip_bfloat16;
using bf16x8=__attribute__((ext_vector_type(8)))short;
using s16x4=__attribute__((ext_vector_type(4)))short;
using f32x16=__attribute__((ext_vector_type(16)))float;
using u32x4=__attribute__((ext_vector_type(4)))unsigned;
constexpr int BATCH=2,NHEAD=16,SEQ=8192,D=64,DM=NHEAD*D;
constexpr int NW=8,QBLK=32,QB=QBLK*NW,KVBLK=64,NQB=SEQ/QB;
constexpr int ATTN_PITCH=DM, ATTN_UNIT_ROWS=QB;
__device__ __forceinline__ int crow(int r,int hi){return (r&3)+8*(r>>2)+4*hi;}
#define SBAR() __builtin_amdgcn_sched_barrier(0)
__device__ __forceinline__ void cmask(f32x16&p0,f32x16&p1,int jb,int qrel,int hi){
  const float NEG=-INFINITY; int kb=64*jb+4*hi;
  #pragma unroll
  for(int r=0;r<16;++r){int kv=kb+(r&3)+8*(r>>2); if(kv>qrel)p0[r]=NEG; if(kv+32>qrel)p1[r]=NEG;}
}

constexpr int NSLOT=3, SLOTB=8192;
constexpr int LDS_K=0, LDS_V=NSLOT*SLOTB, LDS_WS=2*NSLOT*SLOTB, LDS_OST=LDS_WS+NW*64*4, LDS_BYTES=LDS_OST+NW*4096;
constexpr float C2=0.125f*1.4426950408889634f;
__device__ __forceinline__ void glds16(const void*gsrc,unsigned lds_dst){unsigned keep;
  asm volatile("s_mov_b32 %0, m0\n\ts_mov_b32 m0, %2\n\ts_nop 0\n\tglobal_load_lds_dwordx4 %1, off\n\ts_mov_b32 m0, %0":"=&s"(keep):"v"(gsrc),"s"(lds_dst):"memory");}
__device__ __forceinline__ float max3f(float a,float b,float c){float r;asm("v_max3_f32 %0, %1, %2, %3":"=v"(r):"v"(a),"v"(b),"v"(c));return r;}
__device__ __forceinline__ float max2f(float a,float b){float r;asm("v_max_f32_e32 %0, %1, %2":"=v"(r):"v"(a),"v"(b));return r;}
__device__ __forceinline__ float fadd_s(float a,float b){float r;asm("v_add_f32_e32 %0, %1, %2":"=v"(r):"v"(a),"v"(b));return r;}
__device__ __forceinline__ float fsub_s(float a,float b){float r;asm("v_sub_f32_e32 %0, %1, %2":"=v"(r):"v"(a),"v"(b));return r;}
typedef float f32x2_t __attribute__((ext_vector_type(2))); typedef __bf16 bf16x2_t __attribute__((ext_vector_type(2)));
__device__ __forceinline__ unsigned cvtpk_s(float lo,float hi){f32x2_t v={lo,hi};bf16x2_t b=__builtin_convertvector(v,bf16x2_t);return __builtin_bit_cast(unsigned,b);}
#define WAIT_BAR(N) asm volatile("s_waitcnt vmcnt(" #N ") lgkmcnt(0)\n\ts_barrier":::"memory")

__device__ __forceinline__ void qkt(f32x16&p0,f32x16&p1,const char*Kslot,const bf16x8*qr,const f32x16&negm,int r32,int hi){
  const char*kb=Kslot+hi*1024+r32*16;
  #pragma unroll
  for(int d0=0;d0<4;++d0){
    const bf16x8 b0=*reinterpret_cast<const bf16x8*>(kb+d0*2048);
    const bf16x8 b1=*reinterpret_cast<const bf16x8*>(kb+d0*2048+512);
    if(d0==0){p0=__builtin_amdgcn_mfma_f32_32x32x16_bf16(b0,qr[0],negm,0,0,0);p1=__builtin_amdgcn_mfma_f32_32x32x16_bf16(b1,qr[0],negm,0,0,0);}
    else{p0=__builtin_amdgcn_mfma_f32_32x32x16_bf16(b0,qr[d0],p0,0,0,0);p1=__builtin_amdgcn_mfma_f32_32x32x16_bf16(b1,qr[d0],p1,0,0,0);}}
}
typedef __attribute__((address_space(3))) const char* lds_cptr;
typedef short v4i16_t __attribute__((ext_vector_type(4)));
__device__ __forceinline__ void kload8(bf16x8*kf,lds_cptr kp){
  kf[0]=*(const __attribute__((address_space(3))) bf16x8*)(kp);      kf[1]=*(const __attribute__((address_space(3))) bf16x8*)(kp+512);
  kf[2]=*(const __attribute__((address_space(3))) bf16x8*)(kp+2048); kf[3]=*(const __attribute__((address_space(3))) bf16x8*)(kp+2560);
  kf[4]=*(const __attribute__((address_space(3))) bf16x8*)(kp+4096); kf[5]=*(const __attribute__((address_space(3))) bf16x8*)(kp+4608);
  kf[6]=*(const __attribute__((address_space(3))) bf16x8*)(kp+6144); kf[7]=*(const __attribute__((address_space(3))) bf16x8*)(kp+6656);
}
__device__ __forceinline__ void kload2(bf16x8*kf,lds_cptr kp,int j){ kf[2*j]=*(const __attribute__((address_space(3))) bf16x8*)(kp+j*2048); kf[2*j+1]=*(const __attribute__((address_space(3))) bf16x8*)(kp+j*2048+512); }
__device__ __forceinline__ s16x4 vtr(lds_cptr p){ return __builtin_bit_cast(s16x4,__builtin_amdgcn_ds_read_tr16_b64_v4i16((__attribute__((address_space(3))) v4i16_t*)p)); }
__device__ __forceinline__ float rowmax(const f32x16&p0,const f32x16&p1){
  float a=max3f(p0[0],p0[1],p1[0]),b=max3f(p0[2],p0[3],p1[1]);a=max3f(a,p1[2],p1[3]);
  #pragma unroll
  for(int r=4;r<16;r+=4){a=max3f(a,p0[r],p0[r+1]);b=max3f(b,p0[r+2],p0[r+3]);a=max3f(a,p1[r],p1[r+1]);b=max3f(b,p1[r+2],p1[r+3]);}
  const float m=max2f(a,b);
  auto rr=__builtin_amdgcn_permlane32_swap(__float_as_uint(m),__float_as_uint(m),false,false);
  return max2f(__uint_as_float(rr[0]),__uint_as_float(rr[1]));
}
__device__ __forceinline__ void pv(f32x16*o,int vb,bf16x8 pa0,bf16x8 pa1,bf16x8 pa2,bf16x8 pa3){
  #pragma unroll
  for(int d0=0;d0<2;++d0){s16x4 lo[4],hi[4];
    #pragma unroll
    for(int ks=0;ks<4;++ks){
      asm volatile("ds_read_b64_tr_b16 %0,%1 offset:%c2":"=&v"(lo[ks]):"v"(vb),"i"(d0*4096+ks*1024):"memory");
      asm volatile("ds_read_b64_tr_b16 %0,%1 offset:%c2":"=&v"(hi[ks]):"v"(vb),"i"(d0*4096+ks*1024+512):"memory");}
    asm volatile("s_waitcnt lgkmcnt(0)":::"memory");SBAR();
    #define PK(k) (bf16x8){lo[k][0],lo[k][1],lo[k][2],lo[k][3],hi[k][0],hi[k][1],hi[k][2],hi[k][3]}
    o[d0]=__builtin_amdgcn_mfma_f32_32x32x16_bf16(pa0,PK(0),o[d0],0,0,0);
    o[d0]=__builtin_amdgcn_mfma_f32_32x32x16_bf16(pa1,PK(1),o[d0],0,0,0);
    o[d0]=__builtin_amdgcn_mfma_f32_32x32x16_bf16(pa2,PK(2),o[d0],0,0,0);
    o[d0]=__builtin_amdgcn_mfma_f32_32x32x16_bf16(pa3,PK(3),o[d0],0,0,0);
    #undef PK
  }
}

#ifndef ATTN_STORE16
#define ATTN_STORE16(p,v) (*(u32x4*)(p)=(v))
#endif
template<int THRL> __device__ __forceinline__ void attn_unit(const bf16*Qbase,const int QP,const bf16*__restrict__ Kh,const bf16*__restrict__ Vh,const int KP,const int VP,const int NT,bf16*Obase,const int OP,char*shm,const int tid){
  const int lane=tid&63,r32=lane&31,hi=lane>>5; const int wid=__builtin_amdgcn_readfirstlane(tid>>6);
  const bf16*Qw=Qbase+(long)(wid*QBLK)*QP;
  const unsigned lds0=(unsigned)(uintptr_t)shm;
  float*wsf=(float*)(shm+LDS_WS)+wid*64;
  const bf16*ksrc=Kh+(long)lane*KP+wid*8;
  const bf16*vsrc=Vh+(long)(16*(wid&3)+(lane>>2))*VP+(wid>>2)*32+(lane&3)*8;
  const unsigned kdst=lds0+LDS_K+wid*1024, vdst=lds0+LDS_V+wid*1024;
  #define DMA_K(t,slot) glds16(ksrc+(long)(t)*KVBLK*KP,(unsigned)__builtin_amdgcn_readfirstlane(kdst+(slot)))
  #define DMA_V(t,slot) glds16(vsrc+(long)(t)*KVBLK*VP,(unsigned)__builtin_amdgcn_readfirstlane(vdst+(slot)))
  const int vb0=(int)(lds0+LDS_V)+((lane>>4)&1)*32+(lane&3)*8+(4*hi+((lane&15)>>2))*64;
  const char*Kbase=shm+LDS_K; bf16x8 kf[8];
  const lds_cptr shm3=(lds_cptr)shm; const lds_cptr kp0=shm3+LDS_K+hi*1024+r32*16; const lds_cptr vp0=shm3+LDS_V+((lane>>4)&1)*32+(lane&3)*8+(4*hi+((lane&15)>>2))*64;
  DMA_K(0,0);DMA_V(0,0);DMA_K(1,SLOTB);
  bf16x8 qr[4];
  #pragma unroll
  for(int d0=0;d0<4;++d0)qr[d0]=*reinterpret_cast<const bf16x8*>(&Qw[(long)r32*QP+d0*16+hi*8]);
  f32x16 o[2];o[0]=f32x16{};o[1]=f32x16{};f32x16 o2=f32x16{};const bf16x8 ones8={0x3F80,0x3F80,0x3F80,0x3F80,0x3F80,0x3F80,0x3F80,0x3F80};    float zl_=0.f;asm volatile("":"+v"(zl_));f32x16 negm;
  _Pragma("unroll") for(int r=0;r<16;++r)negm[r]=zl_;
  asm volatile("":"+v"(negm));
  #define CMASK(P0,P1,t) do{}while(0)
  #define START(P0,P1) do{ _Pragma("unroll") for(int r=0;r<16;++r)P0[r]=__builtin_amdgcn_exp2f(P0[r]); }while(0)
  #define RESC() do{}while(0)
  f32x16 pA0,pA1,pB0,pB1;
  int sl_prev=0,sl_cur=0,sl_next=SLOTB;
  #define ROT() do{sl_prev=sl_cur;sl_cur=sl_next;sl_next=(sl_next==(NSLOT-1)*SLOTB)?0:sl_next+SLOTB;}while(0)
  DMA_K(2,2*SLOTB);
  WAIT_BAR(3);
  qkt(pA0,pA1,Kbase,qr,negm,r32,hi);asm volatile("s_nop 15\n\ts_nop 7":"+v"(pA0),"+v"(pA1));CMASK(pA0,pA1,0);
  START(pA0,pA1);
  _Pragma("unroll") for(int r=0;r<16;++r)pA1[r]=__builtin_amdgcn_exp2f(pA1[r]);
  WAIT_BAR(0);
  DMA_K(3,0);DMA_V(1,SLOTB);
  ROT();
  kload8(kf,kp0+sl_cur);
  WAIT_BAR(2);
  s16x4 vlo[8],vhi[8]; u32x4 pw0,pw1,pw2,pw3;
  #define PKW(P,B) cvtpk_s(P[B],P[B+1])
  #define PAF(k) __builtin_bit_cast(bf16x8,pw##k)
  #define VFR(i) (bf16x8){vlo[i][0],vlo[i][1],vlo[i][2],vlo[i][3],vhi[i][0],vhi[i][1],vhi[i][2],vhi[i][3]}
  #define PIN(x) asm volatile("":"+v"(x))
  #define MX3(a,b,c) __builtin_fmaxf(__builtin_fmaxf((a),(b)),(c))
  #define GAPA(MF,A0,A1,A2,A3,W0,W1,PW) do{ MF; W0; W1; PIN(PW); SBAR(); }while(0)
  #define EX(v) __builtin_amdgcn_exp2f(v)
  #define GAPB(MF,X,B) do{ MF; X[B]=EX(X[B]); X[B+1]=EX(X[B+1]); X[B+2]=EX(X[B+2]); X[B+3]=EX(X[B+3]); PIN(X); SBAR(); }while(0)
  #define VRD(i) do{ vlo[i]=vtr(vp_+(((i)>>2)*4096+((i)&3)*1024)); vhi[i]=vtr(vp_+(((i)>>2)*4096+((i)&3)*1024+512)); }while(0)
  #define KRD(G,j) do{ if(G){ kload2(kf,kp0+sl_next,j); SBAR(); } }while(0)
  #define STEP(C0,C1,P0,P1,t,GK,GV,GL) do{ SBAR(); \
    const lds_cptr vp_=vp0+sl_prev; \
    VRD(0); SBAR(); \
    GAPA(C0=__builtin_amdgcn_mfma_f32_32x32x16_bf16(kf[0],qr[0],negm,0,0,0), P0[2],P0[3],P0[4],P0[5],     pw0[0]=PKW(P0,0), pw0[1]=PKW(P0,2), pw0); \
    VRD(4); SBAR(); GAPA(C1=__builtin_amdgcn_mfma_f32_32x32x16_bf16(kf[1],qr[0],negm,0,0,0), P0[6],P0[7],P0[8],P0[9],     pw0[2]=PKW(P0,4), pw0[3]=PKW(P0,6), pw0); \
    VRD(1); SBAR(); GAPA(C0=__builtin_amdgcn_mfma_f32_32x32x16_bf16(kf[2],qr[1],C0,0,0,0),   P0[10],P0[11],P0[12],P0[13], pw1[0]=PKW(P0,8), pw1[1]=PKW(P0,10), pw1); \
    VRD(5); SBAR(); GAPA(C1=__builtin_amdgcn_mfma_f32_32x32x16_bf16(kf[3],qr[1],C1,0,0,0),   P0[14],P0[15],P1[0],P1[1],   pw1[2]=PKW(P0,12),pw1[3]=PKW(P0,14), pw1); \
    VRD(2); SBAR(); GAPA(C0=__builtin_amdgcn_mfma_f32_32x32x16_bf16(kf[4],qr[2],C0,0,0,0),   P1[2],P1[3],P1[4],P1[5],     pw2[0]=PKW(P1,0), pw2[1]=PKW(P1,2), pw2); \
    VRD(6); SBAR(); GAPA(C1=__builtin_amdgcn_mfma_f32_32x32x16_bf16(kf[5],qr[2],C1,0,0,0),   P1[6],P1[7],P1[8],P1[9],     pw2[2]=PKW(P1,4), pw2[3]=PKW(P1,6), pw2); \
    VRD(3); SBAR(); GAPA(C0=__builtin_amdgcn_mfma_f32_32x32x16_bf16(kf[6],qr[3],C0,0,0,0),   P1[10],P1[11],P1[12],P1[13], pw3[0]=PKW(P1,8), pw3[1]=PKW(P1,10), pw3); \
    VRD(7); SBAR(); GAPA(C1=__builtin_amdgcn_mfma_f32_32x32x16_bf16(kf[7],qr[3],C1,0,0,0),   P1[14],P1[15],0.f,0.f,       pw3[2]=PKW(P1,12),pw3[3]=PKW(P1,14), pw3); \
    if(GK){DMA_K((t)+3,sl_cur);} if(GV){DMA_V((t)+1,sl_next);} \
    CMASK(C0,C1,t); \
    SBAR(); \
    GAPB(o[0]=__builtin_amdgcn_mfma_f32_32x32x16_bf16(PAF(0),VFR(0),o[0],0,0,0), C0,0); \
    GAPB(o[1]=__builtin_amdgcn_mfma_f32_32x32x16_bf16(PAF(0),VFR(4),o[1],0,0,0), C0,4); \
    o2=__builtin_amdgcn_mfma_f32_32x32x16_bf16(PAF(0),ones8,o2,0,0,0); SBAR(); \
    KRD(GL,0); GAPB(o[0]=__builtin_amdgcn_mfma_f32_32x32x16_bf16(PAF(1),VFR(1),o[0],0,0,0), C0,8); \
    KRD(GL,1); GAPB(o[1]=__builtin_amdgcn_mfma_f32_32x32x16_bf16(PAF(1),VFR(5),o[1],0,0,0), C0,12); \
    o2=__builtin_amdgcn_mfma_f32_32x32x16_bf16(PAF(1),ones8,o2,0,0,0); SBAR(); \
    KRD(GL,2); GAPB(o[0]=__builtin_amdgcn_mfma_f32_32x32x16_bf16(PAF(2),VFR(2),o[0],0,0,0), C1,0); \
    KRD(GL,3); GAPB(o[1]=__builtin_amdgcn_mfma_f32_32x32x16_bf16(PAF(2),VFR(6),o[1],0,0,0), C1,4); \
    o2=__builtin_amdgcn_mfma_f32_32x32x16_bf16(PAF(2),ones8,o2,0,0,0); SBAR(); \
    GAPB(o[0]=__builtin_amdgcn_mfma_f32_32x32x16_bf16(PAF(3),VFR(3),o[0],0,0,0), C1,8); \
    GAPB(o[1]=__builtin_amdgcn_mfma_f32_32x32x16_bf16(PAF(3),VFR(7),o[1],0,0,0), C1,12); \
    o2=__builtin_amdgcn_mfma_f32_32x32x16_bf16(PAF(3),ones8,o2,0,0,0); SBAR(); \
    }while(0)
  int t=1;
  #undef CMASK
  #define CMASK(P0,P1,t) do{}while(0)
  for(;t+5<NT;t+=2){
    STEP(pB0,pB1,pA0,pA1,t,true,true,true);     WAIT_BAR(2); RESC(); ROT();
    STEP(pA0,pA1,pB0,pB1,t+1,true,true,true);   WAIT_BAR(2); RESC(); ROT();
  }
  #undef CMASK
  #define CMASK(P0,P1,t) do{}while(0)
  #define ENDW(tt) do{ if((tt)+3<NT){WAIT_BAR(2);} else if((tt)+2<NT){WAIT_BAR(1);} else {WAIT_BAR(0);} }while(0)
  for(;t+1<NT;t+=2){
    STEP(pB0,pB1,pA0,pA1,t,(t+3<NT),(t+1<NT),(t+1<NT));       ENDW(t);   RESC(); ROT();
    STEP(pA0,pA1,pB0,pB1,t+1,(t+4<NT),(t+2<NT),(t+2<NT));     ENDW(t+1); RESC(); ROT();
  }
  STEP(pB0,pB1,pA0,pA1,NT-1,false,false,false); RESC();
  {
    pw0=(u32x4){PKW(pB0,0),PKW(pB0,2),PKW(pB0,4),PKW(pB0,6)};pw1=(u32x4){PKW(pB0,8),PKW(pB0,10),PKW(pB0,12),PKW(pB0,14)};pw2=(u32x4){PKW(pB1,0),PKW(pB1,2),PKW(pB1,4),PKW(pB1,6)};pw3=(u32x4){PKW(pB1,8),PKW(pB1,10),PKW(pB1,12),PKW(pB1,14)};
    SBAR(); pv(o,vb0+sl_cur,PAF(0),PAF(1),PAF(2),PAF(3));
    o2=__builtin_amdgcn_mfma_f32_32x32x16_bf16(PAF(0),ones8,o2,0,0,0);o2=__builtin_amdgcn_mfma_f32_32x32x16_bf16(PAF(1),ones8,o2,0,0,0);o2=__builtin_amdgcn_mfma_f32_32x32x16_bf16(PAF(2),ones8,o2,0,0,0);o2=__builtin_amdgcn_mfma_f32_32x32x16_bf16(PAF(3),ones8,o2,0,0,0); }
  #undef PKW
  #undef PAF
  #undef VFR
  #undef PIN
  #undef MX3
  #undef GAPA
  #undef GAPB
  #undef EX
  #undef VRD
  #undef KRD
  #undef STEP
  #undef ENDW
  float rli[16];
  #pragma unroll
  for(int r=0;r<16;++r)rli[r]=__builtin_amdgcn_rcpf(o2[r]);
  bf16*Ow=Obase+(long)(wid*QBLK)*OP;
  { bf16*stg=(bf16*)(shm+LDS_OST)+wid*2048;
    #pragma unroll
    for(int r=0;r<16;++r){const int orow=crow(r,hi);
      #pragma unroll
      for(int d0=0;d0<2;++d0)stg[orow*64+d0*32+r32]=__float2bfloat16(o[d0][r]*rli[r]);}
    asm volatile("s_waitcnt lgkmcnt(0)":::"memory");
    #pragma unroll
    for(int i=0;i<4;++i){const int row=i*8+(lane>>3),ch=lane&7; const u32x4 v=*(const u32x4*)(stg+row*64+ch*8); ATTN_STORE16(Ow+(long)row*OP+ch*8,v);} }
  asm volatile("s_waitcnt lgkmcnt(0)\n\ts_barrier":::"memory");
  #undef DMA_K
  #undef DMA_V
  #undef CMASK
  #undef START
  #undef RESC
  #undef ROT
}
constexpr int ATTN_LDS_BYTES=LDS_BYTES;
#undef SBAR
#undef WAIT_BAR
}

constexpr int DM = 1024, NB = 2, SEQ = 8192, CTXL = 256, SB = SEQ + CTXL, MT = NB * SB, DEPTH = 2;
constexpr int NIN = 2576, NWIN = 2816, NP1 = 1792, NQK = 640;
constexpr int C_MQ = 0, C_MK = 256, C_MV = 512, C_MO = 768, C_AQ = 1024, C_AK = 1536, C_AV = 1664;
constexpr int NE = 16, FF = 2816, ROWS_E = 2304, NT1 = 22;
constexpr int NFFT = 16384;
constexpr int HFS = NFFT / 2 + 8;
constexpr float LN_EPS = 1e-5f, RMS_EPS = 1e-6f, ALPHA = 1.41421356237309515f;
constexpr float W1_MUL = 64.f, W2_MUL = 256.f; constexpr int W1_SCALE = 0x79797979, W2_SCALE = 0x77777777;
constexpr int SST = 4224;
constexpr int NPOS = 66;

constexpr size_t MiB = 1u << 20;
constexpr size_t WS_CTL = 0, CTL_ZERO_BYTES = 64 * 1024;
constexpr size_t WS_MODP = 1 * MiB, WS_MOD = 4 * MiB, WS_TW = 6 * MiB, WS_HID = 7 * MiB, WS_TAPC = 12 * MiB;
constexpr size_t WS_ROPE = 14 * MiB;
constexpr size_t WS_GS = 1 * MiB;
constexpr size_t WS_MIXP = 8 * MiB;
constexpr size_t WS_WINT = 16 * MiB, WS_WOUTT = 28 * MiB, WS_HF = 32 * MiB, WS_W1T = 160 * MiB, WS_W2T = 512 * MiB, WS_HN = 688 * MiB;
constexpr size_t WS_R = 722 * MiB;
constexpr size_t WS_P1 = WS_R, WS_HY = WS_R + 58 * MiB, WS_SLOC = WS_R + 108 * MiB, WS_SCAR = WS_R + 126 * MiB, WS_Y = WS_R + 144 * MiB, WS_MIX = WS_R + 178 * MiB;
constexpr size_t WS_TAPS = WS_R;
constexpr size_t WS_Z1 = WS_R + 250 * MiB;
constexpr size_t WS_ACT = WS_R + 72 * MiB, WS_YE = WS_R + 270 * MiB;
constexpr size_t WS_YEP = WS_R + 344 * MiB;
constexpr size_t WS_XS = WS_R + 414 * MiB, WS_XS2 = WS_XS + 66 * MiB, WS_QKP = WS_XS2 + 66 * MiB, WS_AFF = WS_QKP + 22 * MiB, WS_GT = WS_AFF + 2 * MiB, WS_INV = WS_GT + 2 * MiB, WS_IDX = WS_INV + 2 * MiB, WS_VAL = WS_IDX + 1 * MiB, WS_END = WS_VAL + 1 * MiB;
static_assert(WS_END <= 1408 * MiB, "workspace");
static_assert((size_t)MT * NP1 * 2 <= 58 * MiB && (size_t)NB * 768 * SB * 4 <= 50 * MiB && (size_t)16 * NPOS * SST * 4 <= 18 * MiB && (size_t)MT * DM * 2 <= 34 * MiB && (size_t)MT * DM * 4 <= 66 * MiB, "mix region");
static_assert((size_t)NE * ROWS_E * FF <= 198 * MiB && (size_t)NE * ROWS_E * DM * 2 <= 144 * MiB, "moe region");
static_assert(WS_MIX + 66 * MiB <= WS_XS, "mix region end");

constexpr int RING_OFF = 0;
constexpr int IDXL_OFF = 131072;
constexpr int LDSX_OFF = 139264;
constexpr int LDSCTL_OFF = 143360, MISC_OFF = LDSCTL_OFF + 320;
constexpr int LDS_BYTES = 147456;
constexpr int NWAVES = 8, NTHR = 512;
constexpr int CW_SEL = 8192 + 1024;

#define GAS __attribute__((address_space(1)))
#define LAS __attribute__((address_space(3)))
typedef unsigned short bf16;
typedef unsigned v4u __attribute__((ext_vector_type(4)));
typedef float f32x4 __attribute__((ext_vector_type(4)));
typedef short bf16x8 __attribute__((ext_vector_type(8)));
typedef GAS unsigned gu32;
typedef GAS unsigned long long gu64;
#define RLX_AGENT __ATOMIC_RELAXED, __HIP_MEMORY_SCOPE_AGENT
#define LDS_WAIT() asm volatile("s_waitcnt lgkmcnt(0)" ::: "memory")
#define VM_WAIT() asm volatile("s_waitcnt vmcnt(0)" ::: "memory")
__device__ __forceinline__ unsigned long long rt() { return __builtin_amdgcn_s_memrealtime(); }
__device__ __forceinline__ unsigned f2bf(float f) { unsigned u = __builtin_bit_cast(unsigned, f); return (u + 0x7fffu + ((u >> 16) & 1u)) >> 16; }
__device__ __forceinline__ unsigned pk2(float lo, float hi) { return f2bf(lo) | (f2bf(hi) << 16); }

#define XB_TMO      128
#define XB_XCNT(j)  (256  + 64 * (j))
#define XB_XSUB(j)  (1280 + 64 * (j))
#define XB_XGEN(j)  (2304 + 64 * (j))
#define XB_TOP      3328
#define XB_TOPGEN   3392
#define XCD_BAR_WORDS 3456
#define XB_SPIN_CAP (1u << 18)

__device__ __forceinline__ unsigned xb_ld(unsigned* p)              { return __hip_atomic_load(p, __ATOMIC_RELAXED, __HIP_MEMORY_SCOPE_AGENT); }
__device__ __forceinline__ unsigned xb_add(unsigned* p, unsigned v) { return __hip_atomic_fetch_add(p, v, __ATOMIC_RELAXED, __HIP_MEMORY_SCOPE_AGENT); }
__device__ __forceinline__ unsigned xb_xcc_id() { return (unsigned)__builtin_amdgcn_s_getreg((3 << 11) | 20) & 0xFu; }
#define XB_SPIN(cond, bar) do { unsigned _sp = 0; while (cond) { __builtin_amdgcn_s_sleep(1); \
    if ((++_sp & 255u) == 0u) { if (xb_ld(&(bar)[XB_TMO])) break; if (_sp > XB_SPIN_CAP) { atomicAdd(&(bar)[XB_TMO], 1u); break; } } } } while (0)

struct XcdBarrier {
    unsigned* bar; unsigned x;
    volatile LAS unsigned* st;
};

__device__ __forceinline__ XcdBarrier xcd_barrier_post(unsigned* bar, volatile LAS unsigned* st) {
    XcdBarrier b; b.bar = bar; b.x = xb_xcc_id(); b.st = st;
    if (threadIdx.x == 0) (void)xb_add(&bar[XB_XCNT(b.x)], 1u);
    return b;
}
__device__ __forceinline__ void xcd_barrier_complete(unsigned* bar, unsigned x, unsigned& nloc, unsigned& nx) {
    const unsigned G = gridDim.x * gridDim.y * gridDim.z;
    unsigned sum, cnt, mine, sp = 0u;
    for (;;) {
        sum = 0u; cnt = 0u; mine = 0u;
        unsigned cv[16];
#pragma unroll
        for (unsigned j = 0; j < 16; ++j) asm volatile("global_load_dword %0, %1, off sc1" : "=v"(cv[j]) : "v"(&bar[XB_XCNT(j)]) : "memory");
        asm volatile("s_waitcnt vmcnt(0)" : "+v"(cv[0]), "+v"(cv[1]), "+v"(cv[2]), "+v"(cv[3]), "+v"(cv[4]), "+v"(cv[5]), "+v"(cv[6]), "+v"(cv[7]), "+v"(cv[8]), "+v"(cv[9]), "+v"(cv[10]), "+v"(cv[11]), "+v"(cv[12]), "+v"(cv[13]), "+v"(cv[14]), "+v"(cv[15]) : : "memory");
#pragma unroll
        for (unsigned j = 0; j < 16; ++j) { const unsigned c = cv[j]; sum += c; cnt += (c > 0u) ? 1u : 0u; mine = (j == x) ? c : mine; }
        if (sum == G) break;
        __builtin_amdgcn_s_sleep(1);
        if ((++sp & 255u) == 0u) { if (xb_ld(&bar[XB_TMO])) break; if (sp > XB_SPIN_CAP) { atomicAdd(&bar[XB_TMO], 1u); break; } }
    }
    nloc = mine > 0u ? mine : 1u; nx = cnt > 0u ? cnt : 1u;
}

__device__ __forceinline__ void xcd_barrier(const XcdBarrier& b) {
    asm volatile("s_waitcnt vmcnt(0)" ::: "memory");
    __syncthreads();
    if (threadIdx.x == 0) {
        unsigned* bar = b.bar;
        __builtin_amdgcn_s_waitcnt(0);
        unsigned nloc = b.st[0], nx = b.st[1];
        if (nloc == 0u) { xcd_barrier_complete(bar, b.x, nloc, nx); b.st[0] = nloc; b.st[1] = nx; }
        const unsigned old = xb_add(&bar[XB_XSUB(b.x)], 1u);
        const unsigned gen = old / nloc;
        if (old + 1u == (gen + 1u) * nloc) {
            __builtin_amdgcn_fence(__ATOMIC_RELEASE, "agent");
            asm volatile("s_waitcnt vmcnt(0)" ::: "memory");
            const unsigned og = xb_add(&bar[XB_TOP], 1u);
            const unsigned tg = og / nx;
            if (og + 1u == (tg + 1u) * nx) xb_add(&bar[XB_TOPGEN], 1u);
            else XB_SPIN(xb_ld(&bar[XB_TOPGEN]) == tg, bar);
            __builtin_amdgcn_fence(__ATOMIC_ACQUIRE, "agent");
            xb_add(&bar[XB_XGEN(b.x)], 1u);
            asm volatile("s_waitcnt vmcnt(0)" ::: "memory");
        } else {
            XB_SPIN(xb_ld(&bar[XB_XGEN(b.x)]) == gen, bar);
            __builtin_amdgcn_fence(__ATOMIC_ACQUIRE, "agent");
            asm volatile("s_waitcnt vmcnt(0)" ::: "memory");
        }
    }
    __syncthreads();
}


typedef float f32x16 __attribute__((ext_vector_type(16)));
typedef float f32x2 __attribute__((ext_vector_type(2)));
#ifndef MK_WT
#define MK_WT 0
#endif
__device__ __forceinline__ void st16(void* p, v4u v) {
#if MK_WT
    asm volatile("global_store_dwordx4 %0, %1, off sc1\n\ts_nop 1" ::"v"(p), "v"(v) : "memory");
#else
    *(v4u*)p = v;
#endif
}
__device__ __forceinline__ void st8(void* p, unsigned long long v) {
#if MK_WT
    asm volatile("global_store_dwordx2 %0, %1, off sc1\n\ts_nop 1" ::"v"(p), "v"(v) : "memory");
#else
    *(unsigned long long*)p = v;
#endif
}
__device__ __forceinline__ void st4(void* p, unsigned v) {
#if MK_WT
    asm volatile("global_store_dword %0, %1, off sc1\n\ts_nop 1" ::"v"(p), "v"(v) : "memory");
#else
    *(unsigned*)p = v;
#endif
}

struct Args { const float* in[32]; float* out; unsigned char* ws; int ph_lo, ph_hi; };

struct Fr { LAS unsigned char* lds; int tid, lane, wave, G, bid; };
__device__ __forceinline__ Fr fr_fresh(const Fr& F) { Fr P = F; int t = F.tid; asm volatile("" : "+v"(t)); P.tid = t; P.lane = t & 63; P.wave = __builtin_amdgcn_readfirstlane(t >> 6); return P; }

template <int CTRL> __device__ __forceinline__ float dppf(float v) { return __builtin_bit_cast(float, __builtin_amdgcn_update_dpp(0, __builtin_bit_cast(int, v), CTRL, 0xf, 0xf, true)); }
template <int CTRL> __device__ __forceinline__ int dppi(int v) { return __builtin_amdgcn_update_dpp(0, v, CTRL, 0xf, 0xf, true); }
__device__ __forceinline__ float rlanef(float v, int l) { return __builtin_bit_cast(float, __builtin_amdgcn_readlane(__builtin_bit_cast(int, v), l)); }
__device__ __forceinline__ float wave_sum(float v) {
    v += dppf<0xB1>(v); v += dppf<0x4E>(v); v += dppf<0x141>(v); v += dppf<0x140>(v);
    return (rlanef(v, 0) + rlanef(v, 16)) + (rlanef(v, 32) + rlanef(v, 48));
}
__device__ __forceinline__ float wave_max(float v) {
    v = fmaxf(v, dppf<0xB1>(v)); v = fmaxf(v, dppf<0x4E>(v)); v = fmaxf(v, dppf<0x141>(v)); v = fmaxf(v, dppf<0x140>(v));
    return fmaxf(fmaxf(rlanef(v, 0), rlanef(v, 16)), fmaxf(rlanef(v, 32), rlanef(v, 48)));
}
__device__ __forceinline__ int wave_sum_i(int v) {
    v += dppi<0xB1>(v); v += dppi<0x4E>(v); v += dppi<0x141>(v); v += dppi<0x140>(v);
    return (__builtin_amdgcn_readlane(v, 0) + __builtin_amdgcn_readlane(v, 16)) + (__builtin_amdgcn_readlane(v, 32) + __builtin_amdgcn_readlane(v, 48));
}
__device__ __forceinline__ float bf2f(unsigned short b) { return __uint_as_float(((unsigned)b) << 16); }
__device__ __forceinline__ float bflo(unsigned w) { return __uint_as_float(w << 16); }
__device__ __forceinline__ float bfhi(unsigned w) { return __uint_as_float(w & 0xffff0000u); }
__device__ __forceinline__ float sigmoidf_(float x) { return __builtin_amdgcn_rcpf(1.f + __builtin_amdgcn_exp2f(x * -1.44269504088896341f)); }
__device__ __forceinline__ float siluf_(float x) { return x * sigmoidf_(x); }
__device__ __forceinline__ float fexp(float x) { return __builtin_amdgcn_exp2f(x * 1.44269504088896341f); }
#define BSYNC() __syncthreads()

template <int MODE> __device__ __forceinline__ int tr_row(int n) {
    if (MODE == 0) return n;
    if (MODE == 1) return n < 1024 ? n : (n < 1040 ? 2560 + (n - 1024) : (n < NIN ? n - 16 : -1));
    if (MODE == 2) return (n >> 7) * 256 + (n & 127);
    return (n >> 7) * 256 + 128 + (n & 127);
}
template <int MODE> __device__ __forceinline__ void tr_item(const float* __restrict__ W, int K, int N, bf16* WT, LAS unsigned* scr, int item, int lane) {
    const int nblk = (N + 63) / 64, kb = item / nblk, nb = item % nblk, k0 = 64 * kb, n0 = 64 * nb;
    const int n4 = lane & 15, kq = lane >> 4; const int ncol = n0 + 4 * n4; const bool ok = ncol < N;
    f32x4 va[8], vb[8];
    const float* src = W + (size_t)(k0 + 2 * kq) * N + ncol;
#pragma unroll
    for (int i = 0; i < 8; ++i) { va[i] = ok ? __builtin_nontemporal_load((const f32x4*)(src + (size_t)(8 * i) * N)) : (f32x4){0.f, 0.f, 0.f, 0.f};
                                  vb[i] = ok ? __builtin_nontemporal_load((const f32x4*)(src + (size_t)(8 * i + 1) * N)) : (f32x4){0.f, 0.f, 0.f, 0.f}; }
#pragma unroll
    for (int i = 0; i < 8; ++i) { const int kd = 4 * i + kq;
        scr[(4 * n4 + 0) * 36 + kd] = pk2(va[i].x, vb[i].x); scr[(4 * n4 + 1) * 36 + kd] = pk2(va[i].y, vb[i].y); scr[(4 * n4 + 2) * 36 + kd] = pk2(va[i].z, vb[i].z); scr[(4 * n4 + 3) * 36 + kd] = pk2(va[i].w, vb[i].w); }
    LDS_WAIT(); asm volatile("" ::: "memory");
#pragma unroll
    for (int j = 0; j < 8; ++j) { const int n = 8 * j + (lane >> 3), c = lane & 7; const v4u o = *(const LAS v4u*)(scr + n * 36 + 4 * c);
        const int row = (n0 + n < N) ? tr_row<MODE>(n0 + n) : -1;
        if (row >= 0) *(GAS v4u*)(WT + (size_t)row * K + k0 + 8 * c) = o; }
    LDS_WAIT(); asm volatile("" ::: "memory");
}

__device__ __forceinline__ unsigned pk4_fp8(float a, float b, float c, float d) { int w = 0; w = __builtin_amdgcn_cvt_pk_fp8_f32(a, b, w, false); w = __builtin_amdgcn_cvt_pk_fp8_f32(c, d, w, true); return (unsigned)w; }
struct F8Job { const float* W; unsigned char* WT; int K, N, item, mode; float mul; };
__device__ __forceinline__ F8Job f8_job(const Args& A, int l, int q  ) {
    constexpr int I_M = 352, S_M = NE * I_M;
    F8Job j; const int kind = q / S_M, r = q - kind * S_M, e = r / I_M, le = l * NE + e; j.item = r - e * I_M;
    if (kind == 0) { j.W = A.in[27] + (size_t)le * DM * FF; j.WT = (unsigned char*)(A.ws + WS_W1T) + (size_t)le * (2 * FF) * DM; j.K = DM; j.N = FF; j.mode = 2; j.mul = W1_MUL; }
    else if (kind == 1) { j.W = A.in[28] + (size_t)le * DM * FF; j.WT = (unsigned char*)(A.ws + WS_W1T) + (size_t)le * (2 * FF) * DM; j.K = DM; j.N = FF; j.mode = 3; j.mul = W1_MUL; }
    else { j.W = A.in[29] + (size_t)le * FF * DM; j.WT = (unsigned char*)(A.ws + WS_W2T) + (size_t)le * DM * FF; j.K = FF; j.N = DM; j.mode = 0; j.mul = W2_MUL; }
    return j;
}
__device__ __forceinline__ void f8_load(const F8Job& j, int h, f32x4 (&v)[4][4], int lane) {
    const int nblk = j.N / 64, kb = j.item / nblk, nb = j.item % nblk, k0 = 128 * kb + 64 * h, n0 = 64 * nb;
    const int n4 = lane & 15, kq = lane >> 4;
    const float* src = j.W + (size_t)(k0 + 4 * kq) * j.N + n0 + 4 * n4;
#pragma unroll
    for (int i = 0; i < 4; ++i)
#pragma unroll
        for (int q = 0; q < 4; ++q) v[i][q] = __builtin_nontemporal_load((const f32x4*)(src + (size_t)(16 * i + q) * j.N));
}
__device__ __forceinline__ void f8_pack(const f32x4 (&v)[4][4], int h, float mul, LAS unsigned* scr, int lane) {
    const int n4 = lane & 15, kq = lane >> 4; const int sw = (n4 >> 1) & 7;
#pragma unroll
    for (int i = 0; i < 4; ++i) { const int kd = 4 * ((4 * h + i) ^ sw) + kq;
        scr[(4 * n4 + 0) * 36 + kd] = pk4_fp8(v[i][0].x * mul, v[i][1].x * mul, v[i][2].x * mul, v[i][3].x * mul);
        scr[(4 * n4 + 1) * 36 + kd] = pk4_fp8(v[i][0].y * mul, v[i][1].y * mul, v[i][2].y * mul, v[i][3].y * mul);
        scr[(4 * n4 + 2) * 36 + kd] = pk4_fp8(v[i][0].z * mul, v[i][1].z * mul, v[i][2].z * mul, v[i][3].z * mul);
        scr[(4 * n4 + 3) * 36 + kd] = pk4_fp8(v[i][0].w * mul, v[i][1].w * mul, v[i][2].w * mul, v[i][3].w * mul); }
}
__device__ __forceinline__ void f8_store(const F8Job& j, LAS unsigned* scr, int lane) {
    const int nblk = j.N / 64, kb = j.item / nblk, nb = j.item % nblk, k0 = 128 * kb, n0 = 64 * nb;
    LDS_WAIT(); asm volatile("" ::: "memory");
#pragma unroll
    for (int jj = 0; jj < 8; ++jj) { const int n = 8 * jj + (lane >> 3), c = lane & 7; const v4u o = *(const LAS v4u*)(scr + n * 36 + 4 * (c ^ ((n >> 3) & 7)));
        const int nn = n0 + n; const int row = j.mode == 0 ? nn : (nn >> 7) * 256 + (j.mode == 3 ? 128 : 0) + (nn & 127);
        *(GAS v4u*)(j.WT + (size_t)row * j.K + k0 + 16 * c) = o; }
    LDS_WAIT(); asm volatile("" ::: "memory");
}

__device__ __forceinline__ void ph_convert_experts(const Fr& F, const Args& A, int l) {
    LAS unsigned* scr = (LAS unsigned*)(F.lds + RING_OFF + F.wave * 16384);
    const int gw = F.bid * NWAVES + F.wave, NGW = F.G * NWAVES;
    __syncthreads();
#pragma unroll 1
    for (int it = (gw + NGW - 640) % NGW; it < 3 * NE * 352; it += NGW) {
        const F8Job j = f8_job(A, l, it);
        f32x4 va[4][4], vb[4][4];
        f8_load(j, 0, va, F.lane); f8_load(j, 1, vb, F.lane);
        f8_pack(va, 0, j.mul, scr, F.lane); f8_pack(vb, 1, j.mul, scr, F.lane);
        f8_store(j, scr, F.lane);
    }
    __syncthreads();
}
__device__ __forceinline__ void ph_convert(const Fr& F, const Args& A) {
    unsigned char* ws = A.ws;
    LAS unsigned* scr = (LAS unsigned*)(F.lds + RING_OFF + F.wave * 16384);
    const int gw = F.bid * NWAVES + F.wave, NGW = F.G * NWAVES;
    const int gid = F.bid * NTHR + F.tid, NG = F.G * NTHR;
    constexpr int I_WIN = 16 * 41, I_WOUT = 16 * 16, I_GU = 16 * 44, I_DN = 44 * 16;
    constexpr int S_A = DEPTH * I_WIN, S_B = S_A + DEPTH * I_WOUT;
    for (int it = gw; it < S_B; it += NGW) {
        if (it < S_A) { const int l = it / I_WIN, r = it % I_WIN; tr_item<1>(A.in[6] + (size_t)l * DM * NIN, DM, NIN, (bf16*)(ws + WS_WINT) + (size_t)l * NWIN * DM, scr, r, F.lane); }
        else { const int q = it - S_A, l = q / I_WOUT, r = q % I_WOUT; tr_item<0>(A.in[22] + (size_t)l * DM * DM, DM, DM, (bf16*)(ws + WS_WOUTT) + (size_t)l * DM * DM, scr, r, F.lane); }
    }
    f32x2* TW = (f32x2*)(ws + WS_TW);
    for (int i = gid; i < NFFT / 2; i += NG) { float s, c; sincospif((float)i * (1.f / 8192.f), &s, &c); TW[i] = (f32x2){c, -s}; }
    { f32x2* ROPE = (f32x2*)(ws + WS_ROPE);
      for (int i = gid; i < 128 * 16; i += NG) { const float ang = (float)(i >> 4) * exp2f(-(float)(i & 15) * (13.287712379549449f / 16.f)); ROPE[i] = (f32x2){cosf(ang), sinf(ang)}; } }
    float* MODP = (float*)(ws + WS_MODP);
    if (F.wave >= 3) for (int it = F.bid * 5 + (F.wave - 3); it < DEPTH * 16 * 24; it += F.G * 5) {
        const int l = it / (16 * 24), kc = (it / 24) % 16, nb = it % 24;
        const int k = kc * 64 + F.lane;
        const float s0 = siluf_(A.in[1][k]), s1 = siluf_(A.in[1][DM + k]), s2 = siluf_(A.in[3][k]);
        f32x4 a0 = {0.f, 0.f, 0.f, 0.f}, a1 = a0, a2 = a0;
        const float* wp = A.in[4] + ((size_t)l * DM + kc * 64) * 6144 + nb * 256 + 4 * F.lane;
#pragma unroll 16
        for (int kk = 0; kk < 64; ++kk) { const f32x4 w = *(const f32x4*)(wp + (size_t)kk * 6144);
            const float t0 = __shfl(s0, kk), t1 = __shfl(s1, kk), t2 = __shfl(s2, kk); a0 += w * t0; a1 += w * t1; a2 += w * t2; }
        float* o = MODP + ((size_t)(l * 3) * 16 + kc) * 6144 + nb * 256 + 4 * F.lane;
        *(f32x4*)(o) = a0; *(f32x4*)(o + (size_t)16 * 6144) = a1; *(f32x4*)(o + (size_t)32 * 6144) = a2;
    }
    float* HID = (float*)(ws + WS_HID);
    { const int task = F.bid + F.G * F.wave;
      if (F.wave < 3 && task < DEPTH * (SB / 32)) {
        const int l = task / (SB / 32), pos0 = (task % (SB / 32)) * 32, r = F.lane & 31, hh = F.lane >> 5;
        const int pos = pos0 + r, n = pos < SEQ ? SEQ : CTXL, i = pos < SEQ ? pos : pos - SEQ;
        const float* w1 = A.in[15] + (size_t)l * 33 * 64; const float* w2 = A.in[18] + (size_t)l * 64 * 64;
        f32x16 acc[2] = {(f32x16){}, (f32x16){}};
#pragma unroll
        for (int kk = 0; kk < 17; ++kk) { const int k = 2 * kk + hh;
            float a = 0.f;
            if (k == 0) a = (float)i / (float)n;
            else if (k <= 16) a = cospif((float)(2 * i * k) / (float)n);
            else if (k <= 32) a = sinpif((float)(2 * i * (k - 16)) / (float)n);
            const int kc = k <= 32 ? k : 32;
#pragma unroll
            for (int nn = 0; nn < 2; ++nn) { const float b = k <= 32 ? w1[kc * 64 + 32 * nn + r] : 0.f; acc[nn] = __builtin_amdgcn_mfma_f32_32x32x2f32(a, b, acc[nn], 0, 0, 0); } }
        LAS float* hs = (LAS float*)scr;
#pragma unroll
        for (int nn = 0; nn < 2; ++nn) { const int col = 32 * nn + r; const float bv = A.in[16][l * 64 + col], fv = A.in[17][l * 128 + col];
#pragma unroll
            for (int g = 0; g < 16; ++g) hs[((g & 3) + 8 * (g >> 2) + 4 * hh) * 65 + col] = sinf(fv * (acc[nn][g] + bv)); }
        LDS_WAIT(); asm volatile("" ::: "memory");
        f32x16 acc2[2] = {(f32x16){}, (f32x16){}};
#pragma unroll 8
        for (int kk = 0; kk < 32; ++kk) { const float a = hs[r * 65 + 2 * kk + hh];
#pragma unroll
            for (int nn = 0; nn < 2; ++nn) acc2[nn] = __builtin_amdgcn_mfma_f32_32x32x2f32(a, w2[(2 * kk + hh) * 64 + 32 * nn + r], acc2[nn], 0, 0, 0); }
#pragma unroll
        for (int nn = 0; nn < 2; ++nn) { const int col = 32 * nn + r; const float bv = A.in[19][l * 64 + col], fv = A.in[17][l * 128 + 64 + col];
#pragma unroll
            for (int g = 0; g < 16; ++g) HID[((size_t)l * SB + pos0 + (g & 3) + 8 * (g >> 2) + 4 * hh) * 64 + col] = sinf(fv * (acc2[nn][g] + bv)); }
        LDS_WAIT(); asm volatile("" ::: "memory");
      } }
}

__device__ __forceinline__ int fphys(int i) { return i + ((i >> 6) << 2); }
__device__ __forceinline__ f32x2 cmul(f32x2 a, f32x2 b) { return (f32x2){a.x * b.x - a.y * b.y, a.x * b.y + a.y * b.x}; }
__device__ __forceinline__ f32x2 cmulc(f32x2 a, f32x2 b) { return (f32x2){a.x * b.x + a.y * b.y, a.y * b.x - a.x * b.y}; }
template <int NUM, int DEN> struct RotC {
    static constexpr int K16 = NUM * (16 / DEN);
    static constexpr float C = K16 == 0 ? 1.f : K16 == 1 ? 0.92387953251128674f : K16 == 2 ? 0.70710678118654752f : K16 == 3 ? 0.38268343236508977f : K16 == 4 ? 0.f : K16 == 5 ? -0.38268343236508977f : K16 == 6 ? -0.70710678118654752f : -0.92387953251128674f;
    static constexpr float S = K16 == 0 ? 0.f : K16 == 1 ? 0.38268343236508977f : K16 == 2 ? 0.70710678118654752f : K16 == 3 ? 0.92387953251128674f : K16 == 4 ? 1.f : K16 == 5 ? 0.92387953251128674f : K16 == 6 ? 0.70710678118654752f : 0.38268343236508977f;
};
template <int NUM, int DEN> __device__ __forceinline__ f32x2 crot(f32x2 a) {
    constexpr int K16 = RotC<NUM, DEN>::K16; constexpr float C = RotC<NUM, DEN>::C, S = RotC<NUM, DEN>::S;
    if (K16 == 0) return a;
    if (K16 == 4) return (f32x2){a.y, -a.x};
    if (K16 == 2) return (f32x2){(a.x + a.y) * C, (a.y - a.x) * C};
    if (K16 == 6) return (f32x2){(a.y - a.x) * S, -(a.x + a.y) * S};
    return (f32x2){a.x * C + a.y * S, a.y * C - a.x * S};
}
template <int NUM, int DEN> __device__ __forceinline__ f32x2 crotc(f32x2 a) {
    constexpr int K16 = RotC<NUM, DEN>::K16; constexpr float C = RotC<NUM, DEN>::C, S = RotC<NUM, DEN>::S;
    if (K16 == 0) return a;
    if (K16 == 4) return (f32x2){-a.y, a.x};
    if (K16 == 2) return (f32x2){(a.x - a.y) * C, (a.x + a.y) * C};
    if (K16 == 6) return (f32x2){-(a.x + a.y) * S, (a.x - a.y) * S};
    return (f32x2){a.x * C - a.y * S, a.y * C + a.x * S};
}
template <int R, int RS, int J, bool INV, bool UNITY> __device__ __forceinline__ void fft_bfly(f32x2 (&x)[1 << R], const f32x2 wb) {
    constexpr int E = 1 << R, hj = E >> (RS + 1);
    if constexpr (J < E) {
        if constexpr ((J & hj) == 0) {
            constexpr int jp = J & (hj - 1);
            const f32x2 a = x[J], b = x[J + hj];
            if (!INV) { x[J] = a + b; x[J + hj] = crot<jp, 2 * hj>(UNITY ? a - b : cmul(a - b, wb)); }
            else { const f32x2 v = crotc<jp, 2 * hj>(UNITY ? b : cmulc(b, wb)); x[J] = a + v; x[J + hj] = a - v; }
        }
        fft_bfly<R, RS, J + 1, INV, UNITY>(x, wb);
    }
}
template <int R, bool INV, int S> __device__ __forceinline__ void fft_pass(LAS f32x2* d, const f32x2* __restrict__ TW, const int tid) {
    constexpr int E = 1 << R, lq = 14 - S - R, q = 1 << lq, qs = q >= 64 ? q + ((q >> 6) << 2) : q, NIT = (NFFT >> R) / NTHR;
    constexpr bool UNITY = (lq == 0);
    static_assert(q >= 64 || E * q <= 64, "fft_pass: an item must not straddle a 64-element block");
    f32x2 tw[UNITY ? 1 : NIT][R];
    if constexpr (!UNITY) {
#pragma unroll
        for (int it = 0; it < NIT; ++it) { const int pos = (tid + it * NTHR) & (q - 1);
#pragma unroll
            for (int rs = 0; rs < R; ++rs) tw[it][rs] = TW[(pos << (S + rs)) & (NFFT / 2 - 1)]; }
    }
#pragma unroll (R == 4 ? 2 : 1)
    for (int it = 0; it < NIT; ++it) {
        const int w = tid + it * NTHR, grp = w >> lq, pos = w & (q - 1);
        LAS f32x2* p = d + fphys((grp << (lq + R)) + pos);
        f32x2 x[E];
#pragma unroll
        for (int j = 0; j < E; ++j) x[j] = p[j * qs];
        f32x2 wv[R];
#pragma unroll
        for (int rs = 0; rs < R; ++rs) wv[rs] = UNITY ? (f32x2){1.f, 0.f} : (NIT == 2 ? (it == 0 ? tw[0][rs] : tw[NIT - 1][rs]) : tw[0][rs]);
        if constexpr (R == 4) {
            if (!INV) { fft_bfly<4, 0, 0, false, UNITY>(x, wv[0]); fft_bfly<4, 1, 0, false, UNITY>(x, wv[1]); fft_bfly<4, 2, 0, false, UNITY>(x, wv[2]); fft_bfly<4, 3, 0, false, UNITY>(x, wv[3]); }
            else { fft_bfly<4, 3, 0, true, UNITY>(x, wv[3]); fft_bfly<4, 2, 0, true, UNITY>(x, wv[2]); fft_bfly<4, 1, 0, true, UNITY>(x, wv[1]); fft_bfly<4, 0, 0, true, UNITY>(x, wv[0]); }
        } else {
            static_assert(R == 2, "fft_pass: R is 4 or 2");
            if (!INV) { fft_bfly<2, 0, 0, false, UNITY>(x, wv[0]); fft_bfly<2, 1, 0, false, UNITY>(x, wv[1]); }
            else { fft_bfly<2, 1, 0, true, UNITY>(x, wv[1]); fft_bfly<2, 0, 0, true, UNITY>(x, wv[0]); }
        }
#pragma unroll
        for (int j = 0; j < E; ++j) p[j * qs] = x[j];
    }
}
__device__ __forceinline__ void fft_fwd(LAS f32x2* d, const f32x2* TW, int tid) {
    fft_pass<4, false, 0>(d, TW, tid); BSYNC(); fft_pass<4, false, 4>(d, TW, tid); BSYNC(); fft_pass<4, false, 8>(d, TW, tid); BSYNC(); fft_pass<2, false, 12>(d, TW, tid); BSYNC();
}
__device__ __forceinline__ void fft_inv(LAS f32x2* d, const f32x2* TW, int tid) {
    fft_pass<2, true, 12>(d, TW, tid); BSYNC(); fft_pass<4, true, 8>(d, TW, tid); BSYNC(); fft_pass<4, true, 4>(d, TW, tid); BSYNC(); fft_pass<4, true, 0>(d, TW, tid); BSYNC();
}

__device__ __forceinline__ float block_sum(float v, LAS float* red, int wave, int lane) {
    v = wave_sum(v);
    BSYNC();
    if (lane == 0) red[wave] = v;
    BSYNC();
    float s = 0.f;
#pragma unroll
    for (int i = 0; i < NWAVES; ++i) s += red[i];
    return s;
}

__device__ __forceinline__ void ph_taps(const Fr& F, const Args& A) {
    unsigned char* ws = A.ws;
    const int gid = F.bid * NTHR + F.tid, NG = F.G * NTHR;
    { float* MOD = (float*)(ws + WS_MOD); const float* MODP = (const float*)(ws + WS_MODP);
      for (int i = gid; i < DEPTH * 3 * 6144; i += NG) { const int l = i / (3 * 6144), n = i % 6144; float a = A.in[5][l * 6144 + n]; const float* p = MODP + (size_t)(i / 6144) * 16 * 6144 + n;
#pragma unroll
          for (int kc = 0; kc < 16; ++kc) a += p[(size_t)kc * 6144];
          MOD[i] = a; } }
    const float* HID = (const float*)(ws + WS_HID); float* TAPS = (float*)(ws + WS_TAPS);
    typedef short s16x8_ __attribute__((ext_vector_type(8)));
    LAS unsigned short* AH = (LAS unsigned short*)(F.lds + RING_OFF); LAS unsigned short* AL = AH + 64 * 72;
    const float log_target = 4.605170185988091f; const float dlo = log_target / 1.5f, dhi = log_target / 0.3f;
    const int r = F.lane & 31, hh = F.lane >> 5;
    const bool split_tail = (F.G == 256);
    for (int pass = 0; pass < (split_tail ? 2 : 1); ++pass) for (int u0 = F.bid; u0 < (split_tail ? 256 : DEPTH * (SB / 64)); u0 += F.G) {
        int u = u0, cb0 = 0, ncb = 16;
        if (pass == 1) { if (F.bid >= 64) break; u = 256 + (F.bid >> 3); cb0 = 2 * (F.bid & 7); ncb = 2; }
        const int l = u / (SB / 64), pos0 = (u % (SB / 64)) * 64;
        BSYNC();
        { const int p = F.tid >> 3, c8 = (F.tid & 7) * 8; const float* src = HID + ((size_t)l * SB + pos0 + p) * 64 + c8;
          const f32x4 v0 = *(const f32x4*)src, v1 = *(const f32x4*)(src + 4); const float x[8] = {v0.x, v0.y, v0.z, v0.w, v1.x, v1.y, v1.z, v1.w};
          unsigned hi[8], lo[8];
#pragma unroll
          for (int i = 0; i < 8; ++i) { hi[i] = f2bf(x[i]); lo[i] = f2bf(x[i] - __uint_as_float(hi[i] << 16)); }
          *(LAS v4u*)(AH + p * 72 + c8) = (v4u){hi[0] | (hi[1] << 16), hi[2] | (hi[3] << 16), hi[4] | (hi[5] << 16), hi[6] | (hi[7] << 16)};
          *(LAS v4u*)(AL + p * 72 + c8) = (v4u){lo[0] | (lo[1] << 16), lo[2] | (lo[3] << 16), lo[4] | (lo[5] << 16), lo[6] | (lo[7] << 16)}; }
        BSYNC();
        const float* w3 = A.in[20] + (size_t)l * 64 * 1024;
#pragma unroll 1
        for (int cb = cb0 + F.wave; cb < cb0 + ncb; cb += NWAVES) {
            const int col0 = cb * 64;
            s16x8_ bh[2][4], bl[2][4];
#pragma unroll
            for (int n = 0; n < 2; ++n)
#pragma unroll
                for (int ks = 0; ks < 4; ++ks) { float x[8];
#pragma unroll
                    for (int j = 0; j < 8; ++j) x[j] = w3[(size_t)(ks * 16 + hh * 8 + j) * 1024 + col0 + 32 * n + r];
#pragma unroll
                    for (int j = 0; j < 8; ++j) { const unsigned h = f2bf(x[j]); bh[n][ks][j] = (short)h; bl[n][ks][j] = (short)f2bf(x[j] - __uint_as_float(h << 16)); } }
#pragma unroll 1
            for (int ph = 0; ph < 2; ++ph) {
                f32x16 acc[2] = {(f32x16){}, (f32x16){}};
#pragma unroll
                for (int ks = 0; ks < 4; ++ks) { const s16x8_ ah = *(const LAS s16x8_*)(AH + (ph * 32 + r) * 72 + ks * 16 + hh * 8), al = *(const LAS s16x8_*)(AL + (ph * 32 + r) * 72 + ks * 16 + hh * 8);
#pragma unroll
                    for (int n = 0; n < 2; ++n) { acc[n] = __builtin_amdgcn_mfma_f32_32x32x16_bf16(al, bh[n][ks], acc[n], 0, 0, 0); acc[n] = __builtin_amdgcn_mfma_f32_32x32x16_bf16(ah, bl[n][ks], acc[n], 0, 0, 0);
                        acc[n] = __builtin_amdgcn_mfma_f32_32x32x16_bf16(ah, bh[n][ks], acc[n], 0, 0, 0); } }
#pragma unroll
                for (int n = 0; n < 2; ++n) { const int col = col0 + 32 * n + r; const float de = (dlo + (dhi - dlo) * (float)(col & 255) / 255.f) * -1.44269504088896341f;
                    float* op = TAPS + ((size_t)l * 1024 + col) * SB + pos0 + ph * 32 + 4 * hh;
#pragma unroll
                    for (int q = 0; q < 4; ++q) { f32x4 o;
#pragma unroll
                        for (int i = 0; i < 4; ++i) { const int pos = pos0 + ph * 32 + 8 * q + 4 * hh + i; const float t = pos < SEQ ? (float)pos / 8192.f : (float)(pos - SEQ) / 256.f; o[i] = acc[n][4 * q + i] * (__builtin_amdgcn_exp2f(t * de) + 0.05f); }
                        *(f32x4*)(op + 8 * q) = o; } }
            }
        }
    }
}
__device__ __forceinline__ void ph_filters(const Fr& F, const Args& A) {
    unsigned char* ws = A.ws;
    const int gw = F.bid * NWAVES + F.wave, NGW = F.G * NWAVES;
    const float* TAPS = (const float*)(ws + WS_TAPS);
    { float* TAPC = (float*)(ws + WS_TAPC);
      for (int it = gw; it < DEPTH * 2 * 256; it += NGW) {
          const int l = it / 512, o = (it / 256) & 1, c = it & 255;
          const float* fw = TAPS + ((size_t)l * 1024 + o * 256 + c) * SB + SEQ; const float* bw = TAPS + ((size_t)l * 1024 + 512 + o * 256 + c) * SB + SEQ;
          float fv[4], gv[4]; float l1 = 0.f;
#pragma unroll
          for (int i = 0; i < 4; ++i) { const int s = F.lane + 64 * i; fv[i] = fw[s]; gv[i] = s ? bw[s] : 0.f; l1 += fabsf(fv[i]) + fabsf(gv[i]); }
          l1 = wave_sum(l1); const float inv = 1.f / l1; float* T = TAPC + (size_t)it * 512;
#pragma unroll
          for (int i = 0; i < 4; ++i) { const int s = F.lane + 64 * i; T[256 + s] = fv[i] * inv; if (s >= 1) T[256 - s] = gv[i] * inv; }
          if (F.lane == 0) T[0] = 0.f;
      } }
    LAS f32x2* d = (LAS f32x2*)(F.lds + RING_OFF); LAS float* xs = (LAS float*)(F.lds + LDSX_OFF);
    const f32x2* TW = (const f32x2*)(ws + WS_TW); f32x2* HF = (f32x2*)(ws + WS_HF);
    for (int u = F.bid; u < DEPTH * 256; u += F.G) {
        const int l = u / 256, c = u & 255;
        const float* fw0 = TAPS + ((size_t)l * 1024 + c) * SB; const float* bw0 = TAPS + ((size_t)l * 1024 + 512 + c) * SB;
        const float* fw1 = fw0 + (size_t)256 * SB; const float* bw1 = bw0 + (size_t)256 * SB;
        BSYNC();
        float l1a = 0.f, l1b = 0.f;
#pragma unroll 4
        for (int s = F.tid; s < SEQ; s += NTHR) { const float f0 = fw0[s], g0 = bw0[s], f1 = fw1[s], g1 = bw1[s];
            d[fphys(s)] = (f32x2){f0, f1};
            if (s >= 1) { d[fphys(NFFT - s)] = (f32x2){g0, g1}; l1a += fabsf(g0); l1b += fabsf(g1); } else d[fphys(SEQ)] = (f32x2){0.f, 0.f};
            l1a += fabsf(f0); l1b += fabsf(f1); }
        l1a = block_sum(l1a, xs + 128, F.wave, F.lane);
        l1b = block_sum(l1b, xs + 144, F.wave, F.lane);
        const float sca = 0.5f / (l1a * (float)NFFT), scb = 0.5f / (l1b * (float)NFFT);
        fft_fwd(d, TW, F.tid);
        f32x2* outa = HF + ((size_t)(l * 2 + 0) * 256 + c) * HFS; f32x2* outb = HF + ((size_t)(l * 2 + 1) * 256 + c) * HFS;
#pragma unroll 4
        for (int j = F.tid; j <= NFFT / 2; j += NTHR) { const int i = j < NFFT / 2 ? 2 * j : 1;
            const int k = (int)(__brev((unsigned)i) >> 18), kp = (NFFT - k) & (NFFT - 1), ip = (int)(__brev((unsigned)kp) >> 18);
            const f32x2 v = d[fphys(i)], w = d[fphys(ip)];
            outa[j] = (f32x2){(v.x + w.x) * sca, (v.y - w.y) * sca};
            outb[j] = (f32x2){(v.y + w.y) * scb, (w.x - v.x) * scb}; }
    }
}

struct Row { f32x4 v[4]; };
__device__ __forceinline__ Row row_load(const float* p, int lane) { Row r; const f32x4* q = (const f32x4*)p + lane;
#pragma unroll
    for (int j = 0; j < 4; ++j) r.v[j] = q[64 * j];
    return r; }
__device__ __forceinline__ Row row_load_bf16(const bf16* p, int lane) { Row r; const unsigned long long* q = (const unsigned long long*)p + lane;
#pragma unroll
    for (int j = 0; j < 4; ++j) { const unsigned long long w = q[64 * j]; const unsigned lo = (unsigned)w, hi = (unsigned)(w >> 32); r.v[j] = (f32x4){bflo(lo), bfhi(lo), bflo(hi), bfhi(hi)}; }
    return r; }
__device__ __forceinline__ void row_store_fp8(unsigned char* p, const Row& r, int lane) { unsigned* q = (unsigned*)p + lane;
#pragma unroll
    for (int j = 0; j < 4; ++j) st4(q + 64 * j, pk4_fp8(r.v[j].x, r.v[j].y, r.v[j].z, r.v[j].w)); }
__device__ __forceinline__ void row_store(float* p, const Row& r, int lane) { f32x4* q = (f32x4*)p + lane;
#pragma unroll
    for (int j = 0; j < 4; ++j) st16(q + 64 * j, __builtin_bit_cast(v4u, r.v[j])); }
__device__ __forceinline__ void row_store_bf16(bf16* p, const Row& r, int lane) { unsigned long long* q = (unsigned long long*)p + lane;
#pragma unroll
    for (int j = 0; j < 4; ++j) st8(q + 64 * j, (unsigned long long)pk2(r.v[j].x, r.v[j].y) | ((unsigned long long)pk2(r.v[j].z, r.v[j].w) << 32)); }
__device__ __forceinline__ Row row_load_lds(const LAS float* p, int lane) { Row r; const LAS f32x4* q = (const LAS f32x4*)p + lane;
#pragma unroll
    for (int j = 0; j < 4; ++j) r.v[j] = q[64 * j];
    return r; }
constexpr int LNPV_OFF = 65536;
__device__ __forceinline__ const LAS float* ln_pv(const Fr& F, int row, int k) { const int b = row / SB, s = row % SB; return (const LAS float*)(F.lds + RING_OFF + LNPV_OFF) + ((s < SEQ ? b : 2) * 5 + k) * DM; }
__device__ __forceinline__ void ln_pv_fill(const Fr& F, int k, const float* v0, const float* v1, const float* v2) {
    LAS float* pv = (LAS float*)(F.lds + RING_OFF + LNPV_OFF);
    for (int i = F.tid; i < DM; i += NTHR) { pv[(0 * 5 + k) * DM + i] = v0[i]; pv[(1 * 5 + k) * DM + i] = v1[i]; pv[(2 * 5 + k) * DM + i] = v2[i]; }
}
struct Pv6 { float a[6]; };
__device__ __forceinline__ Pv6 ln_pv_ld(const Fr& F, const float* v0, const float* v1, const float* v2) { Pv6 q; const int i = F.tid;
    q.a[0] = v0[i]; q.a[1] = v0[i + NTHR]; q.a[2] = v1[i]; q.a[3] = v1[i + NTHR]; q.a[4] = v2[i]; q.a[5] = v2[i + NTHR]; return q; }
__device__ __forceinline__ void ln_pv_st(const Fr& F, int k, Pv6& q) { static_assert(DM == 2 * NTHR, "ln_pv_st: two elements per thread");
#pragma unroll
    for (int j = 0; j < 6; ++j) asm volatile("" : "+v"(q.a[j]));
    LAS float* pv = (LAS float*)(F.lds + RING_OFF + LNPV_OFF); const int i = F.tid;
#pragma unroll
    for (int v = 0; v < 3; ++v) { pv[(v * 5 + k) * DM + i] = q.a[2 * v]; pv[(v * 5 + k) * DM + i + NTHR] = q.a[2 * v + 1]; } }
__device__ __forceinline__ void row_norm(Row& r) {
    float s = 0.f;
#pragma unroll
    for (int j = 0; j < 4; ++j) s += (r.v[j].x + r.v[j].y) + (r.v[j].z + r.v[j].w);
    const float mean = wave_sum(s) * (1.f / DM); float s2 = 0.f;
#pragma unroll
    for (int j = 0; j < 4; ++j) { r.v[j] = r.v[j] - mean; s2 += (r.v[j].x * r.v[j].x + r.v[j].y * r.v[j].y) + (r.v[j].z * r.v[j].z + r.v[j].w * r.v[j].w); }
    const float rstd = 1.f / sqrtf(wave_sum(s2) * (1.f / DM) + LN_EPS);
#pragma unroll
    for (int j = 0; j < 4; ++j) r.v[j] = r.v[j] * rstd;
}
__device__ __forceinline__ void row_mod_lds(Row& r, const LAS float* shift, const LAS float* scale, int lane) {
    const Row sh = row_load_lds(shift, lane), sc = row_load_lds(scale, lane);
#pragma unroll
    for (int j = 0; j < 4; ++j) r.v[j] = r.v[j] * (sc.v[j] + 1.f) + sh.v[j];
}
__device__ __forceinline__ void row_affine_lds(Row& r, const LAS float* w, const LAS float* b, int lane) {
    const Row ww = row_load_lds(w, lane), bb = row_load_lds(b, lane);
#pragma unroll
    for (int j = 0; j < 4; ++j) r.v[j] = r.v[j] * ww.v[j] + bb.v[j];
}
__device__ __forceinline__ void row_dot16x2(const Row& ra, const Row& rb, const LAS float* W16, int lane, float& da, float& db) {
    f32x2 p[16];
#pragma unroll
    for (int e = 0; e < 16; ++e) { const LAS f32x4* w = (const LAS f32x4*)(W16 + e * DM) + lane; f32x2 a = {0.f, 0.f};
#pragma unroll
        for (int j = 0; j < 4; ++j) { const f32x4 x = w[64 * j];
            a += (f32x2){ra.v[j].x, rb.v[j].x} * x.x; a += (f32x2){ra.v[j].y, rb.v[j].y} * x.y; a += (f32x2){ra.v[j].z, rb.v[j].z} * x.z; a += (f32x2){ra.v[j].w, rb.v[j].w} * x.w; }
        p[e] = a; }
    const bool b0 = (lane & 1) != 0, b1 = (lane & 2) != 0;
    float res[2];
#pragma unroll
    for (int c = 0; c < 2; ++c) {
        float q[8];
#pragma unroll
        for (int i = 0; i < 8; ++i) { const float keep = b0 ? p[2 * i + 1][c] : p[2 * i][c], send = b0 ? p[2 * i][c] : p[2 * i + 1][c]; q[i] = keep + dppf<0xB1>(send); }
        float t[4];
#pragma unroll
        for (int i = 0; i < 4; ++i) { const float keep = b1 ? q[2 * i + 1] : q[2 * i], send = b1 ? q[2 * i] : q[2 * i + 1]; t[i] = keep + dppf<0x4E>(send); }
#pragma unroll
        for (int i = 0; i < 4; ++i) { t[i] += dppf<0x124>(t[i]); t[i] += dppf<0x128>(t[i]); t[i] += __shfl_xor(t[i], 16); t[i] += __shfl_xor(t[i], 32); }
        const int sel = (lane >> 2) & 3;
        res[c] = sel == 0 ? t[0] : (sel == 1 ? t[1] : (sel == 2 ? t[2] : t[3]));
    }
    da = res[0]; db = res[1];
}
__device__ __forceinline__ const float* row_input(const Args& A, int l, int row) {
    if (l > 0) return (const float*)(A.ws + WS_XS2) + (size_t)row * DM;
    const int b = row / SB, s = row % SB;
    return s < SEQ ? A.in[0] + ((size_t)b * SEQ + s) * DM : A.in[2] + ((size_t)b * CTXL + (s - SEQ)) * DM;
}
__device__ __forceinline__ Row ln_a_head(const Fr& F, const Args& A, int row, Row r, int lane) {
    row_norm(r); row_mod_lds(r, ln_pv(F, row, 3), ln_pv(F, row, 4), lane);
    row_store_bf16((bf16*)(A.ws + WS_HN) + (size_t)row * DM, r, lane);
    return r;
}
struct LnSched { int full, rem, W;
    __device__ __forceinline__ void init(int NR, int NGW, int G) { full = NR / (2 * NGW); rem = NR - full * 2 * NGW; W = (rem + G - 1) / G; if (W > NWAVES) W = NWAVES; }
    __device__ __forceinline__ bool next(int it, const Fr& F, int& idx, int& idx2) const { const int NGW = F.G * NWAVES;
        if (it < full) { idx = F.bid * NWAVES + F.wave + it * 2 * NGW; idx2 = idx + NGW; return true; }
        const int j = F.bid * W + F.wave + (it - full) * F.G * W; if (F.wave >= W || j >= rem) return false;
        idx = full * 2 * NGW + j; idx2 = idx; return true; } };
__device__ __forceinline__ void ph_ln_a0(const Fr& F, const Args& A) {
    BSYNC();
    { const float* M = (const float*)(A.ws + WS_MOD); Pv6 p3 = ln_pv_ld(F, M, M + 6144, M + 2 * 6144), p4 = ln_pv_ld(F, M + DM, M + 6144 + DM, M + 2 * 6144 + DM); ln_pv_st(F, 3, p3); ln_pv_st(F, 4, p4); BSYNC(); }
    const int gw = F.bid * NWAVES + F.wave, NGW = F.G * NWAVES;
    LnSched LS; LS.init(MT, NGW, F.G); (void)gw;
    for (int it = 0, row, row2; LS.next(it, F, row, row2); ++it) { asm volatile("" ::: "memory");
        (void)ln_a_head(F, A, row, row_load(row_input(A, 0, row), F.lane), F.lane); if (row2 != row) (void)ln_a_head(F, A, row2, row_load(row_input(A, 0, row2), F.lane), F.lane); }
}
__device__ __forceinline__ void ph_ln_b(const Fr& F, const Args& A, int l) {
    LAS float* RW = (LAS float*)(F.lds + RING_OFF);
    BSYNC();
    { const float* M = (const float*)(A.ws + WS_MOD) + (size_t)l * 3 * 6144; const float* w = A.in[23] + l * DM; const float* bb = A.in[24] + l * DM;
      f32x4 rw[8]; const f32x4* rsrc = (const f32x4*)(A.in[25] + (size_t)l * DM * 16);
#pragma unroll
      for (int it = 0; it < 8; ++it) rw[it] = rsrc[F.tid + it * NTHR];
      Pv6 p0 = ln_pv_ld(F, M + 2 * DM, M + 6144 + 2 * DM, M + 2 * 6144 + 2 * DM), p1 = ln_pv_ld(F, w, w, w), p2 = ln_pv_ld(F, bb, bb, bb);
      Pv6 p3 = ln_pv_ld(F, M + 3 * DM, M + 6144 + 3 * DM, M + 2 * 6144 + 3 * DM), p4 = ln_pv_ld(F, M + 4 * DM, M + 6144 + 4 * DM, M + 2 * 6144 + 4 * DM);
#pragma unroll
      for (int it = 0; it < 8; ++it) asm volatile("" : "+v"(rw[it]));
#pragma unroll
      for (int it = 0; it < 8; ++it) { const int i4 = F.tid + it * NTHR, k = i4 >> 2, e4 = (i4 & 3) * 4; RW[(e4 + 0) * DM + k] = rw[it].x; RW[(e4 + 1) * DM + k] = rw[it].y; RW[(e4 + 2) * DM + k] = rw[it].z; RW[(e4 + 3) * DM + k] = rw[it].w; }
      ln_pv_st(F, 0, p0); ln_pv_st(F, 1, p1); ln_pv_st(F, 2, p2); ln_pv_st(F, 3, p3); ln_pv_st(F, 4, p4); }
    BSYNC();
    const int gw = F.bid * NWAVES + F.wave, NGW = F.G * NWAVES; const bool last = (l == DEPTH - 1);
    const int NR = last ? NB * SEQ : MT;
#define LNROW(i_) (last ? (i_) + ((i_) >= SEQ ? CTXL : 0) : (i_))
    LnSched LS; LS.init(NR, NGW, F.G); (void)gw;
    for (int it = 0, idx, idx2; LS.next(it, F, idx, idx2); ++it) {
        asm volatile("" ::: "memory");
        const int rows[2] = {LNROW(idx), LNROW(idx2)};
        Row h[2];
#pragma unroll
        for (int c = 0; c < 2; ++c) { const int row = rows[c];
            Row r = row_load(row_input(A, l, row), F.lane); Row mx; const Row g1 = row_load_lds(ln_pv(F, row, 0), F.lane);
            if (!last && (row % SB) >= SEQ) {
                const bf16* pp = (const bf16*)(A.ws + WS_MIXP) + ((size_t)(row / SB) * 256 + ((row % SB) - SEQ)) * DM; mx = row_load_bf16(pp, F.lane);
#pragma unroll
                for (int kq = 1; kq < 4; ++kq) { const Row t = row_load_bf16(pp + (size_t)kq * 2 * 256 * DM, F.lane);
#pragma unroll
                    for (int j = 0; j < 4; ++j) mx.v[j] += t.v[j]; } }
            else mx = row_load_bf16((const bf16*)(A.ws + WS_MIX) + (size_t)row * DM, F.lane);
#pragma unroll
            for (int j = 0; j < 4; ++j) r.v[j] = r.v[j] * ALPHA + g1.v[j] * mx.v[j];
            row_norm(r); row_affine_lds(r, ln_pv(F, row, 1), ln_pv(F, row, 2), F.lane);
            row_store((float*)(A.ws + WS_XS) + (size_t)row * DM, r, F.lane);
            row_norm(r); row_mod_lds(r, ln_pv(F, row, 3), ln_pv(F, row, 4), F.lane);
            row_store_fp8((unsigned char*)(A.ws + WS_HN) + (size_t)row * DM, r, F.lane);
            h[c] = r; }
        float lgs[2]; row_dot16x2(h[0], h[1], RW, F.lane, lgs[0], lgs[1]);
#pragma unroll
        for (int c = 0; c < 2; ++c) { const int row = rows[c]; const int b = row / SB, s = row % SB;
            const float lg = lgs[c] + A.in[26][l * 16 + (F.lane & 15)];
            float mxv = lg;
#pragma unroll
            for (int o = 1; o < 16; o <<= 1) mxv = fmaxf(mxv, __shfl_xor(mxv, o));
            const float ex = expf(lg - mxv); float sm = ex;
#pragma unroll
            for (int o = 1; o < 16; o <<= 1) sm += __shfl_xor(sm, o);
            if (F.lane < 16) ((float*)(A.ws + WS_AFF))[((size_t)b * 16 + F.lane) * SB + s] = ex / sm; }
    }
#undef LNROW
}
__device__ __forceinline__ void ph_ln_c(const Fr& F, const Args& A, int l) {
    const bool last = (l == DEPTH - 1);
    { const float* M = (const float*)(A.ws + WS_MOD) + (size_t)l * 3 * 6144; const float* w = A.in[30] + l * DM; const float* bb = A.in[31] + l * DM; BSYNC();
      { const float* M1 = last ? M : M + 3 * 6144;
        Pv6 p0 = ln_pv_ld(F, M + 5 * DM, M + 6144 + 5 * DM, M + 2 * 6144 + 5 * DM), p1 = ln_pv_ld(F, w, w, w), p2 = ln_pv_ld(F, bb, bb, bb);
        Pv6 p3 = ln_pv_ld(F, M1, M1 + 6144, M1 + 2 * 6144), p4 = ln_pv_ld(F, M1 + DM, M1 + 6144 + DM, M1 + 2 * 6144 + DM);
        ln_pv_st(F, 0, p0); ln_pv_st(F, 1, p1); ln_pv_st(F, 2, p2); ln_pv_st(F, 3, p3); ln_pv_st(F, 4, p4); }
      BSYNC(); }
    const int gw = F.bid * NWAVES + F.wave, NGW = F.G * NWAVES;
    const int* INV = (const int*)(A.ws + WS_INV); const float* VAL = (const float*)(A.ws + WS_VAL); const bf16* YE = (const bf16*)(A.ws + WS_YE);
    const int NR = last ? NB * SEQ : MT;
#define LNROW(i_) (last ? (i_) + ((i_) >= SEQ ? CTXL : 0) : (i_))
    LnSched LS; LS.init(NR, NGW, F.G); (void)gw;
    for (int it = 0, idx, idx2; LS.next(it, F, idx, idx2); ++it) {
        asm volatile("" ::: "memory");
        const int rows[2] = {LNROW(idx), LNROW(idx2)};
        Row h[2];
#pragma unroll
        for (int c = 0; c < 2; ++c) { const int row = rows[c]; const int b = row / SB, s = row % SB;
            const int myinv = (F.lane < 16) ? INV[(size_t)row * 16 + F.lane] : 0;
            Row r = row_load((const float*)(A.ws + WS_XS) + (size_t)row * DM, F.lane); const Row g2 = row_load_lds(ln_pv(F, row, 0), F.lane);
            Row f;
#pragma unroll
            for (int j = 0; j < 4; ++j) f.v[j] = (f32x4){0.f, 0.f, 0.f, 0.f};
            unsigned emask = (unsigned)__ballot(myinv != 0) & 0xffffu;
            while (emask) {
                int es[4], r1s[4]; unsigned long long yq[4][4]; float vq[4];
#pragma unroll
                for (int k = 0; k < 4; ++k) { es[k] = -1; r1s[k] = 0; if (emask) { const int e = __builtin_ctz(emask); emask &= emask - 1u; es[k] = e; r1s[k] = __builtin_amdgcn_readlane(myinv, e); } }
#pragma unroll
                for (int k = 0; k < 4; ++k) if (es[k] >= 0 && r1s[k] - 1 < 2048) { const size_t rr = (size_t)es[k] * ROWS_E + (r1s[k] - 1); vq[k] = VAL[rr]; const unsigned long long* q = (const unsigned long long*)(YE + rr * DM) + F.lane;
#pragma unroll
                    for (int j = 0; j < 4; ++j) yq[k][j] = q[64 * j]; }
#pragma unroll
                for (int k = 0; k < 4; ++k) if (es[k] >= 0) { Row y; float val;
                    if (r1s[k] - 1 < 2048) { val = vq[k];
#pragma unroll
                        for (int j = 0; j < 4; ++j) { const unsigned long long w = yq[k][j]; const unsigned lo = (unsigned)w, hi = (unsigned)(w >> 32); y.v[j] = (f32x4){bflo(lo), bfhi(lo), bflo(hi), bfhi(hi)}; } }
                    else {
                        const int e = es[k]; val = VAL[(size_t)e * ROWS_E + (r1s[k] - 1)];
                        const bf16* pp = (const bf16*)(A.ws + WS_YEP) + ((size_t)e * 64 + (r1s[k] - 1 - 2048)) * DM; y = row_load_bf16(pp, F.lane);
#pragma unroll
                        for (int kq = 1; kq < 4; ++kq) { const Row t = row_load_bf16(pp + (size_t)kq * NE * 64 * DM, F.lane);
#pragma unroll
                            for (int j = 0; j < 4; ++j) y.v[j] += t.v[j]; } }
#pragma unroll
                    for (int j = 0; j < 4; ++j) f.v[j] += y.v[j] * val; }
            }
#pragma unroll
            for (int j = 0; j < 4; ++j) r.v[j] = r.v[j] * ALPHA + g2.v[j] * f.v[j];
            row_norm(r); row_affine_lds(r, ln_pv(F, row, 1), ln_pv(F, row, 2), F.lane);
            if (last) row_store(A.out + ((size_t)b * SEQ + s) * DM, r, F.lane);
            else { row_store((float*)(A.ws + WS_XS2) + (size_t)row * DM, r, F.lane); (void)ln_a_head(F, A, row, r, F.lane); } }
    }
#undef LNROW
}

struct EpiWin {
    static constexpr bool PERM = true, AFTER_DRAIN = false;
    bf16* P1; float* HY; float* GT;
    __device__ __forceinline__ void operator()(const pg8::f32x4 (&acc)[2][2][4][2], const pg8::Unit& u, int wr, int wc, int fr, int fq) const {
        const int row0 = u.pm * 256 + wr * 64 + fr;
        if (u.pn == 10) {
            if (wc == 0 && fq < 2) {
#pragma unroll
                for (int ai = 0; ai < 2; ++ai)
#pragma unroll
                    for (int m = 0; m < 4; ++m) { float* gp = GT + (size_t)(row0 + ai * 128 + m * 16) * 16 + 8 * fq; *(pg8::f32x4*)gp = acc[ai][0][m][0]; *(pg8::f32x4*)(gp + 4) = acc[ai][0][m][1]; } }
        } else if (u.pn < 7) {
            const int col0 = u.pn * 256 + wc * 32 + 8 * fq;
#pragma unroll
            for (int ai = 0; ai < 2; ++ai)
#pragma unroll
                for (int m = 0; m < 4; ++m) { bf16* rowp = P1 + (size_t)(row0 + ai * 128 + m * 16) * NP1 + col0;
#pragma unroll
                    for (int bj = 0; bj < 2; ++bj) { const pg8::f32x4 v0 = acc[ai][bj][m][0], v1 = acc[ai][bj][m][1]; pg8::u32x4 w;
                        w.x = pg8::cvt_pk_bf16(v0[0], v0[1]); w.y = pg8::cvt_pk_bf16(v0[2], v0[3]); w.z = pg8::cvt_pk_bf16(v1[0], v1[1]); w.w = pg8::cvt_pk_bf16(v1[2], v1[3]);
                        st16(rowp + bj * 128, __builtin_bit_cast(v4u, w)); } }
        } else {
            const int b = u.pm / 33, s0 = (u.pm % 33) * 256 + wr * 64 + fr; const int ch0 = (u.pn - 7) * 256 + wc * 32 + 8 * fq;
            float* base = HY + (size_t)b * 768 * SB;
#pragma unroll
            for (int ai = 0; ai < 2; ++ai)
#pragma unroll
                for (int m = 0; m < 4; ++m) { const int s = s0 + ai * 128 + m * 16;
#pragma unroll
                    for (int bj = 0; bj < 2; ++bj)
#pragma unroll
                        for (int n = 0; n < 2; ++n)
#pragma unroll
                            for (int i = 0; i < 4; ++i) st4(base + (size_t)(ch0 + bj * 128 + 4 * n + i) * SB + s, __float_as_uint(acc[ai][bj][m][n][i])); }
        }
    }
};
struct EpiF32g {
    static constexpr bool PERM = false, AFTER_DRAIN = false;
    float* C; int ldc; int ntn;
    __device__ __forceinline__ void operator()(const pg8::f32x4 (&acc)[2][2][4][2], const pg8::Unit& u, int wr, int wc, int fr, int fq) const {
        const int row0 = u.pm * 256 + wr * 64 + fr, col0 = (u.pn % ntn) * 256 + wc * 32 + 4 * fq;
#pragma unroll
        for (int ai = 0; ai < 2; ++ai)
#pragma unroll
            for (int m = 0; m < 4; ++m) { float* rowp = C + (size_t)(row0 + ai * 128 + m * 16) * ldc + col0;
#pragma unroll
                for (int bj = 0; bj < 2; ++bj)
#pragma unroll
                    for (int n = 0; n < 2; ++n) *(pg8::f32x4*)(rowp + bj * 128 + n * 16) = acc[ai][bj][m][n]; }
    }
};
struct EpiBf16g {
    static constexpr bool PERM = true, AFTER_DRAIN = false;
    bf16* O; int ldc; int ntn;
    __device__ __forceinline__ void operator()(const pg8::f32x4 (&acc)[2][2][4][2], const pg8::Unit& u, int wr, int wc, int fr, int fq) const {
        const int row0 = u.pm * 256 + wr * 64 + fr, col0 = (u.pn % ntn) * 256 + wc * 32 + 8 * fq;
#pragma unroll
        for (int ai = 0; ai < 2; ++ai)
#pragma unroll
            for (int m = 0; m < 4; ++m) { bf16* rowp = O + (size_t)(row0 + ai * 128 + m * 16) * ldc + col0;
#pragma unroll
                for (int bj = 0; bj < 2; ++bj) { const pg8::f32x4 v0 = acc[ai][bj][m][0], v1 = acc[ai][bj][m][1]; pg8::u32x4 w;
                    w.x = pg8::cvt_pk_bf16(v0[0], v0[1]); w.y = pg8::cvt_pk_bf16(v0[2], v0[3]); w.z = pg8::cvt_pk_bf16(v1[0], v1[1]); w.w = pg8::cvt_pk_bf16(v1[2], v1[3]);
                    st16(rowp + bj * 128, __builtin_bit_cast(v4u, w)); } }
    }
};
struct EpiDown {
    static constexpr bool PERM = true, AFTER_DRAIN = false;
    bf16* O; bf16* P;
    __device__ __forceinline__ void operator()(const pg8::f32x4 (&acc)[2][2][4][2], const pg8::Unit& u, int wr, int wc, int fr, int fq) const {
        const int col0 = (u.pn & 3) * 256 + wc * 32 + 8 * fq;
        if (u.kq >= 0 && wr != 0) return;
        bf16* base = u.kq < 0 ? O + (size_t)(u.pm * 256 + wr * 64) * DM : P + (size_t)((u.kq * NE + u.pm / 9) * 64) * DM;
#pragma unroll
        for (int ai = 0; ai < 2; ++ai) { if (u.kq >= 0 && ai) break;
#pragma unroll
            for (int m = 0; m < 4; ++m) { bf16* rowp = base + (size_t)(fr + ai * 128 + m * 16) * DM + col0;
#pragma unroll
                for (int bj = 0; bj < 2; ++bj) { const pg8::f32x4 v0 = acc[ai][bj][m][0], v1 = acc[ai][bj][m][1]; pg8::u32x4 w;
                    w.x = pg8::cvt_pk_bf16(v0[0], v0[1]); w.y = pg8::cvt_pk_bf16(v0[2], v0[3]); w.z = pg8::cvt_pk_bf16(v1[0], v1[1]); w.w = pg8::cvt_pk_bf16(v1[2], v1[3]);
                    st16(rowp + bj * 128, __builtin_bit_cast(v4u, w)); } } }
    }
};
struct EpiSwiglu {
    static constexpr bool PERM = true, AFTER_DRAIN = false;
    unsigned char* ACT;
    __device__ __forceinline__ void operator()(const pg8::f32x4 (&acc)[2][2][4][2], const pg8::Unit& u, int wr, int wc, int fr, int fq) const {
        const int row0 = u.pm * 256 + wr * 64 + fr, col0 = (u.pn % NT1) * 128 + wc * 32 + 8 * fq;
#pragma unroll
        for (int ai = 0; ai < 2; ++ai)
#pragma unroll
            for (int m = 0; m < 4; ++m) { float o[8];
#pragma unroll
                for (int n = 0; n < 2; ++n)
#pragma unroll
                    for (int i = 0; i < 4; ++i) { const float g = acc[ai][0][m][n][i], uu = acc[ai][1][m][n][i]; o[4 * n + i] = g * __builtin_amdgcn_rcpf(1.f + __builtin_amdgcn_exp2f(g * -1.44269504088896341f)) * uu; }
                st8(ACT + (size_t)(row0 + ai * 128 + m * 16) * FF + col0, (unsigned long long)pk4_fp8(o[0], o[1], o[2], o[3]) | ((unsigned long long)pk4_fp8(o[4], o[5], o[6], o[7]) << 32)); }
    }
};
struct OrderBase { __device__ __forceinline__ void a_ready(const pg8::Unit&) const {} __device__ __forceinline__ void done(const pg8::Unit&) const {} __device__ __forceinline__ bool is_small(const pg8::Unit&) const { return false; } };
struct GroupOrder : OrderBase { int nMe, nN, G, c; int splitk = 0;
    __device__ __forceinline__ bool next(int i, pg8::Unit& u) const {
        if ((G & 7) == 0) { const int xcd = c & 7, j = (c >> 3) + (G >> 3) * i; int tl, mt;
            u.kq = -1;
            if (nMe == 9) { const int nfull = 2 * nN * 8; if (j < nfull) { tl = j >> 3; mt = j & 7; } else if (splitk) { tl = (j - nfull) >> 2; mt = 8; u.kq = (j - nfull) & 3; } else { tl = j - nfull; mt = 8; } }
            else { tl = j / nMe; mt = j - tl * nMe; }
            if (tl >= 2 * nN) return false; const int e = xcd + 8 * (tl / nN), nt = tl % nN;
            u.pm = e * 9 + mt; u.pn = e * nN + nt; return true; }
        const int L = i * G + c, per = nMe * nN; if (L >= NE * per) return false; const int e = L / per, r = L % per; u.pm = e * 9 + r % nMe; u.pn = e * nN + r / nMe; return true; }
    __device__ __forceinline__ bool is_small(const pg8::Unit& u) const { return nMe == 9 && (u.pm % 9) == 8; } };
struct WoutOrder : OrderBase { int ctxq, G, c;
    __device__ __forceinline__ bool next(int i, pg8::Unit& u) const { const int L = i * G + c;
        if (L < 256) { int t = L >> 2; t += (t >= 32); u.pm = t; u.pn = L & 3; u.kq = -1; return true; }
        const int j = L - 256; if (!ctxq || j >= 32) return false;
        u.pm = (j >> 4) ? 65 : 32; u.pn = (j >> 2) & 3; u.kq = j & 3; return true; } };
struct EpiWout {
    static constexpr bool PERM = true, AFTER_DRAIN = false;
    bf16* O; bf16* P;
    __device__ __forceinline__ void operator()(const pg8::f32x4 (&acc)[2][2][4][2], const pg8::Unit& u, int wr, int wc, int fr, int fq) const {
        const int col0 = u.pn * 256 + wc * 32 + 8 * fq;
        bf16* base = u.kq < 0 ? O + (size_t)(u.pm * 256) * DM : P + (size_t)((u.kq * 2 + (u.pm == 65 ? 1 : 0)) * 256) * DM;
#pragma unroll
        for (int ai = 0; ai < 2; ++ai)
#pragma unroll
            for (int m = 0; m < 4; ++m) { bf16* rowp = base + (size_t)(wr * 64 + fr + ai * 128 + m * 16) * DM + col0;
#pragma unroll
                for (int bj = 0; bj < 2; ++bj) { const pg8::f32x4 v0 = acc[ai][bj][m][0], v1 = acc[ai][bj][m][1]; pg8::u32x4 w;
                    w.x = pg8::cvt_pk_bf16(v0[0], v0[1]); w.y = pg8::cvt_pk_bf16(v0[2], v0[3]); w.z = pg8::cvt_pk_bf16(v1[0], v1[1]); w.w = pg8::cvt_pk_bf16(v1[2], v1[3]);
                    st16(rowp + bj * 128, __builtin_bit_cast(v4u, w)); } }
    }
};

__device__ __forceinline__ void prep8(const bf16* p, bf16* dst, const float* wv  , bool rope, const f32x2* rp  , bool hi_half) {
    const v4u x = *(const v4u*)p; float v[8] = {bflo(x.x), bfhi(x.x), bflo(x.y), bfhi(x.y), bflo(x.z), bfhi(x.z), bflo(x.w), bfhi(x.w)};
    float ss = 0.f;
#pragma unroll
    for (int i = 0; i < 8; ++i) ss += v[i] * v[i];
    ss += dppf<0xB1>(ss); ss += dppf<0x4E>(ss); ss += dppf<0x141>(ss);
    const float rs = 1.f / sqrtf(ss * (1.f / 64.f) + RMS_EPS);
#pragma unroll
    for (int i = 0; i < 8; ++i) v[i] = v[i] * rs * wv[i];
    if (rope) {
#pragma unroll
        for (int i = 0; i < 8; ++i) { const float partner = dppf<0x4E>(v[i]); const f32x2 cs = rp[i]; v[i] = v[i] * cs.x + (hi_half ? partner : -partner) * cs.y; }
    }
    *(v4u*)dst = (v4u){pk2(v[0], v[1]), pk2(v[2], v[3]), pk2(v[4], v[5]), pk2(v[6], v[7])};
}
__device__ __forceinline__ void ph_attn_prep(const Fr& F, const Args& A, int l) {
    const bf16* P1 = (const bf16*)(A.ws + WS_P1); bf16* QKP = (bf16*)(A.ws + WS_QKP); const f32x2* ROPE = (const f32x2*)(A.ws + WS_ROPE);
    const int gw = F.bid * NWAVES + F.wave, NGW = F.G * NWAVES;
    const int d0 = (F.lane & 7) * 8;
    float qw[8], kw[8];
#pragma unroll
    for (int i = 0; i < 8; ++i) { qw[i] = A.in[11][l * 64 + d0 + i] * attn_body::C2; kw[i] = A.in[12][l * 64 + d0 + i]; }
    const bool hi_half = ((d0 >> 4) & 1) != 0; const bool lastl = (l == DEPTH - 1);
    for (int row = gw; row < MT; row += NGW) {
        const int s = row % SB; const bool lat = s < SEQ;
        const int pos = (d0 < 32) ? (s >> 6) : (s & 63);
        const f32x2* rp = ROPE + (lat ? pos : 0) * 16 + (F.lane & 1) * 8;
        const bf16* rowp = P1 + (size_t)row * NP1; bf16* dstp = QKP + (size_t)row * NQK;
        if (lat || !lastl) prep8(rowp + C_AQ + F.lane * 8, dstp + F.lane * 8, qw, lat, rp, hi_half);
        if (F.lane < 16) prep8(rowp + C_AK + (F.lane & 15) * 8, dstp + 512 + (F.lane & 15) * 8, kw, lat, rp, hi_half);
    }
}

typedef short s16x8 __attribute__((ext_vector_type(8)));
template <int CTRL> __device__ __forceinline__ float dpp_keep(float ident, float v) { return __builtin_bit_cast(float, __builtin_amdgcn_update_dpp(__builtin_bit_cast(int, ident), __builtin_bit_cast(int, v), CTRL, 0xf, 0xf, false)); }
__device__ __forceinline__ float wave_scan_add(float v, int lane) {
    v += dpp_keep<0x111>(0.f, v); v += dpp_keep<0x112>(0.f, v); v += dpp_keep<0x114>(0.f, v); v += dpp_keep<0x118>(0.f, v);
    const float r0 = rlanef(v, 15), r1 = rlanef(v, 31), r2 = rlanef(v, 47); const int row = lane >> 4;
    return v + (row == 0 ? 0.f : (row == 1 ? r0 : (row == 2 ? r0 + r1 : (r0 + r1) + r2)));
}
__device__ __forceinline__ float wave_scan_max(float v, int lane) {
    const float NI = -INFINITY;
    v = fmaxf(v, dpp_keep<0x111>(NI, v)); v = fmaxf(v, dpp_keep<0x112>(NI, v)); v = fmaxf(v, dpp_keep<0x114>(NI, v)); v = fmaxf(v, dpp_keep<0x118>(NI, v));
    const float r0 = rlanef(v, 15), r1 = rlanef(v, 31), r2 = rlanef(v, 47); const int row = lane >> 4;
    return fmaxf(v, row == 0 ? NI : (row == 1 ? r0 : (row == 2 ? fmaxf(r0, r1) : fmaxf(fmaxf(r0, r1), r2))));
}
__device__ __forceinline__ float logsigmoidf_(float x) { return fminf(x, 0.f) - log1pf(expf(-fabsf(x))); }
__device__ __forceinline__ int mpos(int dir, int blk) { return dir == 0 ? (blk >= 64 ? blk - 64 : blk + 2) : (blk >= 64 ? 65 - blk : 65 - blk); }
__device__ __forceinline__ void gate_scan(const Args& A, int l, int row0, int dir, int h, LAS float* BC, LAS float* GG, LAS float* PM, int lane, float* gs = nullptr  ) {
    const float* GT = (const float*)(A.ws + WS_GT); const float bi = A.in[9][((l * 2 + dir) * 2 + 0) * 4 + h], bfg = A.in[9][((l * 2 + dir) * 2 + 1) * 4 + h];
    const int o0 = 2 * lane, o1 = 2 * lane + 1; const int t0 = dir ? 127 - o0 : o0, t1 = dir ? 127 - o1 : o1;
    const float li0 = GT[(size_t)(row0 + t0) * 16 + dir * 8 + h] + bi, li1 = GT[(size_t)(row0 + t1) * 16 + dir * 8 + h] + bi;
    const float lf0 = logsigmoidf_(GT[(size_t)(row0 + t0) * 16 + dir * 8 + 4 + h] + bfg), lf1 = logsigmoidf_(GT[(size_t)(row0 + t1) * 16 + dir * 8 + 4 + h] + bfg);
    const float S = wave_scan_add(lf0 + lf1, lane); const float b0 = S - lf1, b1 = S;
    const float g0 = li0 - b0, g1 = li1 - b1;
    const float M = wave_scan_max(fmaxf(g0, g1), lane); float Mprev = __shfl_up(M, 1); if (lane == 0) Mprev = -INFINITY;
    BC[t0] = b0; BC[t1] = b1; GG[t0] = g0; GG[t1] = g1; PM[t0] = fmaxf(Mprev, g0); PM[t1] = M;
    if (gs) { gs[t0] = b0; gs[t1] = b1; gs[128 + t0] = g0; gs[128 + t1] = g1; gs[256 + t0] = fmaxf(Mprev, g0); gs[256 + t1] = M; }
}
__device__ __forceinline__ void qk_conv8(const bf16* P1, const float* cw  , const float* cb, int row, int seq_lo, int seq_hi, int ch, float scale, float (&o)[8]) {
    const v4u z = {0u, 0u, 0u, 0u};
    const v4u xm = (row - 1 >= seq_lo) ? *(const v4u*)(P1 + (size_t)(row - 1) * NP1 + ch) : z;
    const v4u x0 = *(const v4u*)(P1 + (size_t)row * NP1 + ch);
    const v4u xp = (row + 1 < seq_hi) ? *(const v4u*)(P1 + (size_t)(row + 1) * NP1 + ch) : z;
    const f32x4 w0a = *(const f32x4*)(cw + ch), w0b = *(const f32x4*)(cw + ch + 4), w1a = *(const f32x4*)(cw + 512 + ch), w1b = *(const f32x4*)(cw + 512 + ch + 4), w2a = *(const f32x4*)(cw + 1024 + ch), w2b = *(const f32x4*)(cw + 1024 + ch + 4);
    const f32x4 ba = *(const f32x4*)(cb + ch), bb = *(const f32x4*)(cb + ch + 4);
    const unsigned am[4] = {xm.x, xm.y, xm.z, xm.w}, a0[4] = {x0.x, x0.y, x0.z, x0.w}, ap[4] = {xp.x, xp.y, xp.z, xp.w};
#pragma unroll
    for (int i = 0; i < 4; ++i) {
        const float wl0 = i < 2 ? w0a[2 * i] : w0b[2 * i - 4], wh0 = i < 2 ? w0a[2 * i + 1] : w0b[2 * i - 3];
        const float wl1 = i < 2 ? w1a[2 * i] : w1b[2 * i - 4], wh1 = i < 2 ? w1a[2 * i + 1] : w1b[2 * i - 3];
        const float wl2 = i < 2 ? w2a[2 * i] : w2b[2 * i - 4], wh2 = i < 2 ? w2a[2 * i + 1] : w2b[2 * i - 3];
        const float bl = i < 2 ? ba[2 * i] : bb[2 * i - 4], bh = i < 2 ? ba[2 * i + 1] : bb[2 * i - 3];
        const float ul = bl + wl0 * bflo(am[i]) + wl1 * bflo(a0[i]) + wl2 * bflo(ap[i]);
        const float uh = bh + wh0 * bfhi(am[i]) + wh1 * bfhi(a0[i]) + wh2 * bfhi(ap[i]);
        o[2 * i] = siluf_(ul) * scale; o[2 * i + 1] = siluf_(uh) * scale;
    }
}
constexpr int ML_QT = 0, ML_KN = 18432, ML_AP = 36864, ML_BTP = 88064, ML_VEC = 113664;
constexpr int ML_VT = 36864, ML_KT = 36864 + 26112;
__device__ __forceinline__ void ph_mlstm_local(const Fr& F, const Args& A, int l) {
    const bf16* P1 = (const bf16*)(A.ws + WS_P1); float* SLOC = (float*)(A.ws + WS_SLOC);
    LAS unsigned char* L = F.lds + RING_OFF;
    LAS unsigned short* VT = (LAS unsigned short*)(L + ML_VT); LAS unsigned short* KT = (LAS unsigned short*)(L + ML_KT);
    LAS float* BC = (LAS float*)(L + ML_VEC); LAS float* GG = BC + 256; LAS float* PM = GG + 256; LAS float* WW = PM + 256;
    const float* cw = A.in[7] + (size_t)l * 3 * 512; const float* cb = A.in[8] + l * 512;
    for (int v = F.bid; v < 512 + 32; v += F.G) {
        int b, h, blk, dlo = 0, dhi = 2;
        if (v < 512) { b = v >> 8; h = (v >> 6) & 3; blk = v & 63; } else { const int j = v - 512, c = j >> 1; b = c >> 3; h = (c >> 1) & 3; blk = 64 + (c & 1); dlo = j & 1; dhi = dlo + 1; }
        const int row0 = b * SB + blk * 128; const int seq_lo = blk < 64 ? b * SB : b * SB + SEQ, seq_hi = blk < 64 ? b * SB + SEQ : (b + 1) * SB;
        BSYNC();
        if (F.wave < 2) gate_scan(A, l, row0, F.wave, h, BC + F.wave * 128, GG + F.wave * 128, PM + F.wave * 128, F.lane, (float*)(A.ws + WS_GS) + ((size_t)((b * 4 + h) * NPOS + blk) * 2 + F.wave) * 384);
#pragma unroll
        for (int it = 0; it < 2; ++it) { const int idx = F.tid + it * NTHR, t = idx >> 3, c8 = idx & 7; float o[8];
            qk_conv8(P1, cw, cb, row0 + t, seq_lo, seq_hi, C_MK + h * 64 + c8 * 8, 1.f, o);
#pragma unroll
            for (int i = 0; i < 8; ++i) KT[(c8 * 8 + i) * 136 + t] = (unsigned short)f2bf(o[i]); }
        BSYNC();
        v4u xv[2];
#pragma unroll
        for (int it = 0; it < 2; ++it) { const int idx = F.tid + it * NTHR, t = idx >> 3, c8 = idx & 7; xv[it] = *(const v4u*)(P1 + (size_t)(row0 + t) * NP1 + C_MV + h * 64 + c8 * 8); }
        for (int dir = dlo; dir < dhi; ++dir) {
            const float pmall = dir ? PM[128 + 0] : PM[127];
            const float atot = dir ? BC[128 + 0] : BC[127];
            if (F.tid < 128) { const float wv = fexp(GG[dir * 128 + F.tid] - pmall); WW[dir * 128 + F.tid] = wv; VT[64 * 136 + F.tid] = (unsigned short)f2bf(wv); }
            BSYNC();
#pragma unroll
            for (int it = 0; it < 2; ++it) { const int idx = F.tid + it * NTHR, t = idx >> 3, c8 = idx & 7; const float w = WW[dir * 128 + t];
                const v4u x = xv[it]; const unsigned xa[4] = {x.x, x.y, x.z, x.w};
#pragma unroll
                for (int i = 0; i < 4; ++i) { VT[(c8 * 8 + 2 * i) * 136 + t] = (unsigned short)f2bf(w * bflo(xa[i])); VT[(c8 * 8 + 2 * i + 1) * 136 + t] = (unsigned short)f2bf(w * bfhi(xa[i])); } }
            BSYNC();
            const int stream = (dir * 2 + b) * 4 + h, p = mpos(dir, blk);
            float* rec = SLOC + ((size_t)stream * NPOS + p) * SST;
            if (F.wave < 6) {
                const int be = F.wave >> 1, bd = F.wave & 1, r = F.lane & 31, hh = F.lane >> 5; f32x16 acc = {};
#pragma unroll
                for (int kk = 0; kk < 8; ++kk) { const s16x8 a = *(const LAS s16x8*)(VT + (be * 32 + r) * 136 + kk * 16 + hh * 8), bb = *(const LAS s16x8*)(KT + (bd * 32 + r) * 136 + kk * 16 + hh * 8);
                    acc = __builtin_amdgcn_mfma_f32_32x32x16_bf16(a, bb, acc, 0, 0, 0); }
                if (be < 2) {
#pragma unroll
                    for (int g = 0; g < 16; ++g) { const int e = be * 32 + (g & 3) + 8 * (g >> 2) + 4 * hh; rec[e * 64 + bd * 32 + r] = acc[g]; }
                } else if (hh == 0) rec[4096 + bd * 32 + r] = acc[0];
            } else if (F.wave == 6 && F.lane == 0) { rec[4160] = atot; rec[4161] = atot + pmall; }
            BSYNC();
        }
    }
}
__device__ __forceinline__ void ph_mlstm_carry(const Fr& F, const Args& A) {
    const float* __restrict__ SLOC = (const float*)(A.ws + WS_SLOC); float* __restrict__ SCAR = (float*)(A.ws + WS_SCAR);
    const int vb = F.G - 1 - F.bid; const int gid = vb * NTHR + F.tid, NG = F.G * NTHR;
    for (int i = gid; i < 16 * 4160; i += NG) {
        const int stream = i / 4160, el = i % 4160; float m = 0.f, val = 0.f;
        const float* __restrict__ sl = SLOC + (size_t)stream * NPOS * SST; float* __restrict__ sc = SCAR + (size_t)stream * NPOS * SST;
#pragma unroll 1
        for (int p0 = 0; p0 < NPOS; p0 += 6) {
            float a[6], ml[6], dl[6];
#pragma unroll
            for (int q = 0; q < 6; ++q) { const size_t o = (size_t)(p0 + q) * SST; a[q] = sl[o + 4160]; ml[q] = sl[o + 4161]; dl[q] = sl[o + el]; }
#pragma unroll
            for (int q = 0; q < 6; ++q) { const size_t o = (size_t)(p0 + q) * SST;
                sc[o + el] = val; if (el == 0) sc[o + 4160] = m;
                const float mn = fmaxf(a[q] + m, ml[q]);
                val = fexp(a[q] + m - mn) * val + fexp(ml[q] - mn) * dl[q]; m = mn; }
        }
    }
}
constexpr int M3_QT = 0, M3_KN = 18432, M3_AP = 36864, M3_VT = 88064, M3_C0 = 105472, M3_VEC = 123904;
__device__ __forceinline__ void ph_mlstm_out(const Fr& F, const Args& A, int l, int u_lo, int u_hi, int boff) {
    const bf16* P1 = (const bf16*)(A.ws + WS_P1); const float* SCAR = (const float*)(A.ws + WS_SCAR); const float* SLOC = (const float*)(A.ws + WS_SLOC); bf16* Y = (bf16*)(A.ws + WS_Y);
    LAS unsigned char* L = F.lds + RING_OFF;
    LAS unsigned short* QT = (LAS unsigned short*)(L + M3_QT); LAS unsigned short* KN = (LAS unsigned short*)(L + M3_KN);
    LAS unsigned short* AP = (LAS unsigned short*)(L + M3_AP); LAS unsigned short* VT = (LAS unsigned short*)(L + M3_VT); LAS unsigned short* C0B = (LAS unsigned short*)(L + M3_C0);
    LAS float* BC = (LAS float*)(L + M3_VEC); LAS float* GG = BC + 256; LAS float* PM = GG + 256;
    LAS float* MM = PM + 256; LAS float* WI = MM + 256; LAS float* DEN = WI + 256; LAS float* N0 = DEN + 256; LAS float* SS = N0 + 128; LAS float* M0 = SS + 512;
    const float* cw = A.in[7] + (size_t)l * 3 * 512; const float* cb = A.in[8] + l * 512;
    const int r = F.lane & 31, hh = F.lane >> 5;
    for (int u = u_lo + ((F.bid + F.G - boff) % F.G); u < u_hi; u += F.G) {
        int b, h, blk;
        if (u < 512) { b = u >> 8; h = (u >> 6) & 3; blk = u & 63; } else { const int v = u - 512; b = v >> 3; h = (v >> 1) & 3; blk = 64 + (v & 1); }
        const int row0 = b * SB + blk * 128; const int seq_lo = blk < 64 ? b * SB : b * SB + SEQ, seq_hi = blk < 64 ? b * SB + SEQ : (b + 1) * SB;
        BSYNC();
        if (F.tid < 192) {
            const f32x4 gv = *(const f32x4*)((const float*)(A.ws + WS_GS) + (size_t)((b * 4 + h) * NPOS + blk) * 768 + 4 * F.tid);
            const int gq = 4 * F.tid, gdir = gq / 384, gwhich = (gq % 384) >> 7, gt = gq & 127;
            *(LAS f32x4*)(BC + gwhich * 256 + gdir * 128 + gt) = gv; }
#pragma unroll
        for (int dir = 0; dir < 2; ++dir) {
            const int stream = (dir * 2 + b) * 4 + h, p = mpos(dir, blk);
            const float* rec = p >= 2 ? SCAR + ((size_t)stream * NPOS + p) * SST : SLOC + ((size_t)stream * NPOS) * SST;
            float m0, sc;
            if (p >= 2) { m0 = rec[4160]; sc = 1.f; } else if (p == 1) { const float a0 = rec[4160], ml = rec[4161]; m0 = fmaxf(a0, ml); sc = expf(ml - m0); } else { m0 = 0.f; sc = 0.f; }
            { const int e = F.tid >> 3, d0 = (F.tid & 7) * 8; const f32x4 c0 = *(const f32x4*)(rec + e * 64 + d0), c1 = *(const f32x4*)(rec + e * 64 + d0 + 4);
              *(LAS v4u*)(C0B + (dir * 64 + e) * 72 + d0) = (v4u){pk2(c0.x * sc, c0.y * sc), pk2(c0.z * sc, c0.w * sc), pk2(c1.x * sc, c1.y * sc), pk2(c1.z * sc, c1.w * sc)}; }
            if (F.tid < 64) N0[dir * 64 + F.tid] = rec[4096 + F.tid] * sc;
            if (F.tid == 64) M0[dir] = m0;
        }
#pragma unroll
        for (int it = 0; it < 2; ++it) { const int idx = F.tid + it * NTHR, t = idx >> 3, c8 = idx & 7; float o[8];
            qk_conv8(P1, cw, cb, row0 + t, seq_lo, seq_hi, C_MQ + h * 64 + c8 * 8, 0.125f, o);
            *(LAS v4u*)(QT + t * 72 + c8 * 8) = (v4u){pk2(o[0], o[1]), pk2(o[2], o[3]), pk2(o[4], o[5]), pk2(o[6], o[7])};
            qk_conv8(P1, cw, cb, row0 + t, seq_lo, seq_hi, C_MK + h * 64 + c8 * 8, 1.f, o);
            *(LAS v4u*)(KN + t * 72 + c8 * 8) = (v4u){pk2(o[0], o[1]), pk2(o[2], o[3]), pk2(o[4], o[5]), pk2(o[6], o[7])};
            const v4u x = *(const v4u*)(P1 + (size_t)(row0 + t) * NP1 + C_MV + h * 64 + c8 * 8); const unsigned xa[4] = {x.x, x.y, x.z, x.w};
#pragma unroll
            for (int i = 0; i < 4; ++i) { VT[(c8 * 8 + 2 * i) * 136 + t] = (unsigned short)(xa[i] & 0xffffu); VT[(c8 * 8 + 2 * i + 1) * 136 + t] = (unsigned short)(xa[i] >> 16); } }
        BSYNC();
        if (F.tid < 256) { const int dir = F.tid >> 7, j = F.tid & 127; const float m0 = M0[dir]; const float mm = fmaxf(m0, PM[dir * 128 + j]); MM[F.tid] = mm; WI[F.tid] = fexp(m0 - mm); }
        BSYNC();
        f32x16 osum = {};
        const int bj = F.wave >> 1, be = F.wave & 1;
#pragma unroll 1
        for (int dir = 0; dir < 2; ++dir) {
#pragma unroll
            for (int it = 0; it < 2; ++it) { const int idx = F.tid + it * NTHR, t = idx >> 3, c8 = idx & 7; const float w = WI[dir * 128 + t];
                const v4u x = *(const LAS v4u*)(QT + t * 72 + c8 * 8);
                *(LAS v4u*)(AP + t * 200 + 128 + c8 * 8) = (v4u){pk2(bflo(x.x) * w, bfhi(x.x) * w), pk2(bflo(x.y) * w, bfhi(x.y) * w), pk2(bflo(x.z) * w, bfhi(x.z) * w), pk2(bflo(x.w) * w, bfhi(x.w) * w)}; }
#pragma unroll
            for (int q2 = 0; q2 < 2; ++q2) { const int blkid = F.wave * 2 + q2, bi = blkid >> 2, bs = blkid & 3; f32x16 acc = {};
                const bool need = dir ? (bs >= bi) : (bs <= bi);
                if (need) {
#pragma unroll
                    for (int kk = 0; kk < 4; ++kk) { const s16x8 a = *(const LAS s16x8*)(KN + (bs * 32 + r) * 72 + kk * 16 + hh * 8), bb = *(const LAS s16x8*)(QT + (bi * 32 + r) * 72 + kk * 16 + hh * 8);
                        acc = __builtin_amdgcn_mfma_f32_32x32x16_bf16(a, bb, acc, 0, 0, 0); } }
                const int j = bi * 32 + r; const float mmj = MM[dir * 128 + j];
#pragma unroll
                for (int q = 0; q < 4; ++q) { const int s0 = bs * 32 + 8 * q + 4 * hh; const f32x4 gs = *(const LAS f32x4*)(GG + dir * 128 + s0); float v[4];
#pragma unroll
                    for (int i = 0; i < 4; ++i) { const int sidx = s0 + i; const bool valid = dir ? (sidx >= j) : (sidx <= j); v[i] = valid ? acc[4 * q + i] * fexp(gs[i] - mmj) : 0.f; }
                    *(LAS unsigned long long*)(AP + j * 200 + s0) = (unsigned long long)pk2(v[0], v[1]) | ((unsigned long long)pk2(v[2], v[3]) << 32); } }
            BSYNC();
            { const int j = F.tid >> 2, part = F.tid & 3; float a = 0.f;
#pragma unroll
              for (int i = 0; i < 6; ++i) { const int k0 = part * 48 + 8 * i; const v4u x = *(const LAS v4u*)(AP + j * 200 + k0); const float f[8] = {bflo(x.x), bfhi(x.x), bflo(x.y), bfhi(x.y), bflo(x.z), bfhi(x.z), bflo(x.w), bfhi(x.w)};
                  if (k0 < 128) { a += ((f[0] + f[1]) + (f[2] + f[3])) + ((f[4] + f[5]) + (f[6] + f[7])); }
                  else { const LAS float* nn = N0 + dir * 64 + (k0 - 128);
#pragma unroll
                      for (int q = 0; q < 8; ++q) a += f[q] * nn[q]; } }
              a += dppf<0xB1>(a); a += dppf<0x4E>(a); if (part == 0) DEN[dir * 128 + j] = a; }
            f32x16 acc = {};
#pragma unroll
            for (int kk = 0; kk < 12; ++kk) { const s16x8 a = *(const LAS s16x8*)(AP + (bj * 32 + r) * 200 + kk * 16 + hh * 8);
                const s16x8 bb = kk < 8 ? *(const LAS s16x8*)(VT + (be * 32 + r) * 136 + kk * 16 + hh * 8) : *(const LAS s16x8*)(C0B + (dir * 64 + be * 32 + r) * 72 + (kk - 8) * 16 + hh * 8);
                acc = __builtin_amdgcn_mfma_f32_32x32x16_bf16(a, bb, acc, 0, 0, 0); }
            BSYNC();
#pragma unroll
            for (int g = 0; g < 16; ++g) { const int j = bj * 32 + (g & 3) + 8 * (g >> 2) + 4 * hh; const float den = fmaxf(fabsf(DEN[dir * 128 + j]), fexp(-(BC[dir * 128 + j] + MM[dir * 128 + j]))); osum[g] += acc[g] * __builtin_amdgcn_rcpf(den); }
        }
        float ssq[16];
#pragma unroll
        for (int g = 0; g < 16; ++g) { float q = osum[g] * osum[g]; q += dppf<0xB1>(q); q += dppf<0x4E>(q); q += dppf<0x141>(q); q += dppf<0x140>(q); ssq[g] = q; }
        if ((F.lane & 15) == 0) {
#pragma unroll
            for (int g = 0; g < 16; ++g) SS[(be * 2 + ((F.lane >> 4) & 1)) * 128 + bj * 32 + (g & 3) + 8 * (g >> 2) + 4 * hh] = ssq[g]; }
        BSYNC();
        const int e = be * 32 + r; const float nw = A.in[10][l * 256 + h * 64 + e];
        unsigned ogv[16];
#pragma unroll
        for (int g = 0; g < 16; ++g) ogv[g] = P1[(size_t)(row0 + bj * 32 + (g & 3) + 8 * (g >> 2) + 4 * hh) * NP1 + C_MO + h * 64 + e];
#pragma unroll
        for (int g = 0; g < 16; ++g) asm volatile("" : "+v"(ogv[g]));
#pragma unroll
        for (int g = 0; g < 16; ++g) { const int j = bj * 32 + (g & 3) + 8 * (g >> 2) + 4 * hh; const float tot = (SS[j] + SS[128 + j]) + (SS[256 + j] + SS[384 + j]);
            const float og = bf2f((unsigned short)ogv[g]);
            const float y = osum[g] * (1.f / sqrtf(tot * (1.f / 64.f) + RMS_EPS)) * nw * sigmoidf_(og);
            Y[(size_t)(row0 + j) * DM + h * 64 + e] = (bf16)f2bf(y); }
    }
}

__device__ __forceinline__ float hy_conv(const float* p, int t, int n, float w0, float w1, float w2, float bb) {
    const float xm = t > 0 ? p[t - 1] : 0.f, x0 = p[t], xp = t + 1 < n ? p[t + 1] : 0.f; return bb + w0 * xm + w1 * x0 + w2 * xp; }
__device__ __forceinline__ void hy_row16(const float* p, int t0, float w0, float w1, float w2, float bb, float (&out)[16]) {
    const f32x4 a = *(const f32x4*)(p + t0), b = *(const f32x4*)(p + t0 + 4), c = *(const f32x4*)(p + t0 + 8), d = *(const f32x4*)(p + t0 + 12);
    const float lo = t0 > 0 ? p[t0 - 1] : 0.f, hi = t0 + 16 < SEQ ? p[t0 + 16] : 0.f;
    const float x[18] = {lo, a.x, a.y, a.z, a.w, b.x, b.y, b.z, b.w, c.x, c.y, c.z, c.w, d.x, d.y, d.z, d.w, hi};
#pragma unroll
    for (int i = 0; i < 16; ++i) out[i] = bb + w0 * x[i] + w1 * x[i + 1] + w2 * x[i + 2];
}
__device__ __forceinline__ void hy_spectrum_mul(LAS f32x2* d, const f32x2* __restrict__ hf, int tid) {
#pragma unroll 1
    for (int i0 = 0; i0 < NFFT; i0 += 16 * NTHR) { f32x2 h[16];
#pragma unroll
        for (int k = 0; k < 16; ++k) { const int i = i0 + k * NTHR + tid;
            const int kk = (int)(__brev((unsigned)i) >> 18), ip = (int)(__brev((unsigned)((NFFT - kk) & (NFFT - 1))) >> 18);
            h[k] = hf[(i & 1) ? (i == 1 ? NFFT / 2 : (ip >> 1)) : (i >> 1)]; }
#pragma unroll
        for (int k = 0; k < 16; ++k) { const int i = i0 + k * NTHR + tid; f32x2 hv = h[k]; if (i & 1) hv.y = -hv.y; d[fphys(i)] = cmul(d[fphys(i)], hv); } }
}
__device__ __forceinline__ void ph_hyena(const Fr& F, const Args& A, int l) {
    const float* HY = (const float*)(A.ws + WS_HY); bf16* Y = (bf16*)(A.ws + WS_Y); float* ZT = (float*)(A.ws + WS_Z1);
    const f32x2* TW = (const f32x2*)(A.ws + WS_TW); const f32x2* HF = (const f32x2*)(A.ws + WS_HF);
    LAS f32x2* d = (LAS f32x2*)(F.lds + RING_OFF);
    const bool lastl = (l == DEPTH - 1);
    for (int c = F.bid; c < 256; c += F.G) {
        const float* cwp = A.in[13] + (size_t)l * 3 * 768; const float* cbp = A.in[14] + l * 768;
        float cw[3][3], cbv[3];
#pragma unroll
        for (int w = 0; w < 3; ++w) { cbv[w] = cbp[w * 256 + c];
#pragma unroll
            for (int j = 0; j < 3; ++j) cw[w][j] = cwp[j * 768 + w * 256 + c]; }
        const float sk0 = A.in[21][(l * 2 + 0) * 256 + c], sk1 = A.in[21][(l * 2 + 1) * 256 + c];
        const float* hb0 = HY + ((size_t)(0 * 768 + c)) * SB; const float* hb1 = HY + ((size_t)(1 * 768 + c)) * SB;
        const int t0 = 16 * F.tid; const int pb = fphys(t0);
        float z0[16], z1[16];
        BSYNC();
        hy_row16(hb0, t0, cw[0][0], cw[0][1], cw[0][2], cbv[0], z0); hy_row16(hb1, t0, cw[0][0], cw[0][1], cw[0][2], cbv[0], z1);
#pragma unroll
        for (int i = 0; i < 16; ++i) { d[pb + i] = (f32x2){z0[i], z1[i]}; d[fphys(SEQ + t0) + i] = (f32x2){0.f, 0.f}; }
        BSYNC();
#pragma unroll 1
        for (int o = 0; o < 2; ++o) {
            fft_fwd(d, TW, F.tid);
            hy_spectrum_mul(d, HF + ((size_t)(l * 2 + o) * 256 + c) * HFS, F.tid);
            BSYNC();
            fft_inv(d, TW, F.tid);
            float x0[16], x1[16]; const int w = 1 + o; const float sk = o ? sk1 : sk0;
            hy_row16(hb0 + (size_t)(w * 256) * SB, t0, cw[w][0], cw[w][1], cw[w][2], cbv[w], x0); hy_row16(hb1 + (size_t)(w * 256) * SB, t0, cw[w][0], cw[w][1], cw[w][2], cbv[w], x1);
#pragma unroll
            for (int i = 0; i < 16; ++i) { const f32x2 cv = d[pb + i]; z0[i] = x0[i] * (cv.x + sk * z0[i]); z1[i] = x1[i] * (cv.y + sk * z1[i]); }
            if (o == 0) {
#pragma unroll
                for (int i = 0; i < 16; ++i) { d[pb + i] = (f32x2){z0[i], z1[i]}; d[fphys(SEQ + t0) + i] = (f32x2){0.f, 0.f}; }
            }
            BSYNC();
        }
        { float* o0 = ZT + ((size_t)(0 * 256 + c)) * SEQ + t0; float* o1 = ZT + ((size_t)(1 * 256 + c)) * SEQ + t0;
#pragma unroll
          for (int i4 = 0; i4 < 4; ++i4) { st16(o0 + 4 * i4, __builtin_bit_cast(v4u, (f32x4){z0[4 * i4], z0[4 * i4 + 1], z0[4 * i4 + 2], z0[4 * i4 + 3]})); st16(o1 + 4 * i4, __builtin_bit_cast(v4u, (f32x4){z1[4 * i4], z1[4 * i4 + 1], z1[4 * i4 + 2], z1[4 * i4 + 3]})); } }
        if (!lastl) {
            LAS float* zc = (LAS float*)(F.lds + RING_OFF); LAS float* tp = zc + 512;
            const float* TAPC = (const float*)(A.ws + WS_TAPC) + ((size_t)(l * 2) * 256 + c) * 512;
            const int b = F.tid >> 8, t = F.tid & 255;
            const float* base = HY + ((size_t)(b * 768 + c)) * SB + SEQ;
            const float vc = hy_conv(base, t, CTXL, cw[0][0], cw[0][1], cw[0][2], cbv[0]);
            const float x1c = hy_conv(base + (size_t)256 * SB, t, CTXL, cw[1][0], cw[1][1], cw[1][2], cbv[1]);
            const float x2c = hy_conv(base + (size_t)512 * SB, t, CTXL, cw[2][0], cw[2][1], cw[2][2], cbv[2]);
            BSYNC();
            zc[F.tid] = vc; tp[F.tid] = TAPC[F.tid]; tp[512 + F.tid] = TAPC[(size_t)256 * 512 + F.tid];
            BSYNC();
            auto conv256 = [&](const LAS float* tq  , const LAS float* zq) { float acc = 0.f;
#pragma unroll 1
                for (int q0 = 0; q0 < 256; q0 += 16) { float tv[16], zv[16];
#pragma unroll
                    for (int j = 0; j < 16; ++j) tv[j] = tq[-(q0 + j)];
#pragma unroll
                    for (int j = 0; j < 16; ++j) zv[j] = zq[q0 + j];
#pragma unroll
                    for (int j = 0; j < 16; ++j) asm volatile("" : "+v"(tv[j]), "+v"(zv[j]));
#pragma unroll
                    for (int j = 0; j < 16; ++j) acc += tv[j] * zv[j]; }
                return acc; };
            float y = conv256(tp + 256 + t, zc + b * 256);
            const float zz1 = x1c * (y + sk0 * vc);
            BSYNC(); zc[F.tid] = zz1; BSYNC();
            float y2 = conv256(tp + 512 + 256 + t, zc + b * 256);
            const float zz2 = x2c * (y2 + sk1 * zz1);
            Y[((size_t)b * SB + SEQ + t) * DM + 768 + c] = (bf16)f2bf(zz2);
        }
    }
}

__device__ __forceinline__ void ph_hy_transpose(const Fr& F, const Args& A) {
    const float* ZT = (const float*)(A.ws + WS_Z1); bf16* Y = (bf16*)(A.ws + WS_Y);
    LAS float* tile = (LAS float*)(F.lds + RING_OFF);
    for (int u = F.bid; u < NB * (SEQ / 64); u += F.G) {
        const int b = u / (SEQ / 64), t0 = (u % (SEQ / 64)) * 64;
        BSYNC();
        f32x4 zv[8];
#pragma unroll
        for (int k = 0; k < 8; ++k) { const int idx = F.tid + NTHR * k, c = idx >> 4, f4 = idx & 15; zv[k] = *(const f32x4*)(ZT + ((size_t)(b * 256 + c)) * SEQ + t0 + 4 * f4); }
#pragma unroll
        for (int k = 0; k < 8; ++k) asm volatile("" : "+v"(zv[k]));
#pragma unroll
        for (int k = 0; k < 8; ++k) { const int idx = F.tid + NTHR * k, c = idx >> 4, f4 = idx & 15; const f32x4 v = zv[k];
            tile[(4 * f4 + 0) * 257 + c] = v.x; tile[(4 * f4 + 1) * 257 + c] = v.y; tile[(4 * f4 + 2) * 257 + c] = v.z; tile[(4 * f4 + 3) * 257 + c] = v.w; }
        BSYNC();
#pragma unroll
        for (int k = 0; k < 4; ++k) { const int idx = F.tid + NTHR * k, t = idx >> 5, c8 = idx & 31; const LAS float* sp = tile + t * 257 + c8 * 8;
            *(v4u*)(Y + ((size_t)b * SB + t0 + t) * DM + 768 + c8 * 8) = (v4u){pk2(sp[0], sp[1]), pk2(sp[2], sp[3]), pk2(sp[4], sp[5]), pk2(sp[6], sp[7])}; }
    }
}

__device__ __forceinline__ void ph_attention(const Fr& F, const Args& A, int l, unsigned char* lds_generic, int i_lo, int i_hi) {
    const attn_body::bf16* P1 = (const attn_body::bf16*)(A.ws + WS_P1); const attn_body::bf16* QKP = (const attn_body::bf16*)(A.ws + WS_QKP); attn_body::bf16* Y = (attn_body::bf16*)(A.ws + WS_Y);
    const int nun = (l == DEPTH - 1) ? 512 : 528;
    for (int i = i_lo; i < i_hi; ++i) { const int u = F.bid + i * F.G; if (u >= nun) break;
        int b, hq, q0, kv0, nt;
        if (u < 512) { b = u >> 8; hq = (u >> 5) & 7; q0 = (u & 31) * 256; kv0 = 0; nt = SB / 64; }
        else { const int v = u - 512; b = v >> 3; hq = v & 7; q0 = SEQ; kv0 = SEQ; nt = CTXL / 64; }
        const int kvh = hq >> 2;
        const attn_body::bf16* Qb = QKP + ((size_t)b * SB + q0) * NQK + hq * 64;
        const attn_body::bf16* Kb = QKP + ((size_t)b * SB + kv0) * NQK + 512 + kvh * 64;
        const attn_body::bf16* Vb = P1 + ((size_t)b * SB + kv0) * NP1 + C_AV + kvh * 64;
        attn_body::bf16* Ob = Y + ((size_t)b * SB + q0) * DM + 256 + hq * 64;
        attn_body::attn_unit<8>(Qb, NQK, Kb, Vb, NQK, NP1, nt, Ob, DM, (char*)lds_generic + RING_OFF, F.tid);
    }
}

__device__ __forceinline__ int block_count(int v, LAS int* slot  , int it, int wave, int lane) {
    v = wave_sum_i(v);
    if (lane == 0) slot[(it & 1) * 8 + wave] = v;
    BSYNC();
    int s = 0;
#pragma unroll
    for (int i = 0; i < NWAVES; ++i) s += slot[(it & 1) * 8 + i];
    return s;
}
__device__ __forceinline__ int block_excl_scan(int v, LAS int* wtot  , int wave, int lane, int& tot) {
    int inc = v;
#pragma unroll
    for (int o = 1; o < 64; o <<= 1) { const int t = __shfl_up(inc, o); if (lane >= o) inc += t; }
    BSYNC();
    if (lane == 63) wtot[wave] = inc;
    BSYNC();
    int pre = 0; tot = 0;
#pragma unroll
    for (int i = 0; i < NWAVES; ++i) { const int x = wtot[i]; if (i < wave) pre += x; tot += x; }
    return pre + inc - v;
}
__device__ __forceinline__ void ph_select(const Fr& F, const Args& A, int l) {
    const float* AFF = (const float*)(A.ws + WS_AFF); int* INV = (int*)(A.ws + WS_INV); int* IDX = (int*)(A.ws + WS_IDX); float* VAL = (float*)(A.ws + WS_VAL);
    LAS int* slot = (LAS int*)(F.lds + LDSX_OFF); LAS int* wtot = slot + 16; LAS int* slot3 = slot + 32;
    const int nun = (l == DEPTH - 1) ? 32 : 64;
    for (int u = F.bid; u < nun; u += F.G) {
        const int kind = u >> 5, b = (u >> 4) & 1, e = u & 15;
        const int n = kind ? CTXL : SEQ, cap = n / 8, sbase = kind ? SEQ : 0;
        const float* ap = AFF + ((size_t)b * 16 + e) * SB + sbase;
        unsigned key[16];
#pragma unroll
        for (int i4 = 0; i4 < 4; ++i4) { const int t = 16 * F.tid + 4 * i4; v4u x = {0u, 0u, 0u, 0u}; if (t < n) x = *(const v4u*)(ap + t); key[4 * i4] = x.x; key[4 * i4 + 1] = x.y; key[4 * i4 + 2] = x.z; key[4 * i4 + 3] = x.w; }
        const bool tv = (16 * F.tid < n);
        BSYNC();
        unsigned T = 0u; int itc = 0;
        for (int bit = 29; bit >= -1; bit -= 2) {
            const unsigned c1 = bit >= 0 ? T | (1u << bit) : T | 1u, c2 = bit >= 0 ? T | (2u << bit) : c1, c3 = bit >= 0 ? T | (3u << bit) : c1; int n1 = 0, n2 = 0, n3 = 0;
#pragma unroll
            for (int i = 0; i < 16; ++i) { n1 += (tv && key[i] >= c1) ? 1 : 0; n2 += (tv && key[i] >= c2) ? 1 : 0; n3 += (tv && key[i] >= c3) ? 1 : 0; }
            n1 = wave_sum_i(n1); n2 = wave_sum_i(n2); n3 = wave_sum_i(n3);
            LAS int* sl = slot3 + (itc & 1) * 24; ++itc;
            if (F.lane == 0) { sl[F.wave] = n1; sl[8 + F.wave] = n2; sl[16 + F.wave] = n3; }
            BSYNC();
            int t1 = 0, t2 = 0, t3 = 0;
#pragma unroll
            for (int i = 0; i < NWAVES; ++i) { t1 += sl[i]; t2 += sl[8 + i]; t3 += sl[16 + i]; }
            if (t3 >= cap) T = c3; else if (t2 >= cap) T = c2; else if (t1 >= cap) T = c1; }
        int cgt = 0, ceq = 0;
#pragma unroll
        for (int i = 0; i < 16; ++i) { cgt += (tv && key[i] > T) ? 1 : 0; ceq += (tv && key[i] == T) ? 1 : 0; }
        int tot_gt, tot_eq; (void)block_excl_scan(cgt, wtot, F.wave, F.lane, tot_gt);
        int eqrank = block_excl_scan(ceq, wtot, F.wave, F.lane, tot_eq);
        const int need = cap - tot_gt;
        unsigned selmask = 0u; int csel = 0;
#pragma unroll
        for (int i = 0; i < 16; ++i) { bool sel = false; if (tv) { if (key[i] > T) sel = true; else if (key[i] == T) { sel = eqrank < need; ++eqrank; } } if (sel) { selmask |= 1u << i; ++csel; } }
        int tot_sel; int sl = block_excl_scan(csel, wtot, F.wave, F.lane, tot_sel);
        if (tv) {
#pragma unroll
            for (int i = 0; i < 16; ++i) { const int t = 16 * F.tid + i; const int row = b * SB + sbase + t; int r1 = 0;
                if (selmask & (1u << i)) { const int rr = (kind ? 2048 + b * 32 : b * 1024) + sl; ++sl; IDX[e * ROWS_E + rr] = row; VAL[e * ROWS_E + rr] = __uint_as_float(key[i]); r1 = rr + 1; }
                INV[(size_t)row * 16 + e] = r1; }
        }
#if MK_SINGLE
        asm volatile("s_waitcnt vmcnt(0)" ::: "memory"); __syncthreads();
        if (F.tid == 0) { __builtin_amdgcn_fence(__ATOMIC_RELEASE, "agent"); asm volatile("s_waitcnt vmcnt(0)" ::: "memory"); xb_add((unsigned*)(A.ws + WS_CTL) + CW_SEL + (l * NE + e) * 16, 1u); }
#endif
    }
}
constexpr int NPH_PRO = 3, NPH_LAYER = 10, NPH = NPH_PRO + DEPTH * NPH_LAYER;
constexpr int CARRY_WGS = (16 * 4160 + NTHR - 1) / NTHR;
constexpr int CW_CARRY = 8192;
template <unsigned KMASK> __global__ void __launch_bounds__(NTHR, 2) mk_fwd(Args args) {
    extern __shared__ __attribute__((aligned(16))) unsigned char lds[];
    Fr F; F.lds = (LAS unsigned char*)lds; F.tid = threadIdx.x; F.lane = F.tid & 63; F.wave = __builtin_amdgcn_readfirstlane(F.tid >> 6); F.G = gridDim.x; F.bid = blockIdx.x;
    unsigned char* ws = args.ws;
    for (int u = F.tid; u < (LDS_BYTES - LDSCTL_OFF) / 4; u += NTHR) ((LAS unsigned*)(F.lds + LDSCTL_OFF))[u] = 0u;
    __syncthreads();
#if MK_SINGLE
    XcdBarrier bar = xcd_barrier_post((unsigned*)(ws + WS_CTL) + 1024, (volatile LAS unsigned*)(F.lds + MISC_OFF) + 8);
#ifdef PROBE_DBLBAR
#define GRID_BAR() do { xcd_barrier(bar); xcd_barrier(bar); } while (0)
#else
#define GRID_BAR() xcd_barrier(bar)
#endif
#else
#define GRID_BAR() do {} while (0)
#endif
    const int lo = args.ph_lo, hi = args.ph_hi;
#define IN(k) (lo <= (k) && (k) < hi)
#define KIND(q) if constexpr ((KMASK >> (q)) & 1u)
#ifndef PROBE_KIND
#define PROBE_KIND -1
#endif
#ifndef PROBE_REPS
#define PROBE_REPS 0
#endif
#ifdef PROBE_REPBAR
#define REP(q) for (int rep_ = 0; rep_ < (((q) == PROBE_KIND || PROBE_KIND == 99) ? 1 + PROBE_REPS : 1); ++rep_, (rep_ < (((q) == PROBE_KIND || PROBE_KIND == 99) ? 1 + PROBE_REPS : 1) ? (void)(GRID_BAR()) : (void)0))
#else
#define REP(q) for (int rep_ = 0; rep_ < (((q) == PROBE_KIND || PROBE_KIND == 99) ? 1 + PROBE_REPS : 1); ++rep_)
#endif
#define SEAM(k) do { if (IN(k) && IN((k) + 1)) GRID_BAR(); } while (0)
    KIND(0) if (IN(0)) REP(0) { const Fr Fp = fr_fresh(F); ph_convert(Fp, args); } SEAM(0);
    KIND(1) if (IN(1)) REP(1) { const Fr Fp = fr_fresh(F); ph_taps(Fp, args); } SEAM(1);
    KIND(2) if (IN(2)) { REP(2) { const Fr Fp = fr_fresh(F); ph_ln_a0(Fp, args); } REP(17) { const Fr Fp = fr_fresh(F); ph_filters(Fp, args); } } SEAM(2);
    for (int l = 0; l < DEPTH; ++l) {
        const int pb = NPH_PRO + l * NPH_LAYER; const bool lastl = (l == DEPTH - 1);
        KIND(3) if (IN(pb + 0)) REP(3) {
            const Fr Fp = fr_fresh(F);
            pg8::Gemm g{(const pg8::bf16_t*)(ws + WS_HN), (const pg8::bf16_t*)(ws + WS_WINT) + (size_t)l * NWIN * DM, MT, NWIN, DM}; pg8::StaticOrder S; S.init(MT, NWIN, Fp.G, Fp.bid);
            EpiWin E{(bf16*)(ws + WS_P1), (float*)(ws + WS_HY), (float*)(ws + WS_GT)};
            pg8::gemm_phase<EpiWin, pg8::StaticOrder, PG8_ALIGN, PG8_SP2>(Fp.lds + RING_OFF, g, S, E, Fp.tid);
        } SEAM(pb + 0);
        KIND(4) if (IN(pb + 1)) {
            REP(4) { const Fr Fp = fr_fresh(F); ph_attn_prep(Fp, args, l); }
            REP(14) { const Fr Fp = fr_fresh(F); ph_mlstm_local(Fp, args, l); }
            REP(15) { const Fr Fp = fr_fresh(F); ph_hyena(Fp, args, l); }
        } SEAM(pb + 1);
        KIND(5) if (IN(pb + 2)) { REP(16) { const Fr Fp = fr_fresh(F); ph_mlstm_carry(Fp, args); }
#if MK_SINGLE
            if (F.G - 1 - F.bid < CARRY_WGS) {
                asm volatile("s_waitcnt vmcnt(0)" ::: "memory"); __syncthreads();
                if (F.tid == 0) { __builtin_amdgcn_fence(__ATOMIC_RELEASE, "agent"); asm volatile("s_waitcnt vmcnt(0)" ::: "memory"); xb_add((unsigned*)(ws + WS_CTL) + CW_CARRY + 64 * l, 1u); } }
#endif
            if (!lastl) REP(18) { const Fr Fp = fr_fresh(F); ph_mlstm_out(Fp, args, l, 512, 528, 64); } REP(19) { const Fr Fp = fr_fresh(F); ph_hy_transpose(Fp, args); } REP(5) { const Fr Fp = fr_fresh(F); const int grp = (Fp.bid >> 3) % 3;
#pragma unroll 1
                for (int i = 0; i < 3; ++i) { if (i == grp && rep_ == 0) { const Fr Fq = fr_fresh(F); ph_convert_experts(Fq, args, l); } const Fr Fa = fr_fresh(F); ph_attention(Fa, args, l, lds, i, i + 1); } } }
#if !MK_SINGLE
        SEAM(pb + 2);
#endif
        KIND(6) if (IN(pb + 3)) {
#if MK_SINGLE
            if (IN(pb + 2)) { unsigned* bw = (unsigned*)(ws + WS_CTL) + 1024;
                if (F.tid == 0) { const unsigned need = (unsigned)(CARRY_WGS < F.G ? CARRY_WGS : F.G); XB_SPIN(xb_ld((unsigned*)(ws + WS_CTL) + CW_CARRY + 64 * l) < need, bw); __builtin_amdgcn_fence(__ATOMIC_ACQUIRE, "agent"); asm volatile("s_waitcnt vmcnt(0)" ::: "memory"); }
                __syncthreads(); }
#endif
            REP(6) { const Fr Fp = fr_fresh(F); ph_mlstm_out(Fp, args, l, 0, 512, 0); } } SEAM(pb + 3);
        KIND(7) if (IN(pb + 4)) REP(7) {
            const Fr Fp = fr_fresh(F);
            pg8::Gemm g{(const pg8::bf16_t*)(ws + WS_Y), (const pg8::bf16_t*)(ws + WS_WOUTT) + (size_t)l * DM * DM, MT, DM, DM};
            WoutOrder S; S.ctxq = lastl ? 0 : 1; S.G = Fp.G; S.c = Fp.bid;
            EpiWout E{(bf16*)(ws + WS_MIX), (bf16*)(ws + WS_MIXP)};
            pg8::gemm_phase<EpiWout, WoutOrder, PG8_ALIGN, PG8_SP2>(Fp.lds + RING_OFF, g, S, E, Fp.tid);
        } SEAM(pb + 4);
        KIND(8) if (IN(pb + 5)) REP(8) { const Fr Fp = fr_fresh(F); ph_ln_b(Fp, args, l); } SEAM(pb + 5);
        KIND(9) if (IN(pb + 6)) REP(9) { const Fr Fp = fr_fresh(F); ph_select(Fp, args, l); }
#if !MK_SINGLE
        SEAM(pb + 6);
#endif
        KIND(11) if (IN(pb + 7)) REP(11) {
            const Fr Fp = fr_fresh(F);
            LAS unsigned short* idxl = (LAS unsigned short*)(Fp.lds + IDXL_OFF);
            { const int* IDX = (const int*)(ws + WS_IDX); const int e0 = Fp.bid & 7;
#if MK_SINGLE
              if (IN(pb + 6)) { unsigned* bw = (unsigned*)(ws + WS_CTL) + 1024; const unsigned need = lastl ? 2u : 4u;
                  if (Fp.tid == 0) { unsigned* c0 = (unsigned*)(ws + WS_CTL) + CW_SEL + (l * NE + e0) * 16;
                      XB_SPIN(xb_ld(c0) < need || xb_ld(c0 + 8 * 16) < need, bw); __builtin_amdgcn_fence(__ATOMIC_ACQUIRE, "agent"); asm volatile("s_waitcnt vmcnt(0)" ::: "memory"); } }
#endif
              __syncthreads();
              for (int i = Fp.tid; i < 2 * ROWS_E; i += NTHR) { const int e = e0 + 8 * (i / ROWS_E); const unsigned v = (unsigned)IDX[e * ROWS_E + (i % ROWS_E)]; idxl[i] = (unsigned short)(v < (unsigned)MT ? v : 0u); }
              __syncthreads(); }
            pg8::Gemm8 g{(const unsigned char*)(ws + WS_HN), (const unsigned char*)(ws + WS_W1T) + (size_t)l * NE * (2 * FF) * DM, NE * ROWS_E, NE * 2 * FF, DM, W1_SCALE, idxl};
            GroupOrder S; S.nMe = lastl ? 8 : 9; S.nN = NT1; S.G = Fp.G; S.c = Fp.bid;
            EpiSwiglu E{(unsigned char*)(ws + WS_ACT)};
            pg8::gemm_phase8<EpiSwiglu, GroupOrder, PG8_ALIGN, false, true>(Fp.lds + RING_OFF, g, S, E, Fp.tid);
        } SEAM(pb + 7);
        KIND(12) if (IN(pb + 8)) REP(12) {
            const Fr Fp = fr_fresh(F);
            pg8::Gemm8 g{(const unsigned char*)(ws + WS_ACT), (const unsigned char*)(ws + WS_W2T) + (size_t)l * NE * DM * FF, NE * ROWS_E, NE * DM, FF, W2_SCALE, nullptr};
            GroupOrder S; S.nMe = lastl ? 8 : 9; S.nN = 4; S.G = Fp.G; S.c = Fp.bid; S.splitk = 1;
            EpiDown E{(bf16*)(ws + WS_YE), (bf16*)(ws + WS_YEP)};
            pg8::gemm_phase8<EpiDown, GroupOrder, PG8_ALIGN, false>(Fp.lds + RING_OFF, g, S, E, Fp.tid);
        } SEAM(pb + 8);
        KIND(13) if (IN(pb + 9)) REP(13) { const Fr Fp = fr_fresh(F); ph_ln_c(Fp, args, l); } if (!lastl) SEAM(pb + 9);
    }
#undef IN
#undef SEAM
#undef KIND
#undef REP
}

constexpr int kind_of_phase(int k) { return k < NPH_PRO ? k : (3 + (k - NPH_PRO) % NPH_LAYER < 10 ? 3 + (k - NPH_PRO) % NPH_LAYER : 4 + (k - NPH_PRO) % NPH_LAYER); }
typedef void (*kern_t)(Args);
template <int Q> static kern_t kern_for_kind(int q) { if (q == Q) return mk_fwd<(1u << Q)>; if constexpr (Q + 1 < 14) return kern_for_kind<Q + 1>(q); else return nullptr; }
extern "C" void kernel_launch(void* const* d_in, const int* in_sizes, int n_in, void* d_out, int out_size, void* d_ws, size_t ws_size, hipStream_t stream) {
    static int grid = 0;
    if (grid == 0) {
        if (n_in != 32 || in_sizes[0] != NB * SEQ * DM || out_size != NB * SEQ * DM || ws_size < WS_END) { fprintf(stderr, "kernel_launch: unexpected shapes / workspace (n_in %d, ws %zu < %zu)\n", n_in, ws_size, (size_t)WS_END); grid = -1; return; }
        int dev = 0, cus = 0;
        if (hipGetDevice(&dev) != hipSuccess || hipDeviceGetAttribute(&cus, hipDeviceAttributeMultiprocessorCount, dev) != hipSuccess) { grid = -1; return; }
#if MK_SINGLE
        if (hipFuncSetAttribute((const void*)mk_fwd<0x3fffu>, hipFuncAttributeMaxDynamicSharedMemorySize, LDS_BYTES) != hipSuccess) { fprintf(stderr, "kernel_launch: hipFuncSetAttribute failed\n"); grid = -1; return; }
#else
        for (int q = 0; q < 14; ++q) if (hipFuncSetAttribute((const void*)kern_for_kind<0>(q), hipFuncAttributeMaxDynamicSharedMemorySize, LDS_BYTES) != hipSuccess) { fprintf(stderr, "kernel_launch: hipFuncSetAttribute failed\n"); grid = -1; return; }
#endif
        (void)hipGetLastError();
        grid = cus & ~7;
    }
    if (grid < 0) return;
    if (hipMemsetAsync((char*)d_ws + WS_CTL, 0, CTL_ZERO_BYTES, stream) != hipSuccess) return;
    Args a{};
    for (int i = 0; i < 32; ++i) a.in[i] = (const float*)d_in[i];
    a.out = (float*)d_out; a.ws = (unsigned char*)d_ws;
#if MK_SINGLE
    a.ph_lo = 0; a.ph_hi = NPH;
    hipLaunchKernelGGL(mk_fwd<0x3fffu>, dim3(grid), dim3(NTHR), LDS_BYTES, stream, a);
#else
    for (int k = 0; k < NPH; ++k) { a.ph_lo = k; a.ph_hi = k + 1; kern_t f = kern_for_kind<0>(kind_of_phase(k)); hipLaunchKernelGGL(f, dim3(grid), dim3(NTHR), LDS_BYTES, stream, a); }
#endif
}
```
